# Optimizing an MI355X kernel written in HIP

```python
import jax
import jax.numpy as jnp
from jax import lax
import numpy as np

D_MODEL = 2048
BATCH = 4
SEQ = 2048
DEPTH = 2

HEAD_DIM = 128
Q_BLOCK = 128
EPS = 1e-6
SB_WIDTH = D_MODEL // 2
SB_HEADS = SB_WIDTH // HEAD_DIM
RG_WIDTH = D_MODEL // 2
RG_BLOCK = 64
RG_BLOCKS = RG_WIDTH // RG_BLOCK
CONV_WIDTH = 4
RG_C = 8.0
EVEN_IN = 3 * SB_WIDTH + 2 * RG_WIDTH
EVEN_MIX = SB_WIDTH + RG_WIDTH
NSA_HEADS = D_MODEL // HEAD_DIM
NSA_KV_HEADS = 4
NSA_GROUP = NSA_HEADS // NSA_KV_HEADS
NSA_WIDTH = NSA_HEADS * HEAD_DIM
KV_WIDTH = NSA_KV_HEADS * HEAD_DIM
N_BRANCH = 3
NSA_IN = NSA_WIDTH + 6 * KV_WIDTH + N_BRANCH * NSA_HEADS
CMP_BLOCK = 32
CMP_STRIDE = 16
SLC_BLOCK = 64
N_SEL = 8
WINDOW = 512
FORCE_BONUS = 1e6
D_FF = 7 * D_MODEL // 2
N_EXPERTS = 8
TOP_K = 2
N_EVEN = (DEPTH + 1) // 2
N_ODD = DEPTH // 2
F32 = jnp.float32

kernel_name = 'hybrid_stickbreak_rglru_nsa_moe_adaln'


def rmsnorm(x, g):
    xf = x.astype(F32)
    y = xf * lax.rsqrt(jnp.mean(xf * xf, axis=-1, keepdims=True) + EPS)
    return (y * g.astype(F32)).astype(x.dtype)


def adaln(c, w, b):
    m = jnp.einsum('bd,de->be', jax.nn.silu(c), w) + b
    shift, scale, gate = jnp.split(m, 3, axis=-1)
    return shift[:, None, :], scale[:, None, :], gate[:, None, :]


def masked_softmax(s, mask):
    s = jnp.where(mask, s, -jnp.inf)
    m = jnp.max(s, axis=-1, keepdims=True)
    e = jnp.where(mask, jnp.exp(s - jnp.where(jnp.isfinite(m), m, 0.0)), 0.0)
    return e / jnp.maximum(jnp.sum(e, axis=-1, keepdims=True), 1e-30)


def stick_breaking_attention(q, k, v):
    B, S, H, Dh = q.shape
    nb = S // Q_BLOCK
    scale = Dh ** -0.5
    qb = q.reshape(B, nb, Q_BLOCK, H, Dh).transpose(1, 0, 3, 2, 4)
    kt = k.transpose(0, 2, 1, 3)
    vt = v.transpose(0, 2, 1, 3)
    kpos = jnp.arange(S)

    def block(args):
        qi, bi = args
        qpos = bi * Q_BLOCK + jnp.arange(Q_BLOCK)
        causal = kpos[None, :] < qpos[:, None]
        z = jnp.einsum('bhqd,bhkd->bhqk', qi, kt, preferred_element_type=F32) * scale
        log_beta = jax.nn.log_sigmoid(z)
        log_keep = jnp.where(causal, jax.nn.log_sigmoid(-z), 0.0)
        between = lax.cumsum(log_keep, axis=3, reverse=True) - log_keep
        w = jnp.where(causal, jnp.exp(log_beta + between), 0.0)
        o = jnp.einsum('bhqk,bhkd->bhqd', w.astype(vt.dtype), vt, preferred_element_type=F32)
        return o.astype(q.dtype)

    o = lax.map(block, (qb, jnp.arange(nb)))
    return o.transpose(1, 0, 3, 2, 4).reshape(B, S, H * Dh)


def causal_depthwise_conv(x, w, b):
    C = x.shape[-1]
    K = w.shape[0]
    y = lax.conv_general_dilated(x, w[:, None, :].astype(x.dtype), window_strides=(1,),
                                 padding=[(K - 1, 0)], dimension_numbers=('NWC', 'WIO', 'NWC'),
                                 feature_group_count=C)
    return y + b


def block_diag_linear(x, w, b):
    B, S, C = x.shape
    nblk, cb, _ = w.shape
    y = jnp.einsum('bsnc,ncd->bsnd', x.reshape(B, S, nblk, cb), w).reshape(B, S, C)
    return y + b


def rg_lru(x, wa, ba, wx, bx, lam):
    xf = x.astype(F32)
    r = jax.nn.sigmoid(block_diag_linear(x, wa, ba).astype(F32))
    i = jax.nn.sigmoid(block_diag_linear(x, wx, bx).astype(F32))
    log_a = RG_C * r * jax.nn.log_sigmoid(lam.astype(F32))
    a = jnp.exp(log_a)
    u = jnp.sqrt(-jnp.expm1(2.0 * log_a)) * (i * xf)

    def combine(left, right):
        a_l, b_l = left
        a_r, b_r = right
        return a_l * a_r, a_r * b_l + b_r

    _, h = lax.associative_scan(combine, (a, u), axis=1)
    return h.astype(x.dtype)


def even_mixer(h, w_in, conv_w, conv_b, wa, ba, wx, bx, lam, w_out):
    B, S, _ = h.shape
    proj = jnp.einsum('bsd,de->bse', h, w_in)
    q, k, v, xr, gr = jnp.split(
        proj, [SB_WIDTH, 2 * SB_WIDTH, 3 * SB_WIDTH, 3 * SB_WIDTH + RG_WIDTH], axis=-1)
    heads = lambda t: t.reshape(B, S, SB_HEADS, HEAD_DIM)
    o_a = stick_breaking_attention(heads(q), heads(k), heads(v))
    xr = causal_depthwise_conv(xr, conv_w, conv_b)
    o_b = rg_lru(xr, wa, ba, wx, bx, lam) * jax.nn.gelu(gr)
    return jnp.einsum('bse,ed->bsd', jnp.concatenate([o_a, o_b], axis=-1), w_out)


def compress_blocks(t, pos, w1, w2):
    B, S, G, Dh = t.shape
    nc = (S - CMP_BLOCK) // CMP_STRIDE + 1
    idx = jnp.arange(nc)[:, None] * CMP_STRIDE + jnp.arange(CMP_BLOCK)[None, :]
    blk = t[:, idx] + pos[None, None, :, None, :]
    flat = blk.transpose(0, 1, 3, 2, 4).reshape(B, nc, G, CMP_BLOCK * Dh)
    return jax.nn.gelu(flat @ w1) @ w2


def nsa_mixer(h, w_in, pos_k, pos_v, k_w1, k_w2, v_w1, v_w2, w_out):
    B, S, _ = h.shape
    G, HG, Dh = NSA_KV_HEADS, NSA_GROUP, HEAD_DIM
    nb = S // Q_BLOCK
    n_s = S // SLC_BLOCK
    k_sel = min(N_SEL, n_s)
    scale = Dh ** -0.5
    proj = jnp.einsum('bsd,de->bse', h, w_in)
    offs = [NSA_WIDTH + j * KV_WIDTH for j in range(7)]
    q, kc, vc, ks, vs, kw, vw, g = jnp.split(proj, offs, axis=-1)
    q = q.reshape(B, S, G, HG, Dh)
    kv = lambda t: t.reshape(B, S, G, Dh)
    gates = jax.nn.sigmoid(g.astype(F32)).reshape(B, S, G, HG, N_BRANCH)

    k_cmp = compress_blocks(kv(kc), pos_k, k_w1, k_w2)
    v_cmp = compress_blocks(kv(vc), pos_v, v_w1, v_w2)
    nc = k_cmp.shape[1]
    cmp_end = jnp.arange(nc) * CMP_STRIDE + CMP_BLOCK - 1
    c_start = jnp.arange(nc)[:, None] * CMP_STRIDE
    blk = jnp.arange(n_s)
    overlap = ((c_start < (blk[None, :] + 1) * SLC_BLOCK)
               & (c_start + CMP_BLOCK > blk[None, :] * SLC_BLOCK)).astype(F32)

    ks_blk = kv(ks).reshape(B, n_s, SLC_BLOCK, G, Dh).transpose(0, 3, 1, 2, 4)
    vs_blk = kv(vs).reshape(B, n_s, SLC_BLOCK, G, Dh).transpose(0, 3, 1, 2, 4)
    kw_pad = jnp.pad(kv(kw), ((0, 0), (WINDOW, 0), (0, 0), (0, 0)))
    vw_pad = jnp.pad(kv(vw), ((0, 0), (WINDOW, 0), (0, 0), (0, 0)))
    gather = jax.vmap(jax.vmap(lambda blocks, ids: blocks[ids]))

    q_ch = q.reshape(B, nb, Q_BLOCK, G, HG, Dh).transpose(1, 0, 2, 3, 4, 5)
    g_ch = gates.reshape(B, nb, Q_BLOCK, G, HG, N_BRANCH).transpose(1, 0, 2, 3, 4, 5)

    def chunk(args):
        qc, gc, ci = args
        qpos = ci * Q_BLOCK + jnp.arange(Q_BLOCK)
        s_c = jnp.einsum('bqghd,bngd->bghqn', qc, k_cmp, preferred_element_type=F32) * scale
        p_c = masked_softmax(s_c, cmp_end[None, :] <= qpos[:, None])
        o_c = jnp.einsum('bghqn,bngd->bqghd', p_c.astype(v_cmp.dtype), v_cmp,
                         preferred_element_type=F32)
        imp = jnp.einsum('bghqn,nj->bgqj', p_c, overlap)
        cur = qpos[:, None] // SLC_BLOCK
        forced = (blk[None, :] == 0) | (blk[None, :] == cur) | (blk[None, :] == cur - 1)
        rank = jnp.where(blk[None, :] * SLC_BLOCK <= qpos[:, None],
                         imp + FORCE_BONUS * forced.astype(F32), -jnp.inf)
        _, sel = lax.top_k(rank, k_sel)
        k_g = gather(ks_blk, sel)
        v_g = gather(vs_blk, sel)
        s_s = jnp.einsum('bqghd,bgqnld->bghqnl', qc, k_g, preferred_element_type=F32) * scale
        tok = sel[..., None] * SLC_BLOCK + jnp.arange(SLC_BLOCK)
        m_s = (tok <= qpos[None, None, :, None, None])[:, :, None]
        flat_n = k_sel * SLC_BLOCK
        p_s = masked_softmax(s_s.reshape(B, G, HG, Q_BLOCK, flat_n),
                             m_s.reshape(B, G, 1, Q_BLOCK, flat_n)).reshape(s_s.shape)
        o_s = jnp.einsum('bghqnl,bgqnld->bqghd', p_s.astype(v_g.dtype), v_g,
                         preferred_element_type=F32)
        kwin = lax.dynamic_slice_in_dim(kw_pad, ci * Q_BLOCK, Q_BLOCK + WINDOW, axis=1)
        vwin = lax.dynamic_slice_in_dim(vw_pad, ci * Q_BLOCK, Q_BLOCK + WINDOW, axis=1)
        kpos = ci * Q_BLOCK - WINDOW + jnp.arange(Q_BLOCK + WINDOW)
        m_w = ((kpos[None, :] <= qpos[:, None]) & (kpos[None, :] > qpos[:, None] - WINDOW)
               & (kpos[None, :] >= 0))
        s_w = jnp.einsum('bqghd,bkgd->bghqk', qc, kwin, preferred_element_type=F32) * scale
        p_w = masked_softmax(s_w, m_w)
        o_w = jnp.einsum('bghqk,bkgd->bqghd', p_w.astype(vwin.dtype), vwin,
                         preferred_element_type=F32)
        o = gc[..., 0:1] * o_c + gc[..., 1:2] * o_s + gc[..., 2:3] * o_w
        return o.astype(qc.dtype)

    o = lax.map(chunk, (q_ch, g_ch, jnp.arange(nb)))
    o = o.transpose(1, 0, 2, 3, 4, 5).reshape(B, S, NSA_WIDTH)
    return jnp.einsum('bse,ed->bsd', o, w_out)


def dense_swiglu(h, w_gate, w_up, w_down):
    return (jax.nn.silu(h @ w_gate) * (h @ w_up)) @ w_down


def moe_swiglu(h, router_w, w_gate, w_up, w_down):
    B, S, D = h.shape
    t = h.reshape(B * S, D)
    logits = (t @ router_w).astype(F32)
    top_v, top_i = lax.top_k(logits, TOP_K)
    probs = jax.nn.softmax(top_v, axis=-1)
    gates = jnp.sum(jax.nn.one_hot(top_i, N_EXPERTS, dtype=F32) * probs[..., None], axis=1)
    out = jnp.zeros_like(t)
    for e in range(N_EXPERTS):
        y = dense_swiglu(t, w_gate[e], w_up[e], w_down[e])
        out = out + gates[:, e:e + 1].astype(t.dtype) * y
    return out.reshape(B, S, D)


def setup_inputs(seed: int = 0) -> dict:
    key = jax.random.key(seed)
    keys = iter(jax.random.split(key, 64))

    def nrm(shape, scale):
        return jax.random.normal(next(keys), shape, F32) * scale

    D = D_MODEL
    u = jax.random.uniform(next(keys), (N_EVEN, RG_WIDTH), F32, minval=0.9, maxval=0.999)
    a_base = u ** (1.0 / RG_C)
    rg_lambda = jnp.log(a_base) - jnp.log1p(-a_base)
    return {
        'x': nrm((BATCH, SEQ, D), 1.0),
        'c': nrm((BATCH, D), 1.0),
        'ada_mix_w': nrm((DEPTH, D, 3 * D), D ** -0.5),
        'ada_mix_b': nrm((DEPTH, 3 * D), 0.02),
        'norm_mix_g': 1.0 + nrm((DEPTH, D), 0.02),
        'ada_ffn_w': nrm((DEPTH, D, 3 * D), D ** -0.5),
        'ada_ffn_b': nrm((DEPTH, 3 * D), 0.02),
        'norm_ffn_g': 1.0 + nrm((DEPTH, D), 0.02),
        'even_in_w': nrm((N_EVEN, D, EVEN_IN), D ** -0.5),
        'rg_conv_w': nrm((N_EVEN, CONV_WIDTH, RG_WIDTH), CONV_WIDTH ** -0.5),
        'rg_conv_b': nrm((N_EVEN, RG_WIDTH), 0.02),
        'rg_wa': nrm((N_EVEN, RG_BLOCKS, RG_BLOCK, RG_BLOCK), RG_BLOCK ** -0.5),
        'rg_ba': nrm((N_EVEN, RG_WIDTH), 0.02),
        'rg_wx': nrm((N_EVEN, RG_BLOCKS, RG_BLOCK, RG_BLOCK), RG_BLOCK ** -0.5),
        'rg_bx': nrm((N_EVEN, RG_WIDTH), 0.02),
        'rg_lambda': rg_lambda,
        'even_out_w': nrm((N_EVEN, EVEN_MIX, D), EVEN_MIX ** -0.5),
        'dense_w_gate': nrm((N_EVEN, D, D_FF), D ** -0.5),
        'dense_w_up': nrm((N_EVEN, D, D_FF), D ** -0.5),
        'dense_w_down': nrm((N_EVEN, D_FF, D), D_FF ** -0.5),
        'nsa_in_w': nrm((N_ODD, D, NSA_IN), D ** -0.5),
        'cmp_pos_k': nrm((N_ODD, CMP_BLOCK, HEAD_DIM), 0.1),
        'cmp_pos_v': nrm((N_ODD, CMP_BLOCK, HEAD_DIM), 0.1),
        'cmp_k_w1': nrm((N_ODD, CMP_BLOCK * HEAD_DIM, HEAD_DIM), (CMP_BLOCK * HEAD_DIM) ** -0.5),
        'cmp_k_w2': nrm((N_ODD, HEAD_DIM, HEAD_DIM), HEAD_DIM ** -0.5),
        'cmp_v_w1': nrm((N_ODD, CMP_BLOCK * HEAD_DIM, HEAD_DIM), (CMP_BLOCK * HEAD_DIM) ** -0.5),
        'cmp_v_w2': nrm((N_ODD, HEAD_DIM, HEAD_DIM), HEAD_DIM ** -0.5),
        'nsa_out_w': nrm((N_ODD, NSA_WIDTH, D), NSA_WIDTH ** -0.5),
        'router_w': nrm((N_ODD, D, N_EXPERTS), D ** -0.5),
        'moe_w_gate': nrm((N_ODD, N_EXPERTS, D, D_FF), D ** -0.5),
        'moe_w_up': nrm((N_ODD, N_EXPERTS, D, D_FF), D ** -0.5),
        'moe_w_down': nrm((N_ODD, N_EXPERTS, D_FF, D), D_FF ** -0.5),
        'final_norm_g': 1.0 + nrm((D,), 0.02),
    }


def reference(x, c, ada_mix_w, ada_mix_b, norm_mix_g, ada_ffn_w, ada_ffn_b, norm_ffn_g,
              even_in_w, rg_conv_w, rg_conv_b, rg_wa, rg_ba, rg_wx, rg_bx, rg_lambda,
              even_out_w, dense_w_gate, dense_w_up, dense_w_down,
              nsa_in_w, cmp_pos_k, cmp_pos_v, cmp_k_w1, cmp_k_w2, cmp_v_w1, cmp_v_w2,
              nsa_out_w, router_w, moe_w_gate, moe_w_up, moe_w_down, final_norm_g):
    for layer in range(DEPTH):
        j = layer // 2
        shift, scale, gate = adaln(c, ada_mix_w[layer], ada_mix_b[layer])
        h = rmsnorm(x, norm_mix_g[layer]) * (1.0 + scale) + shift
        if layer % 2 == 0:
            mix = even_mixer(h, even_in_w[j], rg_conv_w[j], rg_conv_b[j], rg_wa[j], rg_ba[j],
                             rg_wx[j], rg_bx[j], rg_lambda[j], even_out_w[j])
        else:
            mix = nsa_mixer(h, nsa_in_w[j], cmp_pos_k[j], cmp_pos_v[j], cmp_k_w1[j], cmp_k_w2[j],
                            cmp_v_w1[j], cmp_v_w2[j], nsa_out_w[j])
        x = x + gate * mix
        shift, scale, gate = adaln(c, ada_ffn_w[layer], ada_ffn_b[layer])
        h = rmsnorm(x, norm_ffn_g[layer]) * (1.0 + scale) + shift
        if layer % 2 == 0:
            ffn = dense_swiglu(h, dense_w_gate[j], dense_w_up[j], dense_w_down[j])
        else:
            ffn = moe_swiglu(h, router_w[j], moe_w_gate[j], moe_w_up[j], moe_w_down[j])
        x = x + gate * ffn
    return rmsnorm(x, final_norm_g)
```

```cpp
#include <hip/hip_runtime.h>
#include <cstdio>
#include <cstdint>
namespace pg8 {
#define PG8_LAS __attribute__((address_space(3)))
typedef unsigned short bf16_t;
typedef short bf16x8 __attribute__((ext_vector_type(8)));
typedef float f32x4 __attribute__((ext_vector_type(4)));
typedef unsigned u32x4 __attribute__((ext_vector_type(4)));
constexpr int BM = 256, BK = 64, HALF = 128, HTB = HALF * BK * 2  , STAGE_BYTES = 8 * HTB, NXCD = 8, WGM = 8;

__host__ __device__ __forceinline__ int lds_byte(int r, int c) { const int st = (r >> 4) * 2 + (c >> 5), rr = r & 15, cc = c & 31, ob = rr * 64 + cc * 2; return st * 1024 + (ob ^ (((ob >> 9) & 1) << 5)); }
__host__ __device__ __forceinline__ void stage_rc(int b, int& R, int& C) { const int st = b / 1024, sb = b % 1024, swz = sb ^ (((sb >> 9) & 1) << 5); R = (st >> 1) * 16 + swz / 64; C = (st & 1) * 32 + (swz % 64) / 2; }
__host__ __device__ __forceinline__ int perm32(int rho) { const int n = rho >> 4, i = rho & 15; return 8 * (i >> 2) + 4 * n + (i & 3); }

struct Unit { int pm, pn; size_t boff; };
struct Gemm { const bf16_t* A; const bf16_t* Bt; int M, N, K; };

struct StaticOrder {
    int nM, nN, nwg, G, c;
    __host__ __device__ void init(int M, int N, int G_, int c_) { nM = M / BM; nN = N / BM; nwg = nM * nN; G = G_; c = c_; }
    __host__ __device__ bool next(int i, Unit& u) const {
        const long L = (long)i * G + c; if (L >= nwg) return false;
        int wgid = (int)L; { const int q = nwg / NXCD, r = nwg % NXCD, xcd = wgid % NXCD, off = wgid / NXCD; wgid = (xcd < r ? xcd * (q + 1) : r * (q + 1) + (xcd - r) * q) + off; }
        const int nig = WGM * nN, gid = wgid / nig, fm = gid * WGM, gsz = (nM - fm) < WGM ? (nM - fm) : WGM;
        u.pm = fm + ((wgid % nig) % gsz); u.pn = (wgid % nig) / gsz; u.boff = 0; return true;
    }
    __device__ __forceinline__ void a_ready(const Unit&) const {}
    __device__ __forceinline__ void done(const Unit&) const {}
};

__device__ __forceinline__ unsigned cvt_pk_bf16(float lo, float hi) { unsigned r; asm volatile("v_cvt_pk_bf16_f32 %0, %1, %2" : "=v"(r) : "v"(lo), "v"(hi)); return r; }

struct EpiBf16P {
    static constexpr bool PERM = true, AFTER_DRAIN = false;
    bf16_t* O; int ldc;
    __device__ __forceinline__ void operator()(const f32x4 (&acc)[2][2][4][2], const Unit& u, int wr, int wc, int fr, int fq) const {
        const int row0 = u.pm * BM + wr * 64 + fr, col0 = u.pn * BM + wc * 32 + 8 * fq;
#pragma unroll
        for (int ai = 0; ai < 2; ++ai)
#pragma unroll
            for (int m = 0; m < 4; ++m) { bf16_t* rowp = O + (size_t)(row0 + ai * HALF + m * 16) * ldc + col0;
#pragma unroll
                for (int bj = 0; bj < 2; ++bj) { const f32x4 v0 = acc[ai][bj][m][0], v1 = acc[ai][bj][m][1];
                    u32x4 w; w.x = cvt_pk_bf16(v0[0], v0[1]); w.y = cvt_pk_bf16(v0[2], v0[3]); w.z = cvt_pk_bf16(v1[0], v1[1]); w.w = cvt_pk_bf16(v1[2], v1[3]);
                    *(u32x4*)(rowp + bj * HALF) = w; } }
    }
};

struct EpiResid {
    static constexpr bool PERM = false, AFTER_DRAIN = false;
    const float* xin; float* xout; int ldc; const float* gate; int gpitch; int rows_per_batch;
    __device__ __forceinline__ void operator()(const f32x4 (&acc)[2][2][4][2], const Unit& u, int wr, int wc, int fr, int fq) const {
        const int row0 = u.pm * BM + wr * 64 + fr, col0 = u.pn * BM + wc * 32 + 4 * fq;
        const float* gp = gate + (size_t)((u.pm * BM) / rows_per_batch) * gpitch + col0;
        f32x4 gv[2][2];
#pragma unroll
        for (int bj = 0; bj < 2; ++bj)
#pragma unroll
            for (int n = 0; n < 2; ++n) gv[bj][n] = *(const f32x4*)(gp + bj * HALF + n * 16);
#pragma unroll
        for (int ai = 0; ai < 2; ++ai)
#pragma unroll
            for (int m = 0; m < 4; ++m) { const size_t off = (size_t)(row0 + ai * HALF + m * 16) * ldc + col0;
#pragma unroll
                for (int bj = 0; bj < 2; ++bj)
#pragma unroll
                    for (int n = 0; n < 2; ++n) { const f32x4 xi = *(const f32x4*)(xin + off + bj * HALF + n * 16);
                        *(f32x4*)(xout + off + bj * HALF + n * 16) = xi + gv[bj][n] * acc[ai][bj][m][n]; } }
    }
};

struct EpiSwiGLU {
    static constexpr bool PERM = true, AFTER_DRAIN = false;
    bf16_t* O; int ldc;
    __device__ __forceinline__ static float silu_mul(float g, float u) { return g * u * __builtin_amdgcn_rcpf(1.f + __builtin_amdgcn_exp2f(-1.44269504089f * g)); }
    __device__ __forceinline__ void operator()(const f32x4 (&acc)[2][2][4][2], const Unit& u, int wr, int wc, int fr, int fq) const {
        const int row0 = u.pm * BM + wr * 64 + fr, col0 = u.pn * HALF + wc * 32 + 8 * fq;
#pragma unroll
        for (int ai = 0; ai < 2; ++ai)
#pragma unroll
            for (int m = 0; m < 4; ++m) { bf16_t* rowp = O + (size_t)(row0 + ai * HALF + m * 16) * ldc + col0;
                const f32x4 g0 = acc[ai][0][m][0], g1 = acc[ai][0][m][1], u0 = acc[ai][1][m][0], u1 = acc[ai][1][m][1];
                u32x4 w; w.x = cvt_pk_bf16(silu_mul(g0[0], u0[0]), silu_mul(g0[1], u0[1])); w.y = cvt_pk_bf16(silu_mul(g0[2], u0[2]), silu_mul(g0[3], u0[3]));
                w.z = cvt_pk_bf16(silu_mul(g1[0], u1[0]), silu_mul(g1[1], u1[1])); w.w = cvt_pk_bf16(silu_mul(g1[2], u1[2]), silu_mul(g1[3], u1[3]));
                *(u32x4*)rowp = w; }
    }
};

struct EpiScaleRow {
    static constexpr bool PERM = false, AFTER_DRAIN = false;
    float* C; int ldc; const float* rowscale;
    __device__ __forceinline__ void operator()(const f32x4 (&acc)[2][2][4][2], const Unit& u, int wr, int wc, int fr, int fq) const {
        const int row0 = u.pm * BM + wr * 64 + fr, col0 = u.pn * BM + wc * 32 + 4 * fq;
#pragma unroll
        for (int ai = 0; ai < 2; ++ai)
#pragma unroll
            for (int m = 0; m < 4; ++m) { const int r = row0 + ai * HALF + m * 16; const float s = rowscale[r]; float* rowp = C + (size_t)r * ldc + col0;
#pragma unroll
                for (int bj = 0; bj < 2; ++bj)
#pragma unroll
                    for (int n = 0; n < 2; ++n) *(f32x4*)(rowp + bj * HALF + n * 16) = acc[ai][bj][m][n] * s; }
    }
};

struct MoeOrder {
    int tc[9]; int nN, G, c; size_t estride;
    __device__ __forceinline__ bool next(int i, Unit& u) const {
        const int nwg = tc[8] * nN; const long L = (long)i * G + c; if (L >= nwg) return false;
        int wgid = (int)L; { const int q = nwg / NXCD, r = nwg % NXCD, xcd = wgid % NXCD, off = wgid / NXCD; wgid = (xcd < r ? xcd * (q + 1) : r * (q + 1) + (xcd - r) * q) + off; }
        int e = 0, start = 0, nt = tc[1];
#pragma unroll
        for (int k = 1; k < 8; ++k) { if (wgid >= tc[k] * nN) { e = k; start = tc[k]; nt = tc[k + 1] - tc[k]; } }
        const int r2 = wgid - start * nN;
        u.pn = r2 / nt; u.pm = start + r2 % nt; u.boff = (size_t)e * estride; return true;
    }
    __device__ __forceinline__ void a_ready(const Unit&) const {}
    __device__ __forceinline__ void done(const Unit&) const {}
};

template <class Epi, class Sched, bool ALIGN_EPI = false, bool SP2 = false>
__device__ __forceinline__ void gemm_phase(PG8_LAS unsigned char* lds, const Gemm g, const Sched& S, const Epi& E) {
    const int tid = threadIdx.x, wid = __builtin_amdgcn_readfirstlane(tid >> 6), lane = tid & 63, wr = wid >> 2, wc = wid & 3, fr = lane & 15, fq = lane >> 4;
    const int K = g.K, nt = K / BK;
    unsigned voffA[2], voffB[2];
#pragma unroll
    for (int i = 0; i < 2; ++i) { int R, C; stage_rc(tid * 16 + i * 8192, R, C); const int Rb = Epi::PERM ? ((R & ~31) + perm32(R & 31)) : R;
        voffA[i] = (unsigned)(R * K + C) * 2u; voffB[i] = (unsigned)(Rb * K + C) * 2u; }
    const size_t kstep = (size_t)(BK * 2);
    const size_t hstep = (size_t)HALF * K * 2;
    const size_t tstep = 2 * hstep;
    const unsigned ldsw = (unsigned)wid * 1024u;
    const int aoff = lds_byte(wr * 64 + fr, fq * 8), boff = lds_byte(wc * 32 + fr, fq * 8);
#define PG8_SA(b, h) (((b) * 2 + (h)) * HTB)
#define PG8_SB(b, h) ((4 + (b) * 2 + (h)) * HTB)
#define PG8_STAGE(bufoff, gbase, voff) do { _Pragma("unroll") for (int _i = 0; _i < 2; ++_i) \
        __builtin_amdgcn_global_load_lds((const unsigned*)((const char*)(gbase) + (voff)[_i]), (PG8_LAS unsigned*)(lds + (bufoff) + ldsw + _i * 8192), 16, 0, 0); } while (0)
#define PG8_LDA(dst, b, h) do { _Pragma("unroll") for (int m = 0; m < 4; ++m) _Pragma("unroll") for (int k = 0; k < 2; ++k) dst[m][k] = *(const PG8_LAS bf16x8*)(lds + PG8_SA(b, h) + aoff + m * 2048 + k * 1024); } while (0)
#define PG8_LDB(dst, b, h) do { _Pragma("unroll") for (int n = 0; n < 2; ++n) _Pragma("unroll") for (int k = 0; k < 2; ++k) dst[n][k] = *(const PG8_LAS bf16x8*)(lds + PG8_SB(b, h) + boff + n * 2048 + k * 1024); } while (0)
#define PG8_MMA(ai, bj, At, Bt) do { __builtin_amdgcn_s_setprio(1); _Pragma("unroll") for (int m = 0; m < 4; ++m) _Pragma("unroll") for (int n = 0; n < 2; ++n) _Pragma("unroll") for (int k = 0; k < 2; ++k) \
        acc[ai][bj][m][n] = __builtin_amdgcn_mfma_f32_16x16x32_bf16(Bt[n][k], At[m][k], acc[ai][bj][m][n], 0, 0, 0); __builtin_amdgcn_s_setprio(0); } while (0)
#define PG8_WAIT_V(n) asm volatile("s_waitcnt vmcnt(" #n ")" ::: "memory")
#define PG8_WAIT_L(n) asm volatile("s_waitcnt lgkmcnt(" #n ")" ::: "memory")
#define PG8_BAR __builtin_amdgcn_s_barrier()
#define PG8_SCHED __builtin_amdgcn_sched_barrier(0)
    Unit cur, nxt; int ui = 0;
    if (!S.next(0, cur)) return;
    f32x4 acc[2][2][4][2];
#pragma unroll
    for (int a = 0; a < 2; ++a)
#pragma unroll
        for (int b = 0; b < 2; ++b)
#pragma unroll
            for (int m = 0; m < 4; ++m)
#pragma unroll
                for (int n = 0; n < 2; ++n) acc[a][b][m][n] = (f32x4){0.f, 0.f, 0.f, 0.f};
    bf16x8 At[4][2], B0[2][2], B1[2][2];
    const char* cA = (const char*)g.A + (size_t)cur.pm * tstep; const char* cB = (const char*)g.Bt + (size_t)cur.pn * tstep + cur.boff;
    S.a_ready(cur);
    if constexpr (SP2) {
        PG8_STAGE(PG8_SB(0, 0), cB, voffB); PG8_STAGE(PG8_SB(0, 1), cB + hstep, voffB); PG8_STAGE(PG8_SA(0, 0), cA, voffA); PG8_STAGE(PG8_SA(0, 1), cA + hstep, voffA);
        if (wr == 1) PG8_BAR;
        PG8_WAIT_V(2); PG8_BAR;
        PG8_STAGE(PG8_SB(1, 0), cB + kstep, voffB); PG8_STAGE(PG8_SA(1, 0), cA + kstep, voffA); PG8_STAGE(PG8_SB(1, 1), cB + hstep + kstep, voffB);
        PG8_WAIT_V(6); PG8_BAR;
    } else {
        PG8_STAGE(PG8_SB(0, 0), cB, voffB); PG8_STAGE(PG8_SA(0, 0), cA, voffA); PG8_STAGE(PG8_SB(0, 1), cB + hstep, voffB); PG8_STAGE(PG8_SA(0, 1), cA + hstep, voffA);
        if (wr == 1) PG8_BAR;
        PG8_WAIT_V(4); PG8_BAR;
        PG8_STAGE(PG8_SB(1, 0), cB + kstep, voffB); PG8_STAGE(PG8_SA(1, 0), cA + kstep, voffA); PG8_STAGE(PG8_SB(1, 1), cB + hstep + kstep, voffB);
        PG8_WAIT_V(6); PG8_BAR;
    }
    for (;;) {
        const bool has_next = S.next(ui + 1, nxt);
        const char* nA = has_next ? (const char*)g.A + (size_t)nxt.pm * tstep : cA; const char* nB = has_next ? (const char*)g.Bt + (size_t)nxt.pn * tstep + nxt.boff : cB;
        for (int t = 0; t < nt; t += 2) {
            const bool last = (t == nt - 2);
            const char* a1 = cA + (size_t)(t + 1) * kstep;
            const char* a2 = last ? nA : cA + (size_t)(t + 2) * kstep; const char* b2 = last ? nB : cB + (size_t)(t + 2) * kstep;
            const char* a3 = a2 + kstep; const char* b3 = b2 + kstep;
            if (last && has_next) S.a_ready(nxt);
            if constexpr (SP2) {
            PG8_LDB(B0, 0, 0); PG8_LDB(B1, 0, 1); PG8_SCHED; PG8_LDA(At, 0, 0); PG8_STAGE(PG8_SA(1, 1), a1 + hstep, voffA);
            PG8_WAIT_V(8); PG8_WAIT_L(0); PG8_BAR; PG8_MMA(0, 0, At, B0); PG8_MMA(0, 1, At, B1); PG8_BAR; PG8_SCHED;
            PG8_LDA(At, 0, 1); PG8_STAGE(PG8_SB(0, 0), b2, voffB); PG8_STAGE(PG8_SB(0, 1), b2 + hstep, voffB); PG8_STAGE(PG8_SA(0, 0), a2, voffA);
            PG8_WAIT_V(8); PG8_WAIT_L(0); PG8_BAR; PG8_MMA(1, 0, At, B0); PG8_MMA(1, 1, At, B1); PG8_BAR; PG8_SCHED;
            PG8_LDB(B0, 1, 0); PG8_LDB(B1, 1, 1); PG8_SCHED; PG8_LDA(At, 1, 0); PG8_STAGE(PG8_SA(0, 1), a2 + hstep, voffA);
            PG8_WAIT_V(8); PG8_WAIT_L(0); PG8_BAR; PG8_MMA(0, 0, At, B0); PG8_MMA(0, 1, At, B1); PG8_BAR; PG8_SCHED;
            PG8_LDA(At, 1, 1); PG8_STAGE(PG8_SB(1, 0), b3, voffB); PG8_STAGE(PG8_SB(1, 1), b3 + hstep, voffB); PG8_STAGE(PG8_SA(1, 0), a3, voffA);
            PG8_WAIT_V(8); PG8_WAIT_L(0); PG8_BAR; PG8_MMA(1, 0, At, B0); PG8_MMA(1, 1, At, B1); PG8_BAR; PG8_SCHED;
            } else {
            PG8_LDB(B0, 0, 0); PG8_SCHED; PG8_LDA(At, 0, 0); PG8_STAGE(PG8_SA(1, 1), a1 + hstep, voffA);
            PG8_WAIT_L(8); PG8_BAR; PG8_WAIT_L(0); PG8_MMA(0, 0, At, B0); PG8_BAR; PG8_SCHED;
            PG8_LDB(B1, 0, 1); PG8_STAGE(PG8_SB(0, 0), b2, voffB);
            PG8_BAR; PG8_WAIT_L(0); PG8_MMA(0, 1, At, B1); PG8_BAR;
            PG8_LDA(At, 0, 1); PG8_STAGE(PG8_SA(0, 0), a2, voffA);
            PG8_BAR; PG8_WAIT_L(0); PG8_MMA(1, 0, At, B0); PG8_BAR; PG8_SCHED;
            PG8_STAGE(PG8_SB(0, 1), b2 + hstep, voffB);
            PG8_WAIT_V(6); PG8_BAR; PG8_MMA(1, 1, At, B1); PG8_BAR;
            PG8_LDB(B0, 1, 0); PG8_SCHED; PG8_LDA(At, 1, 0); PG8_STAGE(PG8_SA(0, 1), a2 + hstep, voffA);
            PG8_WAIT_L(8); PG8_BAR; PG8_WAIT_L(0); PG8_MMA(0, 0, At, B0); PG8_BAR; PG8_SCHED;
            PG8_LDB(B1, 1, 1); PG8_STAGE(PG8_SB(1, 0), b3, voffB);
            PG8_BAR; PG8_WAIT_L(0); PG8_MMA(0, 1, At, B1); PG8_BAR;
            PG8_LDA(At, 1, 1); PG8_STAGE(PG8_SA(1, 0), a3, voffA);
            PG8_BAR; PG8_WAIT_L(0); PG8_MMA(1, 0, At, B0); PG8_BAR; PG8_SCHED;
            PG8_STAGE(PG8_SB(1, 1), b3 + hstep, voffB);
            PG8_WAIT_V(6); PG8_BAR; PG8_MMA(1, 1, At, B1); PG8_BAR;
            }
        }
        if constexpr (ALIGN_EPI) { if (wr == 0) PG8_BAR; }
        if constexpr (!Epi::AFTER_DRAIN) { E(acc, cur, wr, wc, fr, fq); S.done(cur); }
        if (!has_next) break;
#pragma unroll
        for (int a = 0; a < 2; ++a)
#pragma unroll
            for (int b = 0; b < 2; ++b)
#pragma unroll
                for (int m = 0; m < 4; ++m)
#pragma unroll
                    for (int n = 0; n < 2; ++n) acc[a][b][m][n] = (f32x4){0.f, 0.f, 0.f, 0.f};
        cur = nxt; cA = nA; cB = nB; ++ui;
        if constexpr (ALIGN_EPI) { if (wr == 1) PG8_BAR; }
    }
    PG8_WAIT_V(0);
    if constexpr (!ALIGN_EPI) { if (wr == 0) PG8_BAR; }
    PG8_BAR;
    if constexpr (Epi::AFTER_DRAIN) { E.fused(acc, cur, wr, wc, fr, fq, lds, wid, lane); S.done(cur); }
#undef PG8_SA
#undef PG8_SB
#undef PG8_STAGE
#undef PG8_LDA
#undef PG8_LDB
#undef PG8_MMA
#undef PG8_WAIT_V
#undef PG8_WAIT_L
#undef PG8_BAR
#undef PG8_SCHED
}
}
#define GAS __attribute__((address_space(1)))
#define LAS __attribute__((address_space(3)))
typedef unsigned short bf16;
typedef unsigned v4u __attribute__((ext_vector_type(4)));
typedef float f32x4 __attribute__((ext_vector_type(4)));
typedef short bf16x8 __attribute__((ext_vector_type(8)));
typedef GAS unsigned gu32;
typedef GAS unsigned long long gu64;
#define RLX_AGENT __ATOMIC_RELAXED, __HIP_MEMORY_SCOPE_AGENT
#define LDS_WAIT() asm volatile("s_waitcnt lgkmcnt(0)" ::: "memory")
#define VM_WAIT() asm volatile("s_waitcnt vmcnt(0)" ::: "memory")
__device__ __forceinline__ unsigned long long rt() { return __builtin_amdgcn_s_memrealtime(); }
__device__ __forceinline__ unsigned f2bf(float f) { unsigned u = __builtin_bit_cast(unsigned, f); return (u + 0x7fffu + ((u >> 16) & 1u)) >> 16; }
__device__ __forceinline__ unsigned pk2(float lo, float hi) { return f2bf(lo) | (f2bf(hi) << 16); }

#define XB_TMO      128
#define XB_XCNT(j)  (256  + 64 * (j))
#define XB_XSUB(j)  (1280 + 64 * (j))
#define XB_XGEN(j)  (2304 + 64 * (j))
#define XB_TOP      3328
#define XB_TOPGEN   3392
#define XCD_BAR_WORDS 3456
#define XB_SPIN_CAP (1u << 18)

__device__ __forceinline__ unsigned xb_ld(unsigned* p)              { return __hip_atomic_load(p, __ATOMIC_RELAXED, __HIP_MEMORY_SCOPE_AGENT); }
__device__ __forceinline__ unsigned xb_add(unsigned* p, unsigned v) { return __hip_atomic_fetch_add(p, v, __ATOMIC_RELAXED, __HIP_MEMORY_SCOPE_AGENT); }
__device__ __forceinline__ unsigned xb_xcc_id() { return (unsigned)__builtin_amdgcn_s_getreg((3 << 11) | 20) & 0xFu; }
#define XB_SPIN(cond, bar) do { unsigned _sp = 0; while (cond) { __builtin_amdgcn_s_sleep(1); \
    if ((++_sp & 255u) == 0u) { if (xb_ld(&(bar)[XB_TMO])) break; if (_sp > XB_SPIN_CAP) { atomicAdd(&(bar)[XB_TMO], 1u); break; } } } } while (0)

struct XcdBarrier {
    unsigned* bar; unsigned x;
    volatile LAS unsigned* st;
};

__device__ __forceinline__ XcdBarrier xcd_barrier_post(unsigned* bar, volatile LAS unsigned* st) {
    XcdBarrier b; b.bar = bar; b.x = xb_xcc_id(); b.st = st;
    if (threadIdx.x == 0) (void)xb_add(&bar[XB_XCNT(b.x)], 1u);
    return b;
}
__device__ __forceinline__ void xcd_barrier_complete(unsigned* bar, unsigned x, unsigned& nloc, unsigned& nx) {
    const unsigned G = gridDim.x * gridDim.y * gridDim.z;
    unsigned sum, cnt, mine, sp = 0u;
    for (;;) {
        sum = 0u; cnt = 0u; mine = 0u;
#pragma unroll
        for (unsigned j = 0; j < 16; ++j) { const unsigned c = xb_ld(&bar[XB_XCNT(j)]); sum += c; cnt += (c > 0u) ? 1u : 0u; mine = (j == x) ? c : mine; }
        if (sum == G) break;
        __builtin_amdgcn_s_sleep(1);
        if ((++sp & 255u) == 0u) { if (xb_ld(&bar[XB_TMO])) break; if (sp > XB_SPIN_CAP) { atomicAdd(&bar[XB_TMO], 1u); break; } }
    }
    nloc = mine > 0u ? mine : 1u; nx = cnt > 0u ? cnt : 1u;
}

__device__ __forceinline__ void xcd_barrier(const XcdBarrier& b) {
    asm volatile("s_waitcnt vmcnt(0)" ::: "memory");
    __syncthreads();
    if (threadIdx.x == 0) {
        unsigned* bar = b.bar;
        __builtin_amdgcn_s_waitcnt(0);
        unsigned nloc = b.st[0], nx = b.st[1];
        if (nloc == 0u) { xcd_barrier_complete(bar, b.x, nloc, nx); b.st[0] = nloc; b.st[1] = nx; }
        const unsigned old = xb_add(&bar[XB_XSUB(b.x)], 1u);
        const unsigned gen = old / nloc;
        if (old + 1u == (gen + 1u) * nloc) {
            __builtin_amdgcn_fence(__ATOMIC_RELEASE, "agent");
            asm volatile("s_waitcnt vmcnt(0)" ::: "memory");
            const unsigned og = xb_add(&bar[XB_TOP], 1u);
            const unsigned tg = og / nx;
            if (og + 1u == (tg + 1u) * nx) xb_add(&bar[XB_TOPGEN], 1u);
            else XB_SPIN(xb_ld(&bar[XB_TOPGEN]) == tg, bar);
            __builtin_amdgcn_fence(__ATOMIC_ACQUIRE, "agent");
            xb_add(&bar[XB_XGEN(b.x)], 1u);
            asm volatile("s_waitcnt vmcnt(0)" ::: "memory");
        } else {
            XB_SPIN(xb_ld(&bar[XB_XGEN(b.x)]) == gen, bar);
            __builtin_amdgcn_fence(__ATOMIC_ACQUIRE, "agent");
            asm volatile("s_waitcnt vmcnt(0)" ::: "memory");
        }
    }
    __syncthreads();
}


constexpr int NWAVES = 8, NTHR = 512;
constexpr int BATCH = 4, SEQ = 2048, DM = 2048, MTOK = BATCH * SEQ;
constexpr int EVEN_IN = 5120, NSA_IN = 5168, NSA_INP = 5376, DFF = 7168, NEXP = 8, MOE_ROWS = 18432;
constexpr int NCMP = 127;
constexpr float EPS = 1e-6f, QSCALE = 0.08838834764831845f;
constexpr int E_Q = 0, E_K = 1024, E_V = 2048, E_XR = 3072, E_GR = 4096;
constexpr int N_Q = 0, N_KC = 2048, N_VC = 2560, N_KS = 3072, N_VS = 3584, N_KW = 4096, N_VW = 4608, N_G = 5120;
#ifndef MK_N_LAUNCHES
#define MK_N_LAUNCHES 1
#endif
constexpr int NPH = 19;
constexpr int N_LAUNCHES = MK_N_LAUNCHES;

constexpr size_t MiB = 1u << 20;
constexpr size_t WS_CTL = 0, CTL_ZERO_BYTES = 1 * MiB;
constexpr size_t WS_MOD = 1 * MiB;
constexpr size_t WS_ROUTE = 2 * MiB;
constexpr size_t WS_ROWP = 2 * MiB + 512 * 1024;
constexpr size_t WS_KCMP = 3 * MiB, WS_VCMP = 4 * MiB;
constexpr size_t WS_SUMP = 5 * MiB, WS_SUMH = 5 * MiB + 512 * 1024;
constexpr size_t WS_WIN0 = 8 * MiB, WS_WOUT0 = 28 * MiB, WS_WGU0 = 36 * MiB, WS_WDN0 = 92 * MiB, WS_WIN1 = 120 * MiB, WS_WOUT1 = 141 * MiB;
constexpr size_t WS_WMGU = 150 * MiB, WS_WMDN = 598 * MiB;
constexpr size_t WS_XA = 822 * MiB, WS_XB = 886 * MiB, WS_H = 950 * MiB, WS_PROJ = 982 * MiB, WS_MIX = 1066 * MiB;
constexpr size_t WS_ACT = 1098 * MiB, WS_HPERM = 1350 * MiB, WS_Y = 1422 * MiB, WS_END = 1566 * MiB;
constexpr size_t WS_HL = WS_ACT, WS_PC = WS_ACT + 32 * MiB;
constexpr int CW_TMO = 0, CW_CODE = 1, CW_BAR = 4096, CW_CNT = 8192  , CW_TILE = 12288  ;

constexpr int RING_OFF = 0, RING_BYTES = 131072;
constexpr int LDSCTL_OFF = 147456 - 448, MISC_OFF = LDSCTL_OFF + 320;
constexpr int LDS_BYTES = 147456;

struct Frame {
    LAS unsigned char* lds;
    volatile LAS unsigned* MISC;
    gu32* ctl;
    int tid, lane, wave;
    int vcu, G;
    const float *x, *c, *ada_mix_w, *ada_mix_b, *norm_mix_g, *ada_ffn_w, *ada_ffn_b, *norm_ffn_g;
    const float *even_in_w, *rg_conv_w, *rg_conv_b, *rg_wa, *rg_ba, *rg_wx, *rg_bx, *rg_lambda, *even_out_w;
    const float *dense_w_gate, *dense_w_up, *dense_w_down, *nsa_in_w, *cmp_pos_k, *cmp_pos_v, *cmp_k_w1, *cmp_k_w2, *cmp_v_w1, *cmp_v_w2;
    const float *nsa_out_w, *router_w, *moe_w_gate, *moe_w_up, *moe_w_down, *final_norm_g;
    float* out;
    bf16 *Win0, *Wout0, *Wgu0, *Wdn0, *Win1, *Wout1, *Wmgu, *Wmdn;
    float *mod, *xa, *xb, *kcmp, *vcmp, *sumP, *sumH, *hl, *pc, *y, *rowp;
    int* route;
    bf16 *h, *proj, *mix, *act, *hperm;
};

__device__ __forceinline__ float wave_sum(float v) {
#pragma unroll
    for (int o = 1; o < 64; o <<= 1) v += __shfl_xor(v, o);
    return v;
}
__device__ __forceinline__ float grp8_sum(float v) { v += __shfl_xor(v, 1); v += __shfl_xor(v, 2); v += __shfl_xor(v, 4); return v; }
__device__ __forceinline__ float bflo(unsigned u) { return __builtin_bit_cast(float, u << 16); }
__device__ __forceinline__ float bfhi(unsigned u) { return __builtin_bit_cast(float, u & 0xffff0000u); }
__device__ __forceinline__ float bf1(bf16 u) { return __builtin_bit_cast(float, ((unsigned)u) << 16); }
__device__ __forceinline__ void ld16bf(const bf16* p, float (&o)[16]) {
    const v4u a = *(const v4u*)p, b = *(const v4u*)(p + 8);
    o[0] = bflo(a.x); o[1] = bfhi(a.x); o[2] = bflo(a.y); o[3] = bfhi(a.y); o[4] = bflo(a.z); o[5] = bfhi(a.z); o[6] = bflo(a.w); o[7] = bfhi(a.w);
    o[8] = bflo(b.x); o[9] = bfhi(b.x); o[10] = bflo(b.y); o[11] = bfhi(b.y); o[12] = bflo(b.z); o[13] = bfhi(b.z); o[14] = bflo(b.w); o[15] = bfhi(b.w);
}
__device__ __forceinline__ void st16bf(bf16* p, const float (&o)[16]) {
    v4u a, b; a.x = pk2(o[0], o[1]); a.y = pk2(o[2], o[3]); a.z = pk2(o[4], o[5]); a.w = pk2(o[6], o[7]);
    b.x = pk2(o[8], o[9]); b.y = pk2(o[10], o[11]); b.z = pk2(o[12], o[13]); b.w = pk2(o[14], o[15]);
    *(v4u*)p = a; *(v4u*)(p + 8) = b;
}
__device__ __forceinline__ float sigmoidf_(float v) { return 1.f / (1.f + __expf(-v)); }
__device__ __forceinline__ float logsigf_(float z) { return fminf(z, 0.f) - __logf(1.f + __expf(-fabsf(z))); }
__device__ __forceinline__ float gelu_tanh(float v) { const float u = 0.7978845608028654f * (v + 0.044715f * v * v * v); const float t = 1.f - 2.f / (1.f + __expf(2.f * u)); return 0.5f * v * (1.f + t); }

__device__ __forceinline__ void p0_adaln(Frame& F) {
    LAS float* sc = (LAS float*)(F.lds);
    LAS float* red = (LAS float*)(F.lds + 32768);
    for (int i = F.tid; i < BATCH * DM; i += NTHR) { const float v = F.c[i]; sc[i] = v / (1.f + __expf(-v)); }
    __syncthreads();
    for (int u = F.vcu; u < 384; u += F.G) {
        const int j = u / 96, cb = u % 96;
        const float* W = ((j & 1) ? F.ada_ffn_w : F.ada_mix_w) + (size_t)(j >> 1) * DM * 6144;
        const float* Bv = ((j & 1) ? F.ada_ffn_b : F.ada_mix_b) + (size_t)(j >> 1) * 6144;
        const int r = F.lane >> 4, cx = (F.lane & 15) * 4;
        float acc[4][4];
#pragma unroll
        for (int b = 0; b < 4; ++b)
#pragma unroll
            for (int q = 0; q < 4; ++q) acc[b][q] = 0.f;
        const int kbase = F.wave * 256;
#pragma unroll 8
        for (int i = 0; i < 64; ++i) {
            const int k = kbase + 4 * i + r;
            const f32x4 w = *(const f32x4*)(W + (size_t)k * 6144 + cb * 64 + cx);
#pragma unroll
            for (int b = 0; b < 4; ++b) { const float s = sc[b * DM + k]; acc[b][0] += s * w.x; acc[b][1] += s * w.y; acc[b][2] += s * w.z; acc[b][3] += s * w.w; }
        }
#pragma unroll
        for (int b = 0; b < 4; ++b)
#pragma unroll
            for (int q = 0; q < 4; ++q) { float v = acc[b][q]; v += __shfl_xor(v, 16); v += __shfl_xor(v, 32); acc[b][q] = v; }
        if (F.lane < 16) {
#pragma unroll
            for (int b = 0; b < 4; ++b)
#pragma unroll
                for (int q = 0; q < 4; ++q) red[(F.wave * 4 + b) * 64 + cx + q] = acc[b][q];
        }
        __syncthreads();
        if (F.tid < 256) { const int b = F.tid >> 6, col = F.tid & 63; float s = 0.f;
#pragma unroll
            for (int w = 0; w < 8; ++w) s += red[(w * 4 + b) * 64 + col];
            F.mod[(size_t)(j * 4 + b) * 6144 + cb * 64 + col] = s + Bv[cb * 64 + col]; }
        __syncthreads();
    }
}

struct CvtDesc { const float* src; bf16* dst; int N, K, n0, mode; };
constexpr int CVT_NMAT = 10;
__device__ __forceinline__ bool cvt_decode(const Frame& F, int it, CvtDesc& d) {
    constexpr int C0 = 2560, C1 = C0 + 1024, C2 = C1 + 3584, C3 = C2 + 3584, C4 = C3 + 3584, C5 = C4 + 2592, C6 = C5 + 1024, C7 = C6 + 28672, C8 = C7 + 28672, C9 = C8 + 28672;
    if (it >= C9) return false;
    const float* src; bf16* dst; int K, N, mode = 0, r; size_t dstb = 0;
    if (it < C0) { src = F.even_in_w; dst = F.Win0; K = DM; N = EVEN_IN; r = it; }
    else if (it < C1) { src = F.even_out_w; dst = F.Wout0; K = DM; N = DM; r = it - C0; }
    else if (it < C2) { src = F.dense_w_gate; dst = F.Wgu0; K = DM; N = DFF; mode = 1; r = it - C1; }
    else if (it < C3) { src = F.dense_w_up; dst = F.Wgu0; K = DM; N = DFF; mode = 2; r = it - C2; }
    else if (it < C4) { src = F.dense_w_down; dst = F.Wdn0; K = DFF; N = DM; r = it - C3; }
    else if (it < C5) { src = F.nsa_in_w; dst = F.Win1; K = DM; N = NSA_IN; r = it - C4; }
    else if (it < C6) { src = F.nsa_out_w; dst = F.Wout1; K = DM; N = DM; r = it - C5; }
    else if (it < C7) { src = F.moe_w_gate; dst = F.Wmgu; K = DM; N = DFF; mode = 1; r = it - C6; dstb = (size_t)2 * DFF * DM; }
    else if (it < C8) { src = F.moe_w_up; dst = F.Wmgu; K = DM; N = DFF; mode = 2; r = it - C7; dstb = (size_t)2 * DFF * DM; }
    else { src = F.moe_w_down; dst = F.Wmdn; K = DFF; N = DM; r = it - C8; dstb = (size_t)DFF * DM; }
    const int nblk = (N + 63) >> 6, ipb = (K >> 6) * nblk;
    const int e = r / ipb, r2 = r - e * ipb, kb = r2 / nblk, nb = r2 - kb * nblk;
    d.N = N; d.K = K; d.n0 = nb * 64; d.mode = mode;
    d.src = src + (size_t)e * K * N + (size_t)(kb * 64) * N + nb * 64;
    d.dst = dst + (size_t)e * dstb + kb * 64;
    return true;
}
__device__ __forceinline__ void cvt_load(const CvtDesc& d, int lane, f32x4 (&v)[16]) {
    const int r = lane >> 4, cx = (lane & 15) * 4; const bool ok = (d.n0 + cx) < d.N;
#pragma unroll
    for (int i = 0; i < 16; ++i) v[i] = ok ? *(const f32x4*)(d.src + (size_t)(4 * i + r) * d.N + cx) : (f32x4){0.f, 0.f, 0.f, 0.f};
}
__device__ __forceinline__ void cvt_store(const CvtDesc& d, int lane, const f32x4 (&v)[16], LAS float* scr) {
    const int r = lane >> 4, cx = (lane & 15) * 4;
#pragma unroll
    for (int i = 0; i < 16; ++i) { LAS float* p = scr + (4 * i + r) * 65 + cx; p[0] = v[i].x; p[1] = v[i].y; p[2] = v[i].z; p[3] = v[i].w; }
    LDS_WAIT(); asm volatile("" ::: "memory");
    const int c = lane & 7;
#pragma unroll
    for (int j = 0; j < 8; ++j) { const int nl = (lane >> 3) + 8 * j, n = d.n0 + nl; const LAS float* s = scr + (8 * c) * 65 + nl;
        v4u o; o.x = pk2(s[0 * 65], s[1 * 65]); o.y = pk2(s[2 * 65], s[3 * 65]); o.z = pk2(s[4 * 65], s[5 * 65]); o.w = pk2(s[6 * 65], s[7 * 65]);
        const int row = d.mode == 0 ? n : ((n >> 7) * 256 + (n & 127) + (d.mode == 2 ? 128 : 0));
        if (n < d.N) *(v4u*)(d.dst + (size_t)row * d.K + 8 * c) = o; }
    LDS_WAIT(); asm volatile("" ::: "memory");
}
__device__ __forceinline__ void p0_convert(Frame& F) {
    LAS float* scr = (LAS float*)(F.lds + F.wave * 16640);
    const int gw = F.vcu * NWAVES + F.wave, NGW = F.G * NWAVES;
    { const int gt = F.vcu * NTHR + F.tid; v4u* z = (v4u*)(F.Win1 + (size_t)NSA_IN * DM); const int nz = (NSA_INP - NSA_IN) * DM / 8;
      for (int i = gt; i < nz; i += F.G * NTHR) z[i] = (v4u){0u, 0u, 0u, 0u}; }
    CvtDesc dA, dB; f32x4 vA[16], vB[16];
    int it = gw; bool okA = cvt_decode(F, it, dA);
    if (okA) cvt_load(dA, F.lane, vA);
    while (okA) {
        const bool okB = cvt_decode(F, it + NGW, dB);
        if (okB) cvt_load(dB, F.lane, vB);
        cvt_store(dA, F.lane, vA, scr);
        if (!okB) break;
        okA = cvt_decode(F, it + 2 * NGW, dA);
        if (okA) cvt_load(dA, F.lane, vA);
        cvt_store(dB, F.lane, vB, scr);
        it += 2 * NGW;
    }
}

__device__ __forceinline__ void normmod_row(const float* xrow, const float* g, const float* modb, bf16* orow, int lane, f32x4 (&y)[8]) {
    const f32x4* xr = (const f32x4*)xrow + lane; float ss = 0.f;
#pragma unroll
    for (int j = 0; j < 8; ++j) { y[j] = xr[64 * j]; ss += (y[j].x * y[j].x + y[j].y * y[j].y) + (y[j].z * y[j].z + y[j].w * y[j].w); }
    const float rs = 1.f / sqrtf(wave_sum(ss) * (1.f / DM) + EPS);
    const f32x4* gp = (const f32x4*)g + lane; const f32x4* sh = (const f32x4*)modb + lane; const f32x4* scl = (const f32x4*)(modb + DM) + lane;
    unsigned long long* o8 = (unsigned long long*)orow + lane;
#pragma unroll
    for (int j = 0; j < 8; ++j) { const f32x4 gg = gp[64 * j], s = sh[64 * j], c = scl[64 * j];
        y[j] = (y[j] * rs) * gg * (c + 1.f) + s;
        o8[64 * j] = (unsigned long long)pk2(y[j].x, y[j].y) | ((unsigned long long)pk2(y[j].z, y[j].w) << 32); }
}
__device__ __forceinline__ void normmod_phase(Frame& F, const float* xin, const float* g, const float* modj) {
    const int gw = F.vcu * NWAVES + F.wave, NGW = F.G * NWAVES;
    for (int m = gw; m < MTOK; m += NGW) { f32x4 y[8]; normmod_row(xin + (size_t)m * DM, g, modj + (size_t)(m / SEQ) * 6144, F.h + (size_t)m * DM, F.lane, y); }
}

__device__ __forceinline__ void sb_attn_unit(Frame& F, int unit) {
    const int qb = unit & 31, hh = (unit >> 5) & 7, b = unit >> 8;
    const int ql = F.tid >> 3, ds = F.tid & 7, t = qb * 64 + ql;
    const bf16* base = F.proj + (size_t)b * SEQ * EVEN_IN + hh * 128 + ds * 16;
    float q[16], o[16];
    ld16bf(base + (size_t)t * EVEN_IN + E_Q, q);
#pragma unroll
    for (int i = 0; i < 16; ++i) { q[i] *= QSCALE; o[i] = 0.f; }
    float R = 0.f; int j = t - 1;
    for (;;) {
        const bool active = (j >= 0) && (R > -120.f);
        if (!__any(active)) break;
        if (active) {
            float k[16], v[16];
            ld16bf(base + (size_t)j * EVEN_IN + E_K, k); ld16bf(base + (size_t)j * EVEN_IN + E_V, v);
            float z = 0.f;
#pragma unroll
            for (int i = 0; i < 16; ++i) z += q[i] * k[i];
            z = grp8_sum(z);
            const float lb = logsigf_(z), w = __expf(lb + R);
            R += lb - z;
#pragma unroll
            for (int i = 0; i < 16; ++i) o[i] += w * v[i];
        }
        --j;
    }
    st16bf(F.mix + (size_t)(b * SEQ + t) * DM + hh * 128 + ds * 16, o);
}

__device__ __forceinline__ void rglru_local_unit(Frame& F, int unit) {
    const int nb = unit & 15, ck = (unit >> 4) & 31, b = unit >> 9;
    LAS float* xin = (LAS float*)(F.lds);
    LAS float* xc = xin + 67 * 64;
    LAS float* wa = xc + 64 * 64;
    LAS float* wx = wa + 64 * 64;
    LAS float* segP = wx + 64 * 64;
    LAS float* segH = segP + 8 * 64;
    const int t0 = ck * 64, ch0 = nb * 64;
    for (int i = F.tid; i < 67 * 64; i += NTHR) { const int r = i >> 6, cc = i & 63, t = t0 - 3 + r;
        xin[i] = (t >= 0) ? bf1(F.proj[(size_t)(b * SEQ + t) * EVEN_IN + E_XR + ch0 + cc]) : 0.f; }
    for (int i = F.tid; i < 64 * 64; i += NTHR) { wa[i] = F.rg_wa[(size_t)nb * 4096 + i]; wx[i] = F.rg_wx[(size_t)nb * 4096 + i]; }
    __syncthreads();
    for (int i = F.tid; i < 64 * 64; i += NTHR) { const int tt = i >> 6, cc = i & 63; const int ch = ch0 + cc;
        xc[i] = F.rg_conv_w[0 * 1024 + ch] * xin[(tt + 0) * 64 + cc] + F.rg_conv_w[1 * 1024 + ch] * xin[(tt + 1) * 64 + cc]
              + F.rg_conv_w[2 * 1024 + ch] * xin[(tt + 2) * 64 + cc] + F.rg_conv_w[3 * 1024 + ch] * xin[(tt + 3) * 64 + cc] + F.rg_conv_b[ch]; }
    __syncthreads();
    const int d = F.tid & 63, tq = F.tid >> 6, ch = ch0 + d;
    float aa[8], ax[8];
#pragma unroll
    for (int i = 0; i < 8; ++i) { aa[i] = 0.f; ax[i] = 0.f; }
    for (int cc = 0; cc < 64; ++cc) { const float wac = wa[cc * 64 + d], wxc = wx[cc * 64 + d];
#pragma unroll
        for (int i = 0; i < 8; ++i) { const float xv = xc[(tq * 8 + i) * 64 + cc]; aa[i] += xv * wac; ax[i] += xv * wxc; } }
    const float ba = F.rg_ba[ch], bx = F.rg_bx[ch], lsl = logsigf_(F.rg_lambda[ch]);
    float hloc[8], pl[8]; float hprev = 0.f, pprev = 1.f;
#pragma unroll
    for (int i = 0; i < 8; ++i) {
        const float r = sigmoidf_(aa[i] + ba), ig = sigmoidf_(ax[i] + bx);
        const float la = 8.f * r * lsl, a = __expf(la);
        const float u = sqrtf(fmaxf(1.f - a * a, 0.f)) * (ig * xc[(tq * 8 + i) * 64 + d]);
        hprev = a * hprev + u; pprev = pprev * a; hloc[i] = hprev; pl[i] = pprev;
    }
    segP[tq * 64 + d] = pprev; segH[tq * 64 + d] = hprev;
    __syncthreads();
    float carry = 0.f, pp = 1.f;
    for (int s = 0; s < tq; ++s) { const float sp = segP[s * 64 + d]; carry = sp * carry + segH[s * 64 + d]; pp *= sp; }
#pragma unroll
    for (int i = 0; i < 8; ++i) { const size_t m = (size_t)(b * SEQ + t0 + tq * 8 + i);
        const float hv = hloc[i] + pl[i] * carry, pv = pl[i] * pp;
        F.hl[m * 1024 + ch] = hv; F.pc[m * 1024 + ch] = pv;
        if (tq == 7 && i == 7) { F.sumP[(size_t)(b * 32 + ck) * 1024 + ch] = pv; F.sumH[(size_t)(b * 32 + ck) * 1024 + ch] = hv; } }
    __syncthreads();
}

__device__ __forceinline__ void rglru_fix_unit(Frame& F, int unit) {
    const int cg = unit & 3, ck = (unit >> 2) & 31, b = unit >> 7;
    const int ch = cg * 256 + (F.tid & 255), th = F.tid >> 8;
    float carry = 0.f;
    for (int s = 0; s < ck; ++s) carry = F.sumP[(size_t)(b * 32 + s) * 1024 + ch] * carry + F.sumH[(size_t)(b * 32 + s) * 1024 + ch];
    for (int i = 0; i < 32; ++i) { const size_t m = (size_t)(b * SEQ + ck * 64 + th * 32 + i);
        const float hv = F.hl[m * 1024 + ch] + F.pc[m * 1024 + ch] * carry;
        const float gr = bf1(F.proj[m * EVEN_IN + E_GR + ch]);
        F.mix[m * DM + 1024 + ch] = (bf16)f2bf(hv * gelu_tanh(gr)); }
}

__device__ __forceinline__ void cmp_unit(Frame& F, int unit) {
    const int ng = unit & 15, g = (unit >> 4) & 3, b = (unit >> 6) & 3, which = unit >> 8;
    const float* w1 = which ? F.cmp_v_w1 : F.cmp_k_w1; const float* w2 = which ? F.cmp_v_w2 : F.cmp_k_w2; const float* pos = which ? F.cmp_pos_v : F.cmp_pos_k;
    float* outp = which ? F.vcmp : F.kcmp; const int coff = (which ? N_VC : N_KC) + g * 128;
    LAS float* xin = (LAS float*)(F.lds);
    LAS float* psum = xin + 144 * 128;
    LAS float* hid = psum + 4 * 8 * 128;
    for (int i = F.tid; i < 144 * 128; i += NTHR) { const int r = i >> 7, dd = i & 127, t = ng * 128 + r;
        xin[i] = (t < SEQ) ? bf1(F.proj[(size_t)(b * SEQ + t) * NSA_INP + coff + dd]) : 0.f; }
    __syncthreads();
    const int dout = F.tid & 127, ks = F.tid >> 7;
    float acc[8], accp = 0.f;
#pragma unroll
    for (int i = 0; i < 8; ++i) acc[i] = 0.f;
    for (int l = ks * 8; l < ks * 8 + 8; ++l) {
#pragma unroll 4
        for (int dd = 0; dd < 128; ++dd) { const float wv = w1[(size_t)(l * 128 + dd) * 128 + dout]; accp += pos[l * 128 + dd] * wv;
#pragma unroll
            for (int nl = 0; nl < 8; ++nl) acc[nl] += xin[(16 * nl + l) * 128 + dd] * wv; } }
#pragma unroll
    for (int nl = 0; nl < 8; ++nl) psum[(ks * 8 + nl) * 128 + dout] = acc[nl] + accp;
    __syncthreads();
    for (int i = F.tid; i < 8 * 128; i += NTHR) hid[i] = gelu_tanh(psum[i] + psum[1024 + i] + psum[2048 + i] + psum[3072 + i]);
    __syncthreads();
    for (int i = F.tid; i < 8 * 128; i += NTHR) { const int nl = i >> 7, dd = i & 127, n = ng * 8 + nl; float s = 0.f;
        for (int k = 0; k < 128; ++k) s += hid[nl * 128 + k] * w2[k * 128 + dd];
        if (n < NCMP) outp[((size_t)(b * 128 + n) * 4 + g) * 128 + dd] = s; }
    __syncthreads();
}

__device__ __forceinline__ unsigned nsa_select(const LAS float* imp, int t) {
    const int cur = t >> 6;
    unsigned mask = 1u | (1u << cur); if (cur >= 1) mask |= 1u << (cur - 1);
    int need = 8 - __builtin_popcount(mask);
    const unsigned valid = (cur >= 31) ? 0xffffffffu : ((2u << cur) - 1u);
    for (; need > 0; --need) {
        unsigned cand = valid & ~mask; if (!cand) break;
        float best = -1.f; int bi = -1;
        for (int j = 0; j <= cur; ++j) if ((cand >> j) & 1u) { const float v = imp[j]; if (v > best) { best = v; bi = j; } }
        if (bi < 0) bi = __builtin_ctz(cand);
        mask |= 1u << bi;
    }
    return mask;
}
__device__ __forceinline__ void nsa_attn_unit(Frame& F, int unit) {
    const int qt = unit & 127, g = (unit >> 7) & 3, b = unit >> 9;
    LAS float* scs = (LAS float*)(F.lds);
    LAS float* impb = scs + 16 * 4 * 128;
    LAS float* imps = impb + 16 * 4 * 32;
    LAS unsigned* selm = (LAS unsigned*)(imps + 16 * 32);
    const int ql = F.tid >> 5, hg = (F.tid >> 3) & 3, ds = F.tid & 7, t = qt * 16 + ql, head = g * 4 + hg;
    const size_t m = (size_t)b * SEQ + t;
    const bf16* prow = F.proj + m * NSA_INP;
    const bf16* pb = F.proj + (size_t)b * SEQ * NSA_INP + g * 128 + ds * 16;
    float q[16], ot[16], ob[16];
    ld16bf(prow + N_Q + head * 128 + ds * 16, q);
#pragma unroll
    for (int i = 0; i < 16; ++i) { q[i] *= QSCALE; ot[i] = 0.f; }
    const float gc = sigmoidf_(bf1(prow[N_G + head * 3 + 0])), gs = sigmoidf_(bf1(prow[N_G + head * 3 + 1])), gw = sigmoidf_(bf1(prow[N_G + head * 3 + 2]));
    const int nv = (t >= 31) ? ((t - 31) >> 4) + 1 : 0;
    LAS float* myscs = scs + (ql * 4 + hg) * 128;
    float mx = -3.0e38f;
    for (int n = 0; n < nv; ++n) { const float* kp = F.kcmp + ((size_t)(b * 128 + n) * 4 + g) * 128 + ds * 16; float s = 0.f;
#pragma unroll
        for (int i = 0; i < 16; ++i) s += q[i] * kp[i];
        s = grp8_sum(s); mx = fmaxf(mx, s); if (ds == 0) myscs[n] = s; }
    __syncthreads();
    float lsum = 0.f;
#pragma unroll
    for (int i = 0; i < 16; ++i) ob[i] = 0.f;
    for (int n = 0; n < nv; ++n) { const float p = __expf(myscs[n] - mx); lsum += p; const float* vp = F.vcmp + ((size_t)(b * 128 + n) * 4 + g) * 128 + ds * 16;
#pragma unroll
        for (int i = 0; i < 16; ++i) ob[i] += p * vp[i]; }
    { const float inv = (nv > 0) ? gc / lsum : 0.f;
#pragma unroll
      for (int i = 0; i < 16; ++i) ot[i] += ob[i] * inv; }
    { const float invl = (nv > 0) ? 1.f / lsum : 0.f;
#pragma unroll
      for (int jj = 0; jj < 4; ++jj) { const int j = ds + 8 * jj; float s = 0.f;
          for (int n = 4 * j - 1; n <= 4 * j + 3; ++n) if (n >= 0 && n < nv) s += __expf(myscs[n] - mx);
          impb[(ql * 4 + hg) * 32 + j] = s * invl; } }
    __syncthreads();
    { const int qq = F.tid >> 5, j = F.tid & 31; imps[qq * 32 + j] = (impb[(qq * 4 + 0) * 32 + j] + impb[(qq * 4 + 1) * 32 + j]) + (impb[(qq * 4 + 2) * 32 + j] + impb[(qq * 4 + 3) * 32 + j]); }
    __syncthreads();
    if (F.tid < 16) selm[F.tid] = nsa_select(imps + F.tid * 32, qt * 16 + F.tid);
    __syncthreads();
    {
        unsigned mask = selm[ql]; float mm = -3.0e38f, l = 0.f;
#pragma unroll
        for (int i = 0; i < 16; ++i) ob[i] = 0.f;
        while (mask) { const int j = __builtin_ctz(mask); mask &= mask - 1u;
            const int kend = (t - 64 * j) < 63 ? (t - 64 * j) : 63;
            for (int kk = 0; kk <= kend; ++kk) { const size_t tok = (size_t)(64 * j + kk);
                float k[16], v[16]; ld16bf(pb + tok * NSA_INP + N_KS, k); ld16bf(pb + tok * NSA_INP + N_VS, v);
                float s = 0.f;
#pragma unroll
                for (int i = 0; i < 16; ++i) s += q[i] * k[i];
                s = grp8_sum(s);
                const float mn = fmaxf(mm, s), corr = __expf(mm - mn), p = __expf(s - mn); mm = mn; l = l * corr + p;
#pragma unroll
                for (int i = 0; i < 16; ++i) ob[i] = ob[i] * corr + p * v[i]; } }
        const float inv = gs / l;
#pragma unroll
        for (int i = 0; i < 16; ++i) ot[i] += ob[i] * inv;
    }
    {
        float mm = -3.0e38f, l = 0.f;
#pragma unroll
        for (int i = 0; i < 16; ++i) ob[i] = 0.f;
        const int lo = (t - 511) > 0 ? (t - 511) : 0;
        for (int tk = lo; tk <= t; ++tk) { const size_t tok = (size_t)tk;
            float k[16], v[16]; ld16bf(pb + tok * NSA_INP + N_KW, k); ld16bf(pb + tok * NSA_INP + N_VW, v);
            float s = 0.f;
#pragma unroll
            for (int i = 0; i < 16; ++i) s += q[i] * k[i];
            s = grp8_sum(s);
            const float mn = fmaxf(mm, s), corr = __expf(mm - mn), p = __expf(s - mn); mm = mn; l = l * corr + p;
#pragma unroll
            for (int i = 0; i < 16; ++i) ob[i] = ob[i] * corr + p * v[i]; }
        const float inv = gw / l;
#pragma unroll
        for (int i = 0; i < 16; ++i) ot[i] += ob[i] * inv;
    }
    st16bf(F.mix + m * DM + head * 128 + ds * 16, ot);
    __syncthreads();
}

__device__ __forceinline__ void router_block(Frame& F, int tb, const float* xin, const float* g, const float* modj) {
    LAS int* cntl = (LAS int*)(F.lds);
    if (F.tid < 8) cntl[F.tid] = 0;
    __syncthreads();
    for (int i = 0; i < 4; ++i) {
        const int m = tb * 32 + F.wave * 4 + i; f32x4 y[8];
        normmod_row(xin + (size_t)m * DM, g, modj + (size_t)(m / SEQ) * 6144, F.h + (size_t)m * DM, F.lane, y);
        float lg[8];
#pragma unroll
        for (int e = 0; e < 8; ++e) lg[e] = 0.f;
#pragma unroll
        for (int j = 0; j < 8; ++j) {
#pragma unroll
            for (int q = 0; q < 4; ++q) { const int dcol = 4 * F.lane + 256 * j + q; const f32x4 w0 = *(const f32x4*)(F.router_w + (size_t)dcol * 8), w1 = *(const f32x4*)(F.router_w + (size_t)dcol * 8 + 4);
                const float yv = y[j][q];
                lg[0] += yv * w0.x; lg[1] += yv * w0.y; lg[2] += yv * w0.z; lg[3] += yv * w0.w; lg[4] += yv * w1.x; lg[5] += yv * w1.y; lg[6] += yv * w1.z; lg[7] += yv * w1.w; } }
#pragma unroll
        for (int e = 0; e < 8; ++e) lg[e] = wave_sum(lg[e]);
        if (F.lane == 0) {
            int e0 = 0; float v0 = lg[0];
#pragma unroll
            for (int e = 1; e < 8; ++e) if (lg[e] > v0) { v0 = lg[e]; e0 = e; }
            int e1 = -1; float v1 = -3.0e38f;
#pragma unroll
            for (int e = 0; e < 8; ++e) if (e != e0 && lg[e] > v1) { v1 = lg[e]; e1 = e; }
            const float p1 = 1.f / (1.f + __expf(v0 - v1)), p0 = 1.f - p1;
            int* r = F.route + (size_t)m * 8; r[0] = e0; r[1] = e1; ((float*)r)[2] = p0; ((float*)r)[3] = p1;
            __hip_atomic_fetch_add(&cntl[e0], 1, __ATOMIC_RELAXED, __HIP_MEMORY_SCOPE_WORKGROUP); __hip_atomic_fetch_add(&cntl[e1], 1, __ATOMIC_RELAXED, __HIP_MEMORY_SCOPE_WORKGROUP);
        }
    }
    __syncthreads();
    if (F.tid < 8) __hip_atomic_store(F.ctl + CW_CNT + tb * 8 + F.tid, (unsigned)cntl[F.tid], RLX_AGENT);
    __syncthreads();
}

__device__ __forceinline__ void moe_scatter_block(Frame& F, int tb) {
    LAS int* tot = (LAS int*)(F.lds);
    LAS int* bas = tot + 8;
    LAS int* seg = bas + 8;
    LAS int* re = seg + 16;
    LAS int* dst = re + 64;
    if (F.tid < 16) tot[F.tid] = 0;
    __syncthreads();
    { const int tb2 = F.tid >> 1, e4 = (F.tid & 1) * 4;
#pragma unroll
      for (int q = 0; q < 4; ++q) { const int v = (int)__hip_atomic_load(F.ctl + CW_CNT + tb2 * 8 + e4 + q, RLX_AGENT); __hip_atomic_fetch_add(&tot[e4 + q], v, __ATOMIC_RELAXED, __HIP_MEMORY_SCOPE_WORKGROUP); if (tb2 < tb) __hip_atomic_fetch_add(&bas[e4 + q], v, __ATOMIC_RELAXED, __HIP_MEMORY_SCOPE_WORKGROUP); } }
    if (F.tid < 64) { const int i = F.tid >> 1, k = F.tid & 1; re[F.tid] = F.route[(size_t)(tb * 32 + i) * 8 + k]; }
    __syncthreads();
    if (F.tid == 0) { int s = 0, tcum = 0; for (int e = 0; e < 8; ++e) { seg[e] = s; const int nt = (tot[e] + 255) >> 8; s += nt * 256;
            if (tb == 0) { __hip_atomic_store(F.ctl + CW_TILE + e, (unsigned)tcum, RLX_AGENT); } tcum += nt; }
        seg[8] = s; if (tb == 0) __hip_atomic_store(F.ctl + CW_TILE + 8, (unsigned)tcum, RLX_AGENT); }
    __syncthreads();
    if (F.tid < 64) { const int i = F.tid >> 1, k = F.tid & 1, e = re[F.tid]; int rank = 0;
        for (int q = 0; q < 2 * i; ++q) rank += (re[q] == e) ? 1 : 0;
        const int d = seg[e] + bas[e] + rank; dst[F.tid] = d;
        const size_t m = (size_t)(tb * 32 + i); F.route[m * 8 + 4 + k] = d; F.rowp[d] = ((const float*)F.route)[m * 8 + 2 + k]; }
    __syncthreads();
    for (int r = F.wave; r < 64; r += NWAVES) { const size_t m = (size_t)(tb * 32 + (r >> 1)); const v4u* s = (const v4u*)(F.h + m * DM) + F.lane; v4u* o = (v4u*)(F.hperm + (size_t)dst[r] * DM) + F.lane;
#pragma unroll
        for (int j = 0; j < 4; ++j) o[64 * j] = s[64 * j]; }
    __syncthreads();
}

__device__ __forceinline__ void final_phase(Frame& F, const float* xin, const float* gate) {
    const int gw = F.vcu * NWAVES + F.wave, NGW = F.G * NWAVES;
    for (int m = gw; m < MTOK; m += NGW) {
        const int p0 = F.route[(size_t)m * 8 + 4], p1 = F.route[(size_t)m * 8 + 5];
        const f32x4* xr = (const f32x4*)(xin + (size_t)m * DM) + F.lane; const f32x4* y0 = (const f32x4*)(F.y + (size_t)p0 * DM) + F.lane; const f32x4* y1 = (const f32x4*)(F.y + (size_t)p1 * DM) + F.lane;
        const f32x4* gp = (const f32x4*)(gate + (size_t)(m / SEQ) * 6144) + F.lane; const f32x4* fg = (const f32x4*)F.final_norm_g + F.lane;
        f32x4 v[8]; float ss = 0.f;
#pragma unroll
        for (int j = 0; j < 8; ++j) { v[j] = xr[64 * j] + gp[64 * j] * (y0[64 * j] + y1[64 * j]); ss += (v[j].x * v[j].x + v[j].y * v[j].y) + (v[j].z * v[j].z + v[j].w * v[j].w); }
        const float rs = 1.f / sqrtf(wave_sum(ss) * (1.f / DM) + EPS);
        f32x4* o = (f32x4*)(F.out + (size_t)m * DM) + F.lane;
#pragma unroll
        for (int j = 0; j < 8; ++j) o[64 * j] = (v[j] * rs) * fg[64 * j];
    }
}

struct Args { const float* in[33]; float* out; unsigned char* ws; int ph_lo, ph_hi; };
__global__ void __launch_bounds__(NTHR, 2) mk_fwd(Args args) {
    extern __shared__ __attribute__((aligned(16))) unsigned char lds[];
    Frame F;
    F.lds = (LAS unsigned char*)lds;
    F.MISC = (volatile LAS unsigned*)(F.lds + MISC_OFF);
    F.tid = threadIdx.x; F.lane = F.tid & 63; F.wave = __builtin_amdgcn_readfirstlane(F.tid >> 6);
    F.G = gridDim.x; { const int bx = blockIdx.x; F.vcu = (F.G % 8 == 0) ? (bx % 8) * (F.G / 8) + bx / 8 : bx; }
    unsigned char* ws = args.ws;
    F.ctl = (gu32*)(ws + WS_CTL);
    F.x = args.in[0]; F.c = args.in[1]; F.ada_mix_w = args.in[2]; F.ada_mix_b = args.in[3]; F.norm_mix_g = args.in[4]; F.ada_ffn_w = args.in[5]; F.ada_ffn_b = args.in[6]; F.norm_ffn_g = args.in[7];
    F.even_in_w = args.in[8]; F.rg_conv_w = args.in[9]; F.rg_conv_b = args.in[10]; F.rg_wa = args.in[11]; F.rg_ba = args.in[12]; F.rg_wx = args.in[13]; F.rg_bx = args.in[14]; F.rg_lambda = args.in[15];
    F.even_out_w = args.in[16]; F.dense_w_gate = args.in[17]; F.dense_w_up = args.in[18]; F.dense_w_down = args.in[19]; F.nsa_in_w = args.in[20]; F.cmp_pos_k = args.in[21]; F.cmp_pos_v = args.in[22];
    F.cmp_k_w1 = args.in[23]; F.cmp_k_w2 = args.in[24]; F.cmp_v_w1 = args.in[25]; F.cmp_v_w2 = args.in[26]; F.nsa_out_w = args.in[27]; F.router_w = args.in[28];
    F.moe_w_gate = args.in[29]; F.moe_w_up = args.in[30]; F.moe_w_down = args.in[31]; F.final_norm_g = args.in[32]; F.out = args.out;
    F.Win0 = (bf16*)(ws + WS_WIN0); F.Wout0 = (bf16*)(ws + WS_WOUT0); F.Wgu0 = (bf16*)(ws + WS_WGU0); F.Wdn0 = (bf16*)(ws + WS_WDN0); F.Win1 = (bf16*)(ws + WS_WIN1); F.Wout1 = (bf16*)(ws + WS_WOUT1);
    F.Wmgu = (bf16*)(ws + WS_WMGU); F.Wmdn = (bf16*)(ws + WS_WMDN);
    F.mod = (float*)(ws + WS_MOD); F.xa = (float*)(ws + WS_XA); F.xb = (float*)(ws + WS_XB); F.kcmp = (float*)(ws + WS_KCMP); F.vcmp = (float*)(ws + WS_VCMP);
    F.sumP = (float*)(ws + WS_SUMP); F.sumH = (float*)(ws + WS_SUMH); F.hl = (float*)(ws + WS_HL); F.pc = (float*)(ws + WS_PC); F.y = (float*)(ws + WS_Y); F.rowp = (float*)(ws + WS_ROWP);
    F.route = (int*)(ws + WS_ROUTE);
    F.h = (bf16*)(ws + WS_H); F.proj = (bf16*)(ws + WS_PROJ); F.mix = (bf16*)(ws + WS_MIX); F.act = (bf16*)(ws + WS_ACT); F.hperm = (bf16*)(ws + WS_HPERM);
    for (int u = F.tid; u < (LDS_BYTES - LDSCTL_OFF) / 4; u += NTHR) ((LAS unsigned*)(F.lds + LDSCTL_OFF))[u] = 0u;
    __syncthreads();
    XcdBarrier bar; bar.bar = (unsigned*)(F.ctl + CW_BAR); bar.x = 0; bar.st = nullptr;
    if (N_LAUNCHES == 1) bar = xcd_barrier_post((unsigned*)(F.ctl + CW_BAR), F.MISC + 8);
    const int lo = args.ph_lo, hi = args.ph_hi;
#define IN(k) (lo <= (k) && (k) < hi)
#define SEAM(k) do { if (IN(k) && IN((k) + 1)) xcd_barrier(bar); } while (0)
    const float* mod0 = F.mod; const float* mod1 = F.mod + 4 * 6144; const float* mod2 = F.mod + 8 * 6144; const float* mod3 = F.mod + 12 * 6144;

    if (IN(0)) { p0_adaln(F); p0_convert(F); } SEAM(0);
    if (IN(1)) { normmod_phase(F, F.x, F.norm_mix_g, mod0); } SEAM(1);
    if (IN(2)) { pg8::Gemm g{F.h, F.Win0, MTOK, EVEN_IN, DM}; pg8::StaticOrder S; S.init(MTOK, EVEN_IN, F.G, (int)blockIdx.x);
        pg8::EpiBf16P E{F.proj, EVEN_IN};
        pg8::gemm_phase<pg8::EpiBf16P, pg8::StaticOrder, true, true>(F.lds + RING_OFF, g, S, E); } SEAM(2);
    if (IN(3)) { for (int u = F.vcu; u < 1024; u += F.G) sb_attn_unit(F, u);
        for (int u = F.vcu; u < 2048; u += F.G) rglru_local_unit(F, u); } SEAM(3);
    if (IN(4)) { for (int u = F.vcu; u < 512; u += F.G) rglru_fix_unit(F, u); } SEAM(4);
    if (IN(5)) { pg8::Gemm g{F.mix, F.Wout0, MTOK, DM, DM}; pg8::StaticOrder S; S.init(MTOK, DM, F.G, (int)blockIdx.x);
        pg8::EpiResid E{F.x, F.xa, DM, mod0 + 4096, 6144, SEQ};
        pg8::gemm_phase<pg8::EpiResid, pg8::StaticOrder, false, true>(F.lds + RING_OFF, g, S, E); } SEAM(5);
    if (IN(6)) { normmod_phase(F, F.xa, F.norm_ffn_g, mod1); } SEAM(6);
    if (IN(7)) { pg8::Gemm g{F.h, F.Wgu0, MTOK, 2 * DFF, DM}; pg8::StaticOrder S; S.init(MTOK, 2 * DFF, F.G, (int)blockIdx.x);
        pg8::EpiSwiGLU E{F.act, DFF};
        pg8::gemm_phase<pg8::EpiSwiGLU, pg8::StaticOrder, true, true>(F.lds + RING_OFF, g, S, E); } SEAM(7);
    if (IN(8)) { pg8::Gemm g{F.act, F.Wdn0, MTOK, DM, DFF}; pg8::StaticOrder S; S.init(MTOK, DM, F.G, (int)blockIdx.x);
        pg8::EpiResid E{F.xa, F.xb, DM, mod1 + 4096, 6144, SEQ};
        pg8::gemm_phase<pg8::EpiResid, pg8::StaticOrder, false, true>(F.lds + RING_OFF, g, S, E); } SEAM(8);
    if (IN(9)) { normmod_phase(F, F.xb, F.norm_mix_g + DM, mod2); } SEAM(9);
    if (IN(10)) { pg8::Gemm g{F.h, F.Win1, MTOK, NSA_INP, DM}; pg8::StaticOrder S; S.init(MTOK, NSA_INP, F.G, (int)blockIdx.x);
        pg8::EpiBf16P E{F.proj, NSA_INP};
        pg8::gemm_phase<pg8::EpiBf16P, pg8::StaticOrder, true, true>(F.lds + RING_OFF, g, S, E); } SEAM(10);
    if (IN(11)) { for (int u = F.vcu; u < 512; u += F.G) cmp_unit(F, u); } SEAM(11);
    if (IN(12)) { for (int u = F.vcu; u < 2048; u += F.G) nsa_attn_unit(F, u); } SEAM(12);
    if (IN(13)) { pg8::Gemm g{F.mix, F.Wout1, MTOK, DM, DM}; pg8::StaticOrder S; S.init(MTOK, DM, F.G, (int)blockIdx.x);
        pg8::EpiResid E{F.xb, F.xa, DM, mod2 + 4096, 6144, SEQ};
        pg8::gemm_phase<pg8::EpiResid, pg8::StaticOrder, false, true>(F.lds + RING_OFF, g, S, E); } SEAM(13);
    if (IN(14)) { for (int tb = F.vcu; tb < 256; tb += F.G) router_block(F, tb, F.xa, F.norm_ffn_g + DM, mod3); } SEAM(14);
    if (IN(15)) { for (int tb = F.vcu; tb < 256; tb += F.G) moe_scatter_block(F, tb); } SEAM(15);
    if (IN(16)) { pg8::Gemm g{F.hperm, F.Wmgu, MOE_ROWS, 2 * DFF, DM}; pg8::MoeOrder S;
#pragma unroll
        for (int e = 0; e < 9; ++e) S.tc[e] = __builtin_amdgcn_readfirstlane((int)__hip_atomic_load(F.ctl + CW_TILE + e, RLX_AGENT));
        S.nN = 2 * DFF / 256; S.G = F.G; S.c = (int)blockIdx.x; S.estride = (size_t)2 * DFF * DM * 2;
        pg8::EpiSwiGLU E{F.act, DFF};
        pg8::gemm_phase<pg8::EpiSwiGLU, pg8::MoeOrder, true, true>(F.lds + RING_OFF, g, S, E); } SEAM(16);
    if (IN(17)) { pg8::Gemm g{F.act, F.Wmdn, MOE_ROWS, DM, DFF}; pg8::MoeOrder S;
#pragma unroll
        for (int e = 0; e < 9; ++e) S.tc[e] = __builtin_amdgcn_readfirstlane((int)__hip_atomic_load(F.ctl + CW_TILE + e, RLX_AGENT));
        S.nN = DM / 256; S.G = F.G; S.c = (int)blockIdx.x; S.estride = (size_t)DFF * DM * 2;
        pg8::EpiScaleRow E{F.y, DM, F.rowp};
        pg8::gemm_phase<pg8::EpiScaleRow, pg8::MoeOrder, true, true>(F.lds + RING_OFF, g, S, E); } SEAM(17);
    if (IN(18)) { final_phase(F, F.xa, mod3 + 4096); }
#undef IN
#undef SEAM
}

extern "C" void kernel_launch(void* const* d_in, const int* in_sizes, int n_in, void* d_out, int out_size, void* d_ws, size_t ws_size, hipStream_t stream) {
    static int grid = 0;
    if (grid == 0) {
        if (n_in != 33 || in_sizes[0] != MTOK * DM || out_size != MTOK * DM || ws_size < WS_END) {
            fprintf(stderr, "kernel_launch: built for 33 inputs, x/out of %d floats, >= %zu bytes of workspace; got n_in %d, in0 %d, out %d, ws %zu; nothing launched\n", MTOK * DM, (size_t)WS_END, n_in, n_in > 0 ? in_sizes[0] : -1, out_size, ws_size); grid = -1; return; }
        int dev = 0, cus = 0, per_cu = 0;
        if (hipGetDevice(&dev) != hipSuccess || hipDeviceGetAttribute(&cus, hipDeviceAttributeMultiprocessorCount, dev) != hipSuccess) { fprintf(stderr, "kernel_launch: device query failed\n"); grid = -1; return; }
        if (hipFuncSetAttribute((const void*)mk_fwd, hipFuncAttributeMaxDynamicSharedMemorySize, LDS_BYTES) != hipSuccess) { fprintf(stderr, "kernel_launch: hipFuncSetAttribute failed\n"); grid = -1; return; }
        if (hipOccupancyMaxActiveBlocksPerMultiprocessor(&per_cu, (const void*)mk_fwd, NTHR, LDS_BYTES) != hipSuccess || per_cu < 1)
            fprintf(stderr, "kernel_launch: note: occupancy query reports %d workgroups per CU\n", per_cu);
        (void)hipGetLastError();
        grid = cus;
    }
    if (grid < 0) return;
    if (hipMemsetAsync((char*)d_ws + WS_CTL, 0, CTL_ZERO_BYTES, stream) != hipSuccess) { fprintf(stderr, "kernel_launch: memset failed\n"); return; }
    Args a{};
    for (int i = 0; i < 33; ++i) a.in[i] = (const float*)d_in[i];
    a.out = (float*)d_out; a.ws = (unsigned char*)d_ws;
    for (int li = 0; li < N_LAUNCHES; ++li) {
        a.ph_lo = (N_LAUNCHES == 1) ? 0 : li; a.ph_hi = (N_LAUNCHES == 1) ? NPH : li + 1;
        hipLaunchKernelGGL(mk_fwd, dim3(grid), dim3(NTHR), LDS_BYTES, stream, a);
        const hipError_t le = hipPeekAtLastError();
        if (le != hipSuccess) { fprintf(stderr, "kernel_launch: launch %d failed: %s\n", li, hipGetErrorName(le)); break; }
    }
}
```

```cpp
#include <hip/hip_runtime.h>
#include <cstdio>
#include <cstdint>
namespace pg8 {
#define PG8_LAS __attribute__((address_space(3)))
typedef unsigned short bf16_t;
typedef short bf16x8 __attribute__((ext_vector_type(8)));
typedef float f32x4 __attribute__((ext_vector_type(4)));
typedef unsigned u32x4 __attribute__((ext_vector_type(4)));
typedef int v4i_t __attribute__((ext_vector_type(4)));
constexpr int BM = 256, BK = 64, HALF = 128, HTB = HALF * BK * 2  , STAGE_BYTES = 8 * HTB, NXCD = 8, WGM = 8;

__host__ __device__ __forceinline__ int lds_byte(int r, int c) { const int st = (r >> 4) * 2 + (c >> 5), rr = r & 15, cc = c & 31, ob = rr * 64 + cc * 2; return st * 1024 + (ob ^ (((ob >> 9) & 1) << 5)); }
__host__ __device__ __forceinline__ void stage_rc(int b, int& R, int& C) { const int st = b / 1024, sb = b % 1024, swz = sb ^ (((sb >> 9) & 1) << 5); R = (st >> 1) * 16 + swz / 64; C = (st & 1) * 32 + (swz % 64) / 2; }
__host__ __device__ __forceinline__ int perm32(int rho) { const int n = rho >> 4, i = rho & 15; return 8 * (i >> 2) + 4 * n + (i & 3); }

struct Unit { int pm, pn; size_t boff; unsigned aoff; int nt, part; };
struct Gemm { const bf16_t* A; const bf16_t* Bt; int M, N, K; };

struct StaticOrder {
    static constexpr bool VARK = false;
    int nM, nN, nwg, G, c;
    __host__ __device__ void init(int M, int N, int G_, int c_) { nM = M / BM; nN = N / BM; nwg = nM * nN; G = G_; c = c_; }
    __host__ __device__ bool next(int i, Unit& u) const {
        const long L = (long)i * G + c; if (L >= nwg) return false;
        int wgid = (int)L; { const int q = nwg / NXCD, r = nwg % NXCD, xcd = wgid % NXCD, off = wgid / NXCD; wgid = (xcd < r ? xcd * (q + 1) : r * (q + 1) + (xcd - r) * q) + off; }
        const int nig = WGM * nN, gid = wgid / nig, fm = gid * WGM, gsz = (nM - fm) < WGM ? (nM - fm) : WGM;
        u.pm = fm + ((wgid % nig) % gsz); u.pn = (wgid % nig) / gsz; u.boff = 0; u.aoff = 0; u.nt = 0; u.part = -1; return true;
    }
    __device__ __forceinline__ void a_ready(const Unit&) const {}
    __device__ __forceinline__ void done(const Unit&) const {}
};

__device__ __forceinline__ unsigned cvt_pk_bf16(float lo, float hi) { unsigned r; asm volatile("v_cvt_pk_bf16_f32 %0, %1, %2" : "=v"(r) : "v"(lo), "v"(hi)); return r; }

struct EpiBf16P {
    static constexpr bool PERM = true, AFTER_DRAIN = false;
    bf16_t* O; int ldc;
    __device__ __forceinline__ void operator()(const f32x4 (&acc)[2][2][4][2], const Unit& u, int wr, int wc, int fr, int fq) const {
        const int row0 = u.pm * BM + wr * 64 + fr, col0 = u.pn * BM + wc * 32 + 8 * fq;
#pragma unroll
        for (int ai = 0; ai < 2; ++ai)
#pragma unroll
            for (int m = 0; m < 4; ++m) { bf16_t* rowp = O + (size_t)(row0 + ai * HALF + m * 16) * ldc + col0;
#pragma unroll
                for (int bj = 0; bj < 2; ++bj) { const f32x4 v0 = acc[ai][bj][m][0], v1 = acc[ai][bj][m][1];
                    u32x4 w; w.x = cvt_pk_bf16(v0[0], v0[1]); w.y = cvt_pk_bf16(v0[2], v0[3]); w.z = cvt_pk_bf16(v1[0], v1[1]); w.w = cvt_pk_bf16(v1[2], v1[3]);
                    *(u32x4*)(rowp + bj * HALF) = w; } }
    }
};

struct EpiBf16Pi8 {
    static constexpr bool PERM = true, AFTER_DRAIN = false;
    bf16_t* O; int ldc; const float* rowscale; float wscale;
    __device__ __forceinline__ static float cf(float bits, float s) { return (float)__builtin_bit_cast(int, bits) * s; }
    __device__ __forceinline__ void operator()(const f32x4 (&acc)[2][2][4][2], const Unit& u, int wr, int wc, int fr, int fq) const {
        const int row0 = u.pm * BM + wr * 64 + fr, col0 = u.pn * BM + wc * 32 + 8 * fq;
#pragma unroll
        for (int ai = 0; ai < 2; ++ai)
#pragma unroll
            for (int m = 0; m < 4; ++m) { const int r = row0 + ai * HALF + m * 16; const float s = rowscale[r] * wscale; bf16_t* rowp = O + (size_t)r * ldc + col0;
#pragma unroll
                for (int bj = 0; bj < 2; ++bj) { const f32x4 v0 = acc[ai][bj][m][0], v1 = acc[ai][bj][m][1];
                    u32x4 w; w.x = cvt_pk_bf16(cf(v0[0], s), cf(v0[1], s)); w.y = cvt_pk_bf16(cf(v0[2], s), cf(v0[3], s)); w.z = cvt_pk_bf16(cf(v1[0], s), cf(v1[1], s)); w.w = cvt_pk_bf16(cf(v1[2], s), cf(v1[3], s));
                    *(u32x4*)(rowp + bj * HALF) = w; } }
    }
};

struct EpiResid {
    static constexpr bool PERM = false, AFTER_DRAIN = false;
    const float* xin; float* xout; int ldc; const float* gate; int gpitch; int rows_per_batch; float sc;
    __device__ __forceinline__ void operator()(const f32x4 (&acc)[2][2][4][2], const Unit& u, int wr, int wc, int fr, int fq) const {
        const int row0 = u.pm * BM + wr * 64 + fr, col0 = u.pn * BM + wc * 32 + 4 * fq;
        const float* gp = gate + (size_t)((u.pm * BM) / rows_per_batch) * gpitch + col0;
        f32x4 gv[2][2];
#pragma unroll
        for (int bj = 0; bj < 2; ++bj)
#pragma unroll
            for (int n = 0; n < 2; ++n) gv[bj][n] = *(const f32x4*)(gp + bj * HALF + n * 16) * sc;
#pragma unroll
        for (int ai = 0; ai < 2; ++ai)
#pragma unroll
            for (int m = 0; m < 4; ++m) { const size_t off = (size_t)(row0 + ai * HALF + m * 16) * ldc + col0;
#pragma unroll
                for (int bj = 0; bj < 2; ++bj)
#pragma unroll
                    for (int n = 0; n < 2; ++n) { const f32x4 xi = *(const f32x4*)(xin + off + bj * HALF + n * 16);
                        *(f32x4*)(xout + off + bj * HALF + n * 16) = xi + gv[bj][n] * acc[ai][bj][m][n]; } }
    }
};

struct EpiSwiGLU {
    static constexpr bool PERM = true, AFTER_DRAIN = false;
    bf16_t* O; int ldc; float sc;
    __device__ __forceinline__ float silu_mul(float g, float u) const { g *= sc; u *= sc; return g * u * __builtin_amdgcn_rcpf(1.f + __builtin_amdgcn_exp2f(-1.44269504089f * g)); }
    __device__ __forceinline__ void operator()(const f32x4 (&acc)[2][2][4][2], const Unit& u, int wr, int wc, int fr, int fq) const {
        const int row0 = u.pm * BM + wr * 64 + fr, col0 = u.pn * HALF + wc * 32 + 8 * fq;
#pragma unroll
        for (int ai = 0; ai < 2; ++ai)
#pragma unroll
            for (int m = 0; m < 4; ++m) { bf16_t* rowp = O + (size_t)(row0 + ai * HALF + m * 16) * ldc + col0;
                const f32x4 g0 = acc[ai][0][m][0], g1 = acc[ai][0][m][1], u0 = acc[ai][1][m][0], u1 = acc[ai][1][m][1];
                u32x4 w; w.x = cvt_pk_bf16(silu_mul(g0[0], u0[0]), silu_mul(g0[1], u0[1])); w.y = cvt_pk_bf16(silu_mul(g0[2], u0[2]), silu_mul(g0[3], u0[3]));
                w.z = cvt_pk_bf16(silu_mul(g1[0], u1[0]), silu_mul(g1[1], u1[1])); w.w = cvt_pk_bf16(silu_mul(g1[2], u1[2]), silu_mul(g1[3], u1[3]));
                *(u32x4*)rowp = w; }
    }
};

__device__ __forceinline__ float clamp448(float v) { return __builtin_fminf(__builtin_fmaxf(v, -448.f), 448.f); }
__device__ __forceinline__ unsigned pk4_fp8(float a, float b, float c, float d) { int p = __builtin_amdgcn_cvt_pk_fp8_f32(clamp448(a), clamp448(b), 0, false); p = __builtin_amdgcn_cvt_pk_fp8_f32(clamp448(c), clamp448(d), p, true); return (unsigned)p; }
template <bool OUT8> struct EpiSwiGLUi8 {
    static constexpr bool PERM = true, AFTER_DRAIN = false;
    bf16_t* O; int ldc; const float* rowscale; float wscale;
    __device__ __forceinline__ static float sm(float g, float u) { return g * u * __builtin_amdgcn_rcpf(1.f + __builtin_amdgcn_exp2f(-1.44269504089f * g)); }
    __device__ __forceinline__ static float cf(float bits, float s) { return (float)__builtin_bit_cast(int, bits) * s; }
    __device__ __forceinline__ void operator()(const f32x4 (&acc)[2][2][4][2], const Unit& u, int wr, int wc, int fr, int fq) const {
        const int row0 = u.pm * BM + wr * 64 + fr, col0 = u.pn * HALF + wc * 32 + 8 * fq;
#pragma unroll
        for (int ai = 0; ai < 2; ++ai)
#pragma unroll
            for (int m = 0; m < 4; ++m) { const int r = row0 + ai * HALF + m * 16; const float s = rowscale[r] * wscale;
                const f32x4 g0 = acc[ai][0][m][0], g1 = acc[ai][0][m][1], u0 = acc[ai][1][m][0], u1 = acc[ai][1][m][1];
                const float v0 = sm(cf(g0[0], s), cf(u0[0], s)), v1 = sm(cf(g0[1], s), cf(u0[1], s)), v2 = sm(cf(g0[2], s), cf(u0[2], s)), v3 = sm(cf(g0[3], s), cf(u0[3], s));
                const float v4 = sm(cf(g1[0], s), cf(u1[0], s)), v5 = sm(cf(g1[1], s), cf(u1[1], s)), v6 = sm(cf(g1[2], s), cf(u1[2], s)), v7 = sm(cf(g1[3], s), cf(u1[3], s));
                if constexpr (OUT8) { uint2 w; w.x = pk4_fp8(v0, v1, v2, v3); w.y = pk4_fp8(v4, v5, v6, v7); *(uint2*)((unsigned char*)O + (size_t)r * ldc + col0) = w; }
                else { u32x4 w; w.x = cvt_pk_bf16(v0, v1); w.y = cvt_pk_bf16(v2, v3); w.z = cvt_pk_bf16(v4, v5); w.w = cvt_pk_bf16(v6, v7); *(u32x4*)(O + (size_t)r * ldc + col0) = w; } }
    }
};

struct EpiSwiGLU8 {
    static constexpr bool PERM = true, AFTER_DRAIN = false;
    unsigned char* O; int ldc; float sc;
    __device__ __forceinline__ float sm(float g, float u) const { g *= sc; u *= sc; return g * u * __builtin_amdgcn_rcpf(1.f + __builtin_amdgcn_exp2f(-1.44269504089f * g)); }
    __device__ __forceinline__ void operator()(const f32x4 (&acc)[2][2][4][2], const Unit& u, int wr, int wc, int fr, int fq) const {
        const int row0 = u.pm * BM + wr * 64 + fr, col0 = u.pn * HALF + wc * 32 + 8 * fq;
#pragma unroll
        for (int ai = 0; ai < 2; ++ai)
#pragma unroll
            for (int m = 0; m < 4; ++m) { unsigned char* rowp = O + (size_t)(row0 + ai * HALF + m * 16) * ldc + col0;
                const f32x4 g0 = acc[ai][0][m][0], g1 = acc[ai][0][m][1], u0 = acc[ai][1][m][0], u1 = acc[ai][1][m][1];
                uint2 w; w.x = pk4_fp8(sm(g0[0], u0[0]), sm(g0[1], u0[1]), sm(g0[2], u0[2]), sm(g0[3], u0[3]));
                w.y = pk4_fp8(sm(g1[0], u1[0]), sm(g1[1], u1[1]), sm(g1[2], u1[2]), sm(g1[3], u1[3]));
                *(uint2*)rowp = w; }
    }
};

struct EpiScaleRow {
    static constexpr bool PERM = false, AFTER_DRAIN = false;
    float* C; int ldc; const float* rowscale;
    __device__ __forceinline__ void operator()(const f32x4 (&acc)[2][2][4][2], const Unit& u, int wr, int wc, int fr, int fq) const {
        const int row0 = u.pm * BM + wr * 64 + fr, col0 = u.pn * BM + wc * 32 + 4 * fq;
#pragma unroll
        for (int ai = 0; ai < 2; ++ai)
#pragma unroll
            for (int m = 0; m < 4; ++m) { const int r = row0 + ai * HALF + m * 16; const float s = rowscale[r]; float* rowp = C + (size_t)r * ldc + col0;
#pragma unroll
                for (int bj = 0; bj < 2; ++bj)
#pragma unroll
                    for (int n = 0; n < 2; ++n) *(f32x4*)(rowp + bj * HALF + n * 16) = acc[ai][bj][m][n] * s; }
    }
};

struct EpiScaleRowBf16 {
    static constexpr bool PERM = true, AFTER_DRAIN = false;
    bf16_t* O; int ldc; const float* rowscale;
    __device__ __forceinline__ void operator()(const f32x4 (&acc)[2][2][4][2], const Unit& u, int wr, int wc, int fr, int fq) const {
        const int row0 = u.pm * BM + wr * 64 + fr, col0 = u.pn * BM + wc * 32 + 8 * fq;
#pragma unroll
        for (int ai = 0; ai < 2; ++ai)
#pragma unroll
            for (int m = 0; m < 4; ++m) { const int r = row0 + ai * HALF + m * 16; const float s = rowscale[r]; bf16_t* rowp = O + (size_t)r * ldc + col0;
#pragma unroll
                for (int bj = 0; bj < 2; ++bj) { const f32x4 v0 = acc[ai][bj][m][0] * s, v1 = acc[ai][bj][m][1] * s;
                    u32x4 w; w.x = cvt_pk_bf16(v0[0], v0[1]); w.y = cvt_pk_bf16(v0[2], v0[3]); w.z = cvt_pk_bf16(v1[0], v1[1]); w.w = cvt_pk_bf16(v1[2], v1[3]);
                    *(u32x4*)(rowp + bj * HALF) = w; } }
    }
};

template <size_t OFF_Y, size_t OFF_ROWP, size_t OFF_PART, int LDC> struct EpiMoeDown {
    static constexpr bool PERM = true, AFTER_DRAIN = false;
    unsigned char* ws;
    __device__ __forceinline__ void operator()(const f32x4 (&acc)[2][2][4][2], const Unit& u, int wr, int wc, int fr, int fq) const {
        const int rl0 = wr * 64 + fr, cl0 = wc * 32 + 8 * fq; constexpr int ldc = LDC;
        bf16_t* O = (bf16_t*)(ws + OFF_Y); const float* rowscale = (const float*)(ws + OFF_ROWP); float* part = (float*)(ws + OFF_PART);
        if (u.part < 0) {
#pragma unroll
            for (int ai = 0; ai < 2; ++ai)
#pragma unroll
                for (int m = 0; m < 4; ++m) { const int r = u.pm * BM + rl0 + ai * HALF + m * 16; const float s = rowscale[r]; bf16_t* rowp = O + (size_t)r * ldc + u.pn * BM + cl0;
#pragma unroll
                    for (int bj = 0; bj < 2; ++bj) { const f32x4 v0 = acc[ai][bj][m][0] * s, v1 = acc[ai][bj][m][1] * s;
                        u32x4 w; w.x = cvt_pk_bf16(v0[0], v0[1]); w.y = cvt_pk_bf16(v0[2], v0[3]); w.z = cvt_pk_bf16(v1[0], v1[1]); w.w = cvt_pk_bf16(v1[2], v1[3]);
                        *(u32x4*)(rowp + bj * HALF) = w; } }
        } else {
            float* pb = part + (size_t)u.part * 65536;
#pragma unroll
            for (int ai = 0; ai < 2; ++ai)
#pragma unroll
                for (int m = 0; m < 4; ++m) { const int rl = rl0 + ai * HALF + m * 16; const float s = rowscale[u.pm * BM + rl]; float* rowp = pb + rl * 256 + cl0;
#pragma unroll
                    for (int bj = 0; bj < 2; ++bj) { *(f32x4*)(rowp + bj * HALF) = acc[ai][bj][m][0] * s; *(f32x4*)(rowp + bj * HALF + 4) = acc[ai][bj][m][1] * s; } }
        }
    }
};

__device__ __forceinline__ int moe_unremap(int wgid, int nwg) {
    const int q = nwg / NXCD, r = nwg % NXCD; int xcd, off;
    if (wgid < r * (q + 1)) { xcd = wgid / (q + 1); off = wgid - xcd * (q + 1); } else { const int w = wgid - r * (q + 1); xcd = r + w / q; off = w - (xcd - r) * q; }
    return off * NXCD + xcd;
}
__device__ __forceinline__ void moe_split_plan(int nwg, int G, int ktiles, int& nfull, int& nleft, int& S) {
    nfull = nwg; nleft = 0; S = 1;
    if (G == 256) { const int rounds = nwg / G, rem = nwg - rounds * G;
        if (rounds >= 1 && rem > 0 && rem <= 64) { const int s = (rem <= 36) ? 7 : 4; if (ktiles % (2 * s) == 0) { S = s; nfull = rounds * G; nleft = rem; } } }
}
template <bool SPLIT> struct MoeOrderT {
    static constexpr bool VARK = SPLIT;
    int tc[9]; int nN, G, c; unsigned estride;
    int ntfull, nfull, nleft, S, kslice;
    __device__ __forceinline__ void plan(int ktiles, int kbytes) { ntfull = ktiles; nfull = tc[8] * nN; nleft = 0; S = 1; kslice = 0;
        if (SPLIT) { moe_split_plan(tc[8] * nN, G, ktiles, nfull, nleft, S); kslice = kbytes / S; } }
    __device__ __forceinline__ bool next(int i, Unit& u) const {
        const int nwg = tc[8] * nN; int L = i * G + c; int s = 0, slot = -1;
        if (SPLIT && L >= nfull) { const int t = L - nfull; if (t >= nleft * S) return false; s = t % S; slot = t; L = nfull + t / S; }
        if (L >= nwg) return false;
        int wgid = L; { const int q = nwg / NXCD, r = nwg % NXCD, xcd = wgid % NXCD, off = wgid / NXCD; wgid = (xcd < r ? xcd * (q + 1) : r * (q + 1) + (xcd - r) * q) + off; }
        int e = 0, start = 0, nt = tc[1];
#pragma unroll
        for (int k = 1; k < 8; ++k) { if (wgid >= tc[k] * nN) { e = k; start = tc[k]; nt = tc[k + 1] - tc[k]; } }
        const int r2 = wgid - start * nN;
        u.pn = r2 / nt; u.pm = start + r2 % nt; u.aoff = (unsigned)(s * kslice); u.boff = (size_t)((unsigned)e * estride + (unsigned)(s * kslice)); u.nt = (slot >= 0) ? ntfull / S : ntfull; u.part = slot; return true;
    }
    __device__ __forceinline__ void a_ready(const Unit&) const {}
    __device__ __forceinline__ void done(const Unit&) const {}
};
typedef MoeOrderT<false> MoeOrder;

template <class Epi, class Sched, bool ALIGN_EPI = false, bool SP2 = false, int MODE = 0>
__device__ __forceinline__ void gemm_phase(PG8_LAS unsigned char* lds, const Gemm g, const Sched& S, const Epi& E, const int tid_in) {
    constexpr bool F8 = (MODE == 1);
    const int tid = tid_in, wid = __builtin_amdgcn_readfirstlane(tid >> 6), lane = tid & 63, wr = wid >> 2, wc = wid & 3, fr = lane & 15, fq = lane >> 4;
    const int K = g.K, nt = K / BK;
    unsigned voffA[2], voffB[2];
#pragma unroll
    for (int i = 0; i < 2; ++i) { int R, C; stage_rc(tid * 16 + i * 8192, R, C); const int Rb = Epi::PERM ? ((R & ~31) + perm32(R & 31)) : R;
        voffA[i] = (unsigned)(R * K + C) * 2u; voffB[i] = (unsigned)(Rb * K + C) * 2u; }
    const size_t kstep = (size_t)(BK * 2);
    const size_t hstep = (size_t)HALF * K * 2;
    const size_t tstep = 2 * hstep;
    const unsigned ldsbase = (unsigned)__builtin_amdgcn_readfirstlane((int)((unsigned)(uintptr_t)lds + (unsigned)wid * 1024u));
    const unsigned ldsw = (unsigned)wid * 1024u;
    const int aoff = lds_byte(wr * 64 + fr, fq * 8), boff = lds_byte(wc * 32 + fr, fq * 8);
#define PG8_SA(b, h) (((b) * 2 + (h)) * HTB)
#define PG8_SB(b, h) ((4 + (b) * 2 + (h)) * HTB)
#define PG8_STAGE(bufoff, gbase, voff) do { _Pragma("unroll") for (int _i = 0; _i < 2; ++_i) { \
        if constexpr (F8) { unsigned keep_; asm volatile("s_mov_b32 %0, m0\n\ts_mov_b32 m0, %3\n\ts_nop 0\n\tglobal_load_lds_dwordx4 %1, %2\n\ts_mov_b32 m0, %0" : "=&s"(keep_) : "v"((voff)[_i]), "s"((const char*)(gbase)), "s"(ldsbase + (unsigned)((bufoff) + _i * 8192)) : "memory"); } \
        else __builtin_amdgcn_global_load_lds((const unsigned*)((const char*)(gbase) + (voff)[_i]), (PG8_LAS unsigned*)(lds + (bufoff) + ldsw + _i * 8192), 16, 0, 0); } } while (0)
#define PG8_LDA(dst, b, h) do { _Pragma("unroll") for (int m = 0; m < 4; ++m) _Pragma("unroll") for (int k = 0; k < 2; ++k) dst[m][k] = *(const PG8_LAS bf16x8*)(lds + PG8_SA(b, h) + aoff + m * 2048 + k * 1024); } while (0)
#define PG8_LDB(dst, b, h) do { _Pragma("unroll") for (int n = 0; n < 2; ++n) _Pragma("unroll") for (int k = 0; k < 2; ++k) dst[n][k] = *(const PG8_LAS bf16x8*)(lds + PG8_SB(b, h) + boff + n * 2048 + k * 1024); } while (0)
#define PG8_CAT8(x) __builtin_shufflevector(__builtin_bit_cast(v4i_t, (x)[0]), __builtin_bit_cast(v4i_t, (x)[1]), 0, 1, 2, 3, 4, 5, 6, 7)
#define PG8_MMA(ai, bj, At, Bt) do { __builtin_amdgcn_s_setprio(1); _Pragma("unroll") for (int m = 0; m < 4; ++m) _Pragma("unroll") for (int n = 0; n < 2; ++n) { \
        if constexpr (F8) { acc[ai][bj][m][n] = __builtin_amdgcn_mfma_scale_f32_16x16x128_f8f6f4(PG8_CAT8(Bt[n]), PG8_CAT8(At[m]), acc[ai][bj][m][n], 0, 0, 0, 0x7F7F7F7F, 0, 0x7F7F7F7F); } \
        else if constexpr (MODE == 2) { _Pragma("unroll") for (int k = 0; k < 2; ++k) acc[ai][bj][m][n] = __builtin_bit_cast(f32x4, __builtin_amdgcn_mfma_i32_16x16x64_i8(__builtin_bit_cast(v4i_t, Bt[n][k]), __builtin_bit_cast(v4i_t, At[m][k]), __builtin_bit_cast(v4i_t, acc[ai][bj][m][n]), 0, 0, 0)); } \
        else { _Pragma("unroll") for (int k = 0; k < 2; ++k) acc[ai][bj][m][n] = __builtin_amdgcn_mfma_f32_16x16x32_bf16(Bt[n][k], At[m][k], acc[ai][bj][m][n], 0, 0, 0); } } __builtin_amdgcn_s_setprio(0); } while (0)
#define PG8_WAIT_V(n) asm volatile("s_waitcnt vmcnt(" #n ")" ::: "memory")
#define PG8_WAIT_L(n) asm volatile("s_waitcnt lgkmcnt(" #n ")" ::: "memory")
#define PG8_BAR __builtin_amdgcn_s_barrier()
#define PG8_SCHED __builtin_amdgcn_sched_barrier(0)
    Unit cur, nxt; int ui = 0;
    if (!S.next(0, cur)) return;
    f32x4 acc[2][2][4][2];
#pragma unroll
    for (int a = 0; a < 2; ++a)
#pragma unroll
        for (int b = 0; b < 2; ++b)
#pragma unroll
            for (int m = 0; m < 4; ++m)
#pragma unroll
                for (int n = 0; n < 2; ++n) acc[a][b][m][n] = (f32x4){0.f, 0.f, 0.f, 0.f};
    bf16x8 At[4][2], B0[2][2], B1[2][2];
    int ntc = nt; if constexpr (Sched::VARK) ntc = cur.nt;
    const char* cA = (const char*)g.A + (size_t)cur.pm * tstep + (Sched::VARK ? cur.aoff : 0u); const char* cB = (const char*)g.Bt + (size_t)cur.pn * tstep + cur.boff;
    S.a_ready(cur);
    if constexpr (SP2) {
        PG8_STAGE(PG8_SB(0, 0), cB, voffB); PG8_STAGE(PG8_SB(0, 1), cB + hstep, voffB); PG8_STAGE(PG8_SA(0, 0), cA, voffA); PG8_STAGE(PG8_SA(0, 1), cA + hstep, voffA);
        if (wr == 1) PG8_BAR;
        PG8_WAIT_V(2); PG8_BAR;
        PG8_STAGE(PG8_SB(1, 0), cB + kstep, voffB); PG8_STAGE(PG8_SA(1, 0), cA + kstep, voffA); PG8_STAGE(PG8_SB(1, 1), cB + hstep + kstep, voffB);
        PG8_WAIT_V(6); PG8_BAR;
    } else {
        PG8_STAGE(PG8_SB(0, 0), cB, voffB); PG8_STAGE(PG8_SA(0, 0), cA, voffA); PG8_STAGE(PG8_SB(0, 1), cB + hstep, voffB); PG8_STAGE(PG8_SA(0, 1), cA + hstep, voffA);
        if (wr == 1) PG8_BAR;
        PG8_WAIT_V(4); PG8_BAR;
        PG8_STAGE(PG8_SB(1, 0), cB + kstep, voffB); PG8_STAGE(PG8_SA(1, 0), cA + kstep, voffA); PG8_STAGE(PG8_SB(1, 1), cB + hstep + kstep, voffB);
        PG8_WAIT_V(6); PG8_BAR;
    }
    for (;;) {
        const bool has_next = S.next(ui + 1, nxt);
        const char* nA = has_next ? (const char*)g.A + (size_t)nxt.pm * tstep + (Sched::VARK ? nxt.aoff : 0u) : cA; const char* nB = has_next ? (const char*)g.Bt + (size_t)nxt.pn * tstep + nxt.boff : cB;
        for (int t = 0; t < ntc; t += 2) {
            const bool last = (t == ntc - 2);
            const char* a1 = cA + (size_t)(t + 1) * kstep;
            const char* a2 = last ? nA : cA + (size_t)(t + 2) * kstep; const char* b2 = last ? nB : cB + (size_t)(t + 2) * kstep;
            const char* a3 = a2 + kstep; const char* b3 = b2 + kstep;
            if (last && has_next) S.a_ready(nxt);
            if constexpr (SP2) {
            PG8_LDB(B0, 0, 0); PG8_LDB(B1, 0, 1); PG8_SCHED; PG8_LDA(At, 0, 0); PG8_STAGE(PG8_SA(1, 1), a1 + hstep, voffA);
            PG8_WAIT_V(8); PG8_WAIT_L(0); PG8_BAR; PG8_MMA(0, 0, At, B0); PG8_MMA(0, 1, At, B1); PG8_BAR; PG8_SCHED;
            PG8_LDA(At, 0, 1); PG8_STAGE(PG8_SB(0, 0), b2, voffB); PG8_STAGE(PG8_SB(0, 1), b2 + hstep, voffB); PG8_STAGE(PG8_SA(0, 0), a2, voffA);
            PG8_WAIT_V(8); PG8_WAIT_L(0); PG8_BAR; PG8_MMA(1, 0, At, B0); PG8_MMA(1, 1, At, B1); PG8_BAR; PG8_SCHED;
            PG8_LDB(B0, 1, 0); PG8_LDB(B1, 1, 1); PG8_SCHED; PG8_LDA(At, 1, 0); PG8_STAGE(PG8_SA(0, 1), a2 + hstep, voffA);
            PG8_WAIT_V(8); PG8_WAIT_L(0); PG8_BAR; PG8_MMA(0, 0, At, B0); PG8_MMA(0, 1, At, B1); PG8_BAR; PG8_SCHED;
            PG8_LDA(At, 1, 1); PG8_STAGE(PG8_SB(1, 0), b3, voffB); PG8_STAGE(PG8_SB(1, 1), b3 + hstep, voffB); PG8_STAGE(PG8_SA(1, 0), a3, voffA);
            PG8_WAIT_V(8); PG8_WAIT_L(0); PG8_BAR; PG8_MMA(1, 0, At, B0); PG8_MMA(1, 1, At, B1); PG8_BAR; PG8_SCHED;
            } else {
            PG8_LDB(B0, 0, 0); PG8_SCHED; PG8_LDA(At, 0, 0); PG8_STAGE(PG8_SA(1, 1), a1 + hstep, voffA);
            PG8_WAIT_L(8); PG8_BAR; PG8_WAIT_L(0); PG8_MMA(0, 0, At, B0); PG8_BAR; PG8_SCHED;
            PG8_LDB(B1, 0, 1); PG8_STAGE(PG8_SB(0, 0), b2, voffB);
            PG8_BAR; PG8_WAIT_L(0); PG8_MMA(0, 1, At, B1); PG8_BAR;
            PG8_LDA(At, 0, 1); PG8_STAGE(PG8_SA(0, 0), a2, voffA);
            PG8_BAR; PG8_WAIT_L(0); PG8_MMA(1, 0, At, B0); PG8_BAR; PG8_SCHED;
            PG8_STAGE(PG8_SB(0, 1), b2 + hstep, voffB);
            PG8_WAIT_V(6); PG8_BAR; PG8_MMA(1, 1, At, B1); PG8_BAR;
            PG8_LDB(B0, 1, 0); PG8_SCHED; PG8_LDA(At, 1, 0); PG8_STAGE(PG8_SA(0, 1), a2 + hstep, voffA);
            PG8_WAIT_L(8); PG8_BAR; PG8_WAIT_L(0); PG8_MMA(0, 0, At, B0); PG8_BAR; PG8_SCHED;
            PG8_LDB(B1, 1, 1); PG8_STAGE(PG8_SB(1, 0), b3, voffB);
            PG8_BAR; PG8_WAIT_L(0); PG8_MMA(0, 1, At, B1); PG8_BAR;
            PG8_LDA(At, 1, 1); PG8_STAGE(PG8_SA(1, 0), a3, voffA);
            PG8_BAR; PG8_WAIT_L(0); PG8_MMA(1, 0, At, B0); PG8_BAR; PG8_SCHED;
            PG8_STAGE(PG8_SB(1, 1), b3 + hstep, voffB);
            PG8_WAIT_V(6); PG8_BAR; PG8_MMA(1, 1, At, B1); PG8_BAR;
            }
        }
        if constexpr (ALIGN_EPI) { if (wr == 0) PG8_BAR; }
        if constexpr (!Epi::AFTER_DRAIN) { int t2_ = tid; asm volatile("" : "+v"(t2_)); const int l2_ = t2_ & 63;
            E(acc, cur, wr, wc, l2_ & 15, l2_ >> 4); S.done(cur); }
        if (!has_next) break;
#pragma unroll
        for (int a = 0; a < 2; ++a)
#pragma unroll
            for (int b = 0; b < 2; ++b)
#pragma unroll
                for (int m = 0; m < 4; ++m)
#pragma unroll
                    for (int n = 0; n < 2; ++n) acc[a][b][m][n] = (f32x4){0.f, 0.f, 0.f, 0.f};
        cur = nxt; cA = nA; cB = nB; ++ui; if constexpr (Sched::VARK) ntc = cur.nt;
        if constexpr (ALIGN_EPI) { if (wr == 1) PG8_BAR; }
    }
    PG8_WAIT_V(0);
    if constexpr (!ALIGN_EPI) { if (wr == 0) PG8_BAR; }
    PG8_BAR;
    if constexpr (Epi::AFTER_DRAIN) { E.fused(acc, cur, wr, wc, fr, fq, lds, wid, lane); S.done(cur); }
#undef PG8_SA
#undef PG8_SB
#undef PG8_STAGE
#undef PG8_LDA
#undef PG8_LDB
#undef PG8_MMA
#undef PG8_CAT8
#undef PG8_WAIT_V
#undef PG8_WAIT_L
#undef PG8_BAR
#undef PG8_SCHED
}
}
#define GAS __attribute__((address_space(1)))
#define LAS __attribute__((address_space(3)))
typedef unsigned short bf16;
typedef unsigned v4u __attribute__((ext_vector_type(4)));
typedef float f32x4 __attribute__((ext_vector_type(4)));
typedef short bf16x8 __attribute__((ext_vector_type(8)));
typedef GAS unsigned gu32;
typedef GAS unsigned long long gu64;
#define RLX_AGENT __ATOMIC_RELAXED, __HIP_MEMORY_SCOPE_AGENT
#define LDS_WAIT() asm volatile("s_waitcnt lgkmcnt(0)" ::: "memory")
#define VM_WAIT() asm volatile("s_waitcnt vmcnt(0)" ::: "memory")
__device__ __forceinline__ unsigned long long rt() { return __builtin_amdgcn_s_memrealtime(); }
__device__ __forceinline__ unsigned f2bf(float f) { unsigned u = __builtin_bit_cast(unsigned, f); return (u + 0x7fffu + ((u >> 16) & 1u)) >> 16; }
__device__ __forceinline__ unsigned pk2(float lo, float hi) { return f2bf(lo) | (f2bf(hi) << 16); }

#define XB_TMO      128
#define XB_XCNT(j)  (256  + 64 * (j))
#define XB_XSUB(j)  (1280 + 64 * (j))
#define XB_XGEN(j)  (2304 + 64 * (j))
#define XB_TOP      3328
#define XB_TOPGEN   3392
#define XCD_BAR_WORDS 3456
#define XB_SPIN_CAP (1u << 18)

__device__ __forceinline__ unsigned xb_ld(unsigned* p)              { return __hip_atomic_load(p, __ATOMIC_RELAXED, __HIP_MEMORY_SCOPE_AGENT); }
__device__ __forceinline__ unsigned xb_add(unsigned* p, unsigned v) { return __hip_atomic_fetch_add(p, v, __ATOMIC_RELAXED, __HIP_MEMORY_SCOPE_AGENT); }
__device__ __forceinline__ unsigned xb_xcc_id() { return (unsigned)__builtin_amdgcn_s_getreg((3 << 11) | 20) & 0xFu; }
#define XB_SPIN(cond, bar) do { unsigned _sp = 0; while (cond) { __builtin_amdgcn_s_sleep(1); \
    if ((++_sp & 255u) == 0u) { if (xb_ld(&(bar)[XB_TMO])) break; if (_sp > XB_SPIN_CAP) { atomicAdd(&(bar)[XB_TMO], 1u); break; } } } } while (0)

struct XcdBarrier {
    unsigned* bar; unsigned x;
    volatile LAS unsigned* st;
};

__device__ __forceinline__ XcdBarrier xcd_barrier_post(unsigned* bar, volatile LAS unsigned* st, const int xb_tid) {
    XcdBarrier b; b.bar = bar; b.x = xb_xcc_id(); b.st = st;
    if (xb_tid == 0) (void)xb_add(&bar[XB_XCNT(b.x)], 1u);
    return b;
}
__device__ __forceinline__ void xcd_barrier_complete(unsigned* bar, unsigned x, unsigned& nloc, unsigned& nx) {
    const unsigned G = gridDim.x * gridDim.y * gridDim.z;
    unsigned sum, cnt, mine, sp = 0u;
    for (;;) {
        sum = 0u; cnt = 0u; mine = 0u;
#pragma unroll
        for (unsigned j = 0; j < 16; ++j) { const unsigned c = xb_ld(&bar[XB_XCNT(j)]); sum += c; cnt += (c > 0u) ? 1u : 0u; mine = (j == x) ? c : mine; }
        if (sum == G) break;
        __builtin_amdgcn_s_sleep(1);
        if ((++sp & 255u) == 0u) { if (xb_ld(&bar[XB_TMO])) break; if (sp > XB_SPIN_CAP) { atomicAdd(&bar[XB_TMO], 1u); break; } }
    }
    nloc = mine > 0u ? mine : 1u; nx = cnt > 0u ? cnt : 1u;
}

__device__ __forceinline__ void xcd_barrier(const XcdBarrier& b, const int xb_tid) {
    asm volatile("s_waitcnt vmcnt(0)" ::: "memory");
    __syncthreads();
    if (xb_tid == 0) {
        unsigned* bar = b.bar;
        __builtin_amdgcn_s_waitcnt(0);
        unsigned nloc = b.st[0], nx = b.st[1];
        if (nloc == 0u) { xcd_barrier_complete(bar, b.x, nloc, nx); b.st[0] = nloc; b.st[1] = nx; }
        const unsigned old = xb_add(&bar[XB_XSUB(b.x)], 1u);
        const unsigned gen = old / nloc;
        if (old + 1u == (gen + 1u) * nloc) {
            __builtin_amdgcn_fence(__ATOMIC_RELEASE, "agent");
            asm volatile("s_waitcnt vmcnt(0)" ::: "memory");
            const unsigned og = xb_add(&bar[XB_TOP], 1u);
            const unsigned tg = og / nx;
            if (og + 1u == (tg + 1u) * nx) xb_add(&bar[XB_TOPGEN], 1u);
            else XB_SPIN(xb_ld(&bar[XB_TOPGEN]) == tg, bar);
            __builtin_amdgcn_fence(__ATOMIC_ACQUIRE, "agent");
            xb_add(&bar[XB_XGEN(b.x)], 1u);
            asm volatile("s_waitcnt vmcnt(0)" ::: "memory");
        } else {
            XB_SPIN(xb_ld(&bar[XB_XGEN(b.x)]) == gen, bar);
            __builtin_amdgcn_fence(__ATOMIC_ACQUIRE, "agent");
            asm volatile("s_waitcnt vmcnt(0)" ::: "memory");
        }
    }
    __syncthreads();
}


constexpr int NWAVES = 8, NTHR = 512;
constexpr int BATCH = 4, SEQ = 2048, DM = 2048, MTOK = BATCH * SEQ;
constexpr int EVEN_IN = 5120, NSA_IN = 5168, NSA_INP = 5376, DFF = 7168, NEXP = 8, MOE_ROWS = 18432;
constexpr int NCMP = 127;
constexpr float EPS = 1e-6f, QSCALE = 0.08838834764831845f;
constexpr int E_Q = 0, E_K = 1024, E_V = 2048, E_XR = 3072, E_GR = 4096;
constexpr int N_Q = 0, N_KC = 2048, N_VC = 2560, N_KS = 3072, N_VS = 3584, N_KW = 4096, N_VW = 4608, N_G = 5120;
#ifndef MK_N_LAUNCHES
#define MK_N_LAUNCHES 1
#endif
constexpr int NPH = 19;
constexpr int N_LAUNCHES = MK_N_LAUNCHES;

constexpr size_t MiB = 1u << 20;
constexpr size_t WS_CTL = 0, CTL_ZERO_BYTES = 1 * MiB;
constexpr size_t WS_MOD = 1 * MiB;
constexpr size_t WS_ROUTE = 2 * MiB;
constexpr size_t WS_ROWP = 2 * MiB + 512 * 1024;
constexpr size_t WS_KCMP = 3 * MiB, WS_VCMP = 4 * MiB;
constexpr size_t WS_KCMPB = 6 * MiB, WS_VCMPB = 6 * MiB + 512 * 1024;
constexpr size_t WS_WC1K = 149 * MiB, WS_WC1V = 7 * MiB, WS_WC2K = 2 * MiB + 768 * 1024, WS_WC2V = WS_WC2K + 32768, WS_CMPPB = WS_WC2V + 32768;
constexpr size_t WS_ROWSA = 2 * MiB + 896 * 1024;
constexpr size_t WS_SUMP = 5 * MiB, WS_SUMH = 5 * MiB + 512 * 1024;
constexpr size_t WS_WIN0 = 8 * MiB, WS_WOUT0 = 28 * MiB, WS_WGU0 = 36 * MiB, WS_WDN0 = 92 * MiB, WS_WIN1 = 120 * MiB, WS_WOUT1 = 141 * MiB;
constexpr size_t WS_WMGU = 150 * MiB, WS_WMDN = 598 * MiB;
constexpr size_t WS_XA = 822 * MiB, WS_XB = 886 * MiB, WS_H = 950 * MiB, WS_PROJ = 982 * MiB, WS_MIX = 1066 * MiB;
constexpr size_t WS_ACT = 1098 * MiB, WS_HPERM = 1350 * MiB, WS_Y = 1422 * MiB, WS_PART = 1566 * MiB  , WS_END = 1632 * MiB;
constexpr size_t WS_HL = WS_ACT, WS_PC = WS_ACT + 32 * MiB;
constexpr int CW_TMO = 0, CW_CODE = 1, CW_BAR = 4096, CW_CNT = 8192  , CW_TILE = 12288  , CW_WMAX = 12352  ;

constexpr int RING_OFF = 0, RING_BYTES = 131072;
constexpr int LDSCTL_OFF = 147456 - 448, MISC_OFF = LDSCTL_OFF + 320;
constexpr int LDS_BYTES = 147456;

struct Frame {
    LAS unsigned char* lds;
    volatile LAS unsigned* MISC;
    gu32* ctl;
    int tid, lane, wave;
    int vcu, G;
    const float *x, *c, *ada_mix_w, *ada_mix_b, *norm_mix_g, *ada_ffn_w, *ada_ffn_b, *norm_ffn_g;
    const float *even_in_w, *rg_conv_w, *rg_conv_b, *rg_wa, *rg_ba, *rg_wx, *rg_bx, *rg_lambda, *even_out_w;
    const float *dense_w_gate, *dense_w_up, *dense_w_down, *nsa_in_w, *cmp_pos_k, *cmp_pos_v, *cmp_k_w1, *cmp_k_w2, *cmp_v_w1, *cmp_v_w2;
    const float *nsa_out_w, *router_w, *moe_w_gate, *moe_w_up, *moe_w_down, *final_norm_g;
    float* out;
    bf16 *Win0, *Wout0, *Wgu0, *Wdn0, *Win1, *Wout1, *Wmgu, *Wmdn;
    float *mod, *xa, *xb, *kcmp, *vcmp, *sumP, *sumH, *hl, *pc, *y, *rowp;
    int* route;
    bf16 *h, *proj, *mix, *act, *hperm, *kcmpb, *vcmpb, *Wc1k, *Wc1v, *Wc2k, *Wc2v;
    float* cmp_pb; float* rowsa; float* part;
};

__device__ __forceinline__ float wave_sum(float v) {
#pragma unroll
    for (int o = 1; o < 64; o <<= 1) v += __shfl_xor(v, o);
    return v;
}
__device__ __forceinline__ float grp8_sum(float v) { v += __shfl_xor(v, 1); v += __shfl_xor(v, 2); v += __shfl_xor(v, 4); return v; }
__device__ __forceinline__ float bflo(unsigned u) { return __builtin_bit_cast(float, u << 16); }
__device__ __forceinline__ float bfhi(unsigned u) { return __builtin_bit_cast(float, u & 0xffff0000u); }
__device__ __forceinline__ float bf1(bf16 u) { return __builtin_bit_cast(float, ((unsigned)u) << 16); }
__device__ __forceinline__ void ld16bf(const bf16* p, float (&o)[16]) {
    const v4u a = *(const v4u*)p, b = *(const v4u*)(p + 8);
    o[0] = bflo(a.x); o[1] = bfhi(a.x); o[2] = bflo(a.y); o[3] = bfhi(a.y); o[4] = bflo(a.z); o[5] = bfhi(a.z); o[6] = bflo(a.w); o[7] = bfhi(a.w);
    o[8] = bflo(b.x); o[9] = bfhi(b.x); o[10] = bflo(b.y); o[11] = bfhi(b.y); o[12] = bflo(b.z); o[13] = bfhi(b.z); o[14] = bflo(b.w); o[15] = bfhi(b.w);
}
__device__ __forceinline__ void st16bf(bf16* p, const float (&o)[16]) {
    v4u a, b; a.x = pk2(o[0], o[1]); a.y = pk2(o[2], o[3]); a.z = pk2(o[4], o[5]); a.w = pk2(o[6], o[7]);
    b.x = pk2(o[8], o[9]); b.y = pk2(o[10], o[11]); b.z = pk2(o[12], o[13]); b.w = pk2(o[14], o[15]);
    *(v4u*)p = a; *(v4u*)(p + 8) = b;
}
__device__ __forceinline__ float sigmoidf_(float v) { return 1.f / (1.f + __expf(-v)); }
__device__ __forceinline__ float logsigf_(float z) { return fminf(z, 0.f) - __logf(1.f + __expf(-fabsf(z))); }
__device__ __forceinline__ float gelu_tanh(float v) { const float u = 0.7978845608028654f * (v + 0.044715f * v * v * v); const float t = 1.f - 2.f / (1.f + __expf(2.f * u)); return 0.5f * v * (1.f + t); }

__device__ __forceinline__ void p0_adaln(Frame& F) {
    LAS float* sc = (LAS float*)(F.lds);
    LAS float* red = (LAS float*)(F.lds + 32768);
    __syncthreads();
    for (int i = F.tid; i < BATCH * DM; i += NTHR) { const float v = F.c[i]; sc[i] = v / (1.f + __expf(-v)); }
    __syncthreads();
    for (int u = F.vcu; u < 768; u += F.G) {
        const int j = u / 192, cb = u % 192;
        const float* W = ((j & 1) ? F.ada_ffn_w : F.ada_mix_w) + (size_t)(j >> 1) * DM * 6144;
        const float* Bv = ((j & 1) ? F.ada_ffn_b : F.ada_mix_b) + (size_t)(j >> 1) * 6144;
        const int r = F.lane >> 3, cx = (F.lane & 7) * 4;
        float acc[4][4];
#pragma unroll
        for (int b = 0; b < 4; ++b)
#pragma unroll
            for (int q = 0; q < 4; ++q) acc[b][q] = 0.f;
        const int kbase = F.wave * 256;
#pragma unroll 8
        for (int i = 0; i < 32; ++i) {
            const int k = kbase + 8 * i + r;
            const f32x4 w = *(const f32x4*)(W + (size_t)k * 6144 + cb * 32 + cx);
#pragma unroll
            for (int b = 0; b < 4; ++b) { const float s = sc[b * DM + k]; acc[b][0] += s * w.x; acc[b][1] += s * w.y; acc[b][2] += s * w.z; acc[b][3] += s * w.w; }
        }
#pragma unroll
        for (int b = 0; b < 4; ++b)
#pragma unroll
            for (int q = 0; q < 4; ++q) { float v = acc[b][q]; v += __shfl_xor(v, 8); v += __shfl_xor(v, 16); v += __shfl_xor(v, 32); acc[b][q] = v; }
        if (F.lane < 8) {
#pragma unroll
            for (int b = 0; b < 4; ++b)
#pragma unroll
                for (int q = 0; q < 4; ++q) red[(F.wave * 4 + b) * 32 + cx + q] = acc[b][q];
        }
        __syncthreads();
        if (F.tid < 128) { const int b = F.tid >> 5, col = F.tid & 31; float s = 0.f;
#pragma unroll
            for (int w = 0; w < 8; ++w) s += red[(w * 4 + b) * 32 + col];
            F.mod[(size_t)(j * 4 + b) * 6144 + cb * 32 + col] = s + Bv[cb * 32 + col]; }
        __syncthreads();
    }
}

struct CvtDesc { const float* src; unsigned char* dst; int N, K, n0, mode, f8; float qs; };
#ifndef FP8_DUP
#define FP8_DUP 0
#endif
#ifndef FP8_P13
#define FP8_P13 0
#endif
#ifndef I8_P2
#define I8_P2 0
#endif
#ifndef I8_P10
#define I8_P10 1
#endif
#ifndef I8_DUP
#define I8_DUP 1
#endif
#ifndef FP8_DDN
#define FP8_DDN 1
#endif
#ifndef FP8_MOE
#define FP8_MOE 1
#endif
constexpr float W8_PRESCALE = 64.f, W8_INV = 1.f / 64.f;
constexpr int CVT_NMAT = 10;
__device__ __forceinline__ bool cvt_decode(const Frame& F, int it, CvtDesc& d) {
    constexpr int C0 = 2560, C1 = C0 + 1024, C2 = C1 + 3584, C3 = C2 + 3584, C4 = C3 + 3584, C5 = C4 + 2592, C6 = C5 + 1024, C7 = C6 + 128, C8 = C7 + 128, C9 = C8 + 4, C10 = C9 + 4, C11 = C10 + 28672, C12 = C11 + 28672, C13 = C12 + 28672;
    if (it >= C13) return false;
    const float* src; bf16* dst; int K, N, mode = 0, r, f8 = 0; size_t dstb = 0;
    if (it < C0) { src = F.even_in_w; dst = F.Win0; K = DM; N = EVEN_IN; r = it; f8 = I8_P2 ? 2 : 0; }
    else if (it < C1) { src = F.even_out_w; dst = F.Wout0; K = DM; N = DM; r = it - C0; }
    else if (it < C2) { src = F.dense_w_gate; dst = F.Wgu0; f8 = I8_DUP ? 2 : FP8_DUP; K = DM; N = DFF; mode = 1; r = it - C1; }
    else if (it < C3) { src = F.dense_w_up; dst = F.Wgu0; f8 = I8_DUP ? 2 : FP8_DUP; K = DM; N = DFF; mode = 2; r = it - C2; }
    else if (it < C4) { src = F.dense_w_down; dst = F.Wdn0; f8 = FP8_DDN; K = DFF; N = DM; r = it - C3; }
    else if (it < C5) { src = F.nsa_in_w; dst = F.Win1; K = DM; N = NSA_IN; r = it - C4; f8 = I8_P10 ? 2 : 0; }
    else if (it < C6) { src = F.nsa_out_w; dst = F.Wout1; K = DM; N = DM; r = it - C5; f8 = FP8_P13; }
    else if (it < C7) { src = F.cmp_k_w1; dst = F.Wc1k; K = 2048; N = 128; r = it - C6; dstb = (size_t)128 * 2048; }
    else if (it < C8) { src = F.cmp_v_w1; dst = F.Wc1v; K = 2048; N = 128; r = it - C7; dstb = (size_t)128 * 2048; }
    else if (it < C9) { src = F.cmp_k_w2; dst = F.Wc2k; K = 128; N = 128; r = it - C8; }
    else if (it < C10) { src = F.cmp_v_w2; dst = F.Wc2v; K = 128; N = 128; r = it - C9; }
    else if (it < C11) { src = F.moe_w_gate; dst = F.Wmgu; f8 = FP8_MOE; K = DM; N = DFF; mode = 1; r = it - C10; dstb = (size_t)2 * DFF * DM; }
    else if (it < C12) { src = F.moe_w_up; dst = F.Wmgu; f8 = FP8_MOE; K = DM; N = DFF; mode = 2; r = it - C11; dstb = (size_t)2 * DFF * DM; }
    else { src = F.moe_w_down; dst = F.Wmdn; f8 = FP8_MOE; K = DFF; N = DM; r = it - C12; dstb = (size_t)DFF * DM; }
    const int nblk = (N + 63) >> 6, ipb = (K >> 6) * nblk;
    const int nkb = K >> 6; const int e = r / ipb, r2 = r - e * ipb, nb = r2 / nkb, kb = r2 - nb * nkb;
    d.N = N; d.K = K; d.n0 = nb * 64; d.mode = mode; d.f8 = f8; d.qs = 0.f;
    d.src = src + (size_t)e * K * N + (size_t)(kb * 64) * N + nb * 64;
    d.dst = (unsigned char*)dst + ((size_t)e * dstb + kb * 64) * (f8 ? 1 : 2);
    return true;
}
__device__ __forceinline__ void cvt_load(const CvtDesc& d, int lane, f32x4 (&v)[16]) {
    const int r = lane >> 4, cx = (lane & 15) * 4; const bool ok = (d.n0 + cx) < d.N;
#pragma unroll
    for (int i = 0; i < 16; ++i) v[i] = ok ? __builtin_nontemporal_load((const f32x4*)(d.src + (size_t)(4 * i + r) * d.N + cx)) : (f32x4){0.f, 0.f, 0.f, 0.f};
#ifdef CVT_PROBE_LD
    asm volatile("" ::: "memory");
#pragma unroll
    for (int i = 0; i < 16; ++i) { const f32x4 w = ok ? __builtin_nontemporal_load((const f32x4*)(d.src + (size_t)(4 * i + r) * d.N + cx)) : (f32x4){0.f, 0.f, 0.f, 0.f}; v[i] = (v[i] + w) * 0.5f; }
#endif
}
__device__ __forceinline__ void cvt_store(const CvtDesc& d, int lane, const f32x4 (&v)[16], LAS float* scr) {
    const int r = lane >> 4, cx = (lane & 15) * 4;
#pragma unroll
    for (int i = 0; i < 16; ++i) { LAS float* p = scr + (4 * i + r) * 65 + cx; p[0] = v[i].x; p[1] = v[i].y; p[2] = v[i].z; p[3] = v[i].w; }
    LDS_WAIT(); asm volatile("" ::: "memory");
#ifdef CVT_PROBE_LDS
    for (int rep = 0; rep < 2; ++rep) {
#pragma unroll
    for (int i = 0; i < 16; ++i) { LAS float* p = scr + (4 * i + r) * 65 + cx; p[0] = v[i].x; p[1] = v[i].y; p[2] = v[i].z; p[3] = v[i].w; }
    LDS_WAIT(); asm volatile("" ::: "memory"); }
#endif
    if (d.f8 == 2) {
        const int c = lane & 3; const float qs = d.qs;
#define Q8(v) (__builtin_amdgcn_fmed3f(__builtin_rintf((v) * qs), -127.f, 127.f))
#define PK8(a, b, c2, d2) (((unsigned)(int)Q8(a) & 255u) | (((unsigned)(int)Q8(b) & 255u) << 8) | (((unsigned)(int)Q8(c2) & 255u) << 16) | (((unsigned)(int)Q8(d2)) << 24))
#pragma unroll
        for (int j = 0; j < 4; ++j) { const int nl = (lane >> 2) + 16 * j, n = d.n0 + nl; const LAS float* s = scr + (16 * c) * 65 + nl;
            v4u o; o.x = PK8(s[0 * 65], s[1 * 65], s[2 * 65], s[3 * 65]); o.y = PK8(s[4 * 65], s[5 * 65], s[6 * 65], s[7 * 65]);
            o.z = PK8(s[8 * 65], s[9 * 65], s[10 * 65], s[11 * 65]); o.w = PK8(s[12 * 65], s[13 * 65], s[14 * 65], s[15 * 65]);
            const int row = d.mode == 0 ? n : ((n >> 7) * 256 + (n & 127) + (d.mode == 2 ? 128 : 0));
            if (n < d.N) *(v4u*)(d.dst + (size_t)row * d.K + 16 * c) = o; }
#undef PK8
#undef Q8
    } else if (d.f8) {
        const int c = lane & 3;
#pragma unroll
        for (int j = 0; j < 4; ++j) { const int nl = (lane >> 2) + 16 * j, n = d.n0 + nl; const LAS float* s = scr + (16 * c) * 65 + nl;
            v4u o; o.x = pg8::pk4_fp8(W8_PRESCALE * s[0 * 65], W8_PRESCALE * s[1 * 65], W8_PRESCALE * s[2 * 65], W8_PRESCALE * s[3 * 65]);
            o.y = pg8::pk4_fp8(W8_PRESCALE * s[4 * 65], W8_PRESCALE * s[5 * 65], W8_PRESCALE * s[6 * 65], W8_PRESCALE * s[7 * 65]);
            o.z = pg8::pk4_fp8(W8_PRESCALE * s[8 * 65], W8_PRESCALE * s[9 * 65], W8_PRESCALE * s[10 * 65], W8_PRESCALE * s[11 * 65]);
            o.w = pg8::pk4_fp8(W8_PRESCALE * s[12 * 65], W8_PRESCALE * s[13 * 65], W8_PRESCALE * s[14 * 65], W8_PRESCALE * s[15 * 65]);
            const int row = d.mode == 0 ? n : ((n >> 7) * 256 + (n & 127) + (d.mode == 2 ? 128 : 0));
            if (n < d.N) *(v4u*)(d.dst + (size_t)row * d.K + 16 * c) = o; }
    } else {
    const int c = lane & 7;
#pragma unroll
    for (int j = 0; j < 8; ++j) { const int nl = (lane >> 3) + 8 * j, n = d.n0 + nl; const LAS float* s = scr + (8 * c) * 65 + nl;
        v4u o; o.x = pg8::cvt_pk_bf16(s[0 * 65], s[1 * 65]); o.y = pg8::cvt_pk_bf16(s[2 * 65], s[3 * 65]); o.z = pg8::cvt_pk_bf16(s[4 * 65], s[5 * 65]); o.w = pg8::cvt_pk_bf16(s[6 * 65], s[7 * 65]);
        const int row = d.mode == 0 ? n : ((n >> 7) * 256 + (n & 127) + (d.mode == 2 ? 128 : 0));
        if (n < d.N) *(v4u*)(d.dst + ((size_t)row * d.K + 8 * c) * 2) = o; }
    }
    LDS_WAIT(); asm volatile("" ::: "memory");
}
constexpr int CVT_TOTAL = 103968 + 264;
#ifndef MOE_SPLIT
#define MOE_SPLIT 0
#endif
#ifndef CVT_LATE
#define CVT_LATE 1
#endif
constexpr int LATE_P2 = CVT_LATE ? 10 * 128 * 8 : 0, LATE_P10 = CVT_LATE ? 4 * 96 * 8 : 0, LATE_P11 = CVT_LATE ? 8 * 96 * 8 : 0, LATE_ALL = LATE_P2 + LATE_P10 + LATE_P11;
struct CvtSeg { int n0, b0, n1, b1, b2, nv; };
__device__ __forceinline__ int cvt_real(const CvtSeg& s, int v) { return v < s.n0 ? s.b0 + v : (v < s.n0 + s.n1 ? s.b1 + (v - s.n0) : s.b2 + (v - s.n0 - s.n1)); }
__device__ __forceinline__ void p0_convert(Frame& F, const CvtSeg sg, const float qs, const int gw_in = -1, const int ngw_in = 0) {
    LAS float* scr = (LAS float*)(F.lds + F.wave * 16640);
    const int gw = gw_in >= 0 ? gw_in : (int)blockIdx.x * NWAVES + F.wave, NGW = gw_in >= 0 ? ngw_in : F.G * NWAVES;
    CvtDesc dA, dB; f32x4 vA[16], vB[16];
#define CVT_DEC(V, D) (((V) < sg.nv) && cvt_decode(F, cvt_real(sg, (V)), D) && ((D).qs = qs, true))
    int it = gw; bool okA = CVT_DEC(it, dA);
    if (okA) cvt_load(dA, F.lane, vA);
    while (okA) {
        const bool okB = CVT_DEC(it + NGW, dB);
        if (okB) cvt_load(dB, F.lane, vB);
        cvt_store(dA, F.lane, vA, scr);
        if (!okB) break;
        okA = CVT_DEC(it + 2 * NGW, dA);
        if (okA) cvt_load(dA, F.lane, vA);
        cvt_store(dB, F.lane, vB, scr);
        it += 2 * NGW;
    }
#undef CVT_DEC
}
__device__ __forceinline__ void p0_zero_pad(Frame& F) {
    const int gt = F.vcu * NTHR + F.tid; constexpr int ESZ = I8_P10 ? 1 : 2;
    v4u* z = (v4u*)((unsigned char*)F.Win1 + (size_t)NSA_IN * DM * ESZ); const int nz = (NSA_INP - NSA_IN) * DM * ESZ / 16;
    for (int i = gt; i < nz; i += F.G * NTHR) z[i] = (v4u){0u, 0u, 0u, 0u};
}
__device__ __forceinline__ void p0_absmax(Frame& F, const float* pa, const float* pb, const int n4, const int word) {
    const int gt = (int)blockIdx.x * NTHR + F.tid, NT = F.G * NTHR;
    const f32x4* a = (const f32x4*)pa; const f32x4* b = (const f32x4*)pb; float m = 0.f;
#pragma unroll 4
    for (int i = gt; i < n4; i += NT) { const f32x4 x = a[i], y = b[i];
        m = fmaxf(m, fmaxf(fmaxf(fabsf(x.x), fabsf(x.y)), fmaxf(fabsf(x.z), fabsf(x.w)))); m = fmaxf(m, fmaxf(fmaxf(fabsf(y.x), fabsf(y.y)), fmaxf(fabsf(y.z), fabsf(y.w)))); }
#pragma unroll
    for (int o = 1; o < 64; o <<= 1) m = fmaxf(m, __shfl_xor(m, o));
    if (F.lane == 0) __hip_atomic_fetch_max(F.ctl + word, __builtin_bit_cast(unsigned, m), __ATOMIC_RELAXED, __HIP_MEMORY_SCOPE_AGENT);
}

template <int OM> __device__ __forceinline__ void normmod_row(const float* xrow, const float* g, const float* modb, bf16* orow, int lane, f32x4 (&y)[8], float* rowsa = nullptr) {
    const f32x4* xr = (const f32x4*)xrow + lane; float ss = 0.f;
#pragma unroll
    for (int j = 0; j < 8; ++j) { y[j] = xr[64 * j]; ss += (y[j].x * y[j].x + y[j].y * y[j].y) + (y[j].z * y[j].z + y[j].w * y[j].w); }
    const float rs = 1.f / sqrtf(wave_sum(ss) * (1.f / DM) + EPS);
    const f32x4* gp = (const f32x4*)g + lane; const f32x4* sh = (const f32x4*)modb + lane; const f32x4* scl = (const f32x4*)(modb + DM) + lane;
    unsigned long long* o8 = (unsigned long long*)orow + lane;
#pragma unroll
    for (int j = 0; j < 8; ++j) { const f32x4 gg = gp[64 * j], s = sh[64 * j], c = scl[64 * j];
        y[j] = (y[j] * rs) * gg * (c + 1.f) + s;
        if constexpr (OM == 1) ((unsigned*)orow + lane)[64 * j] = pg8::pk4_fp8(y[j].x, y[j].y, y[j].z, y[j].w);
        else if constexpr (OM == 0) o8[64 * j] = (unsigned long long)pk2(y[j].x, y[j].y) | ((unsigned long long)pk2(y[j].z, y[j].w) << 32); }
    if constexpr (OM == 2) {
        float am = 0.f;
#pragma unroll
        for (int j = 0; j < 8; ++j) am = fmaxf(am, fmaxf(fmaxf(fabsf(y[j].x), fabsf(y[j].y)), fmaxf(fabsf(y[j].z), fabsf(y[j].w))));
#pragma unroll
        for (int o = 1; o < 64; o <<= 1) am = fmaxf(am, __shfl_xor(am, o));
        const float q = (am > 0.f) ? 127.f / am : 0.f;
        if (lane == 0) *rowsa = (am > 0.f) ? am * (1.f / 127.f) : 1.f;
#pragma unroll
        for (int j = 0; j < 8; ++j) { const int a = (int)__builtin_rintf(y[j].x * q), b = (int)__builtin_rintf(y[j].y * q), c = (int)__builtin_rintf(y[j].z * q), d = (int)__builtin_rintf(y[j].w * q);
            ((unsigned*)orow + lane)[64 * j] = ((unsigned)a & 255u) | (((unsigned)b & 255u) << 8) | (((unsigned)c & 255u) << 16) | ((unsigned)d << 24); }
    }
}
template <int OM> __device__ __forceinline__ void normmod_phase(Frame& F, const float* xin, const float* g, const float* modj) {
    const int gw = (int)blockIdx.x * NWAVES + F.wave, NGW = F.G * NWAVES;
    for (int m = gw; m < MTOK; m += NGW) { f32x4 y[8]; normmod_row<OM>(xin + (size_t)m * DM, g, modj + (size_t)(m / SEQ) * 6144, (bf16*)((unsigned char*)F.h + (size_t)m * DM * (OM ? 1 : 2)), F.lane, y, F.rowsa + m); }
}

__device__ __forceinline__ void rglru_local_unit(Frame& F, int unit) {
    const int nb = unit & 15, ck = (unit >> 4) & 31, b = unit >> 9;
    LAS float* xin = (LAS float*)(F.lds);
    LAS float* xc = xin + 67 * 64;
    LAS float* wa = xc + 64 * 64;
    LAS float* wx = wa + 64 * 64;
    LAS float* segP = wx + 64 * 64;
    LAS float* segH = segP + 8 * 64;
    const int t0 = ck * 64, ch0 = nb * 64;
    for (int i = F.tid; i < 67 * 8; i += NTHR) { const int r = i >> 3, c8 = (i & 7) * 8, t = t0 - 3 + r;
        v4u v = (v4u){0u, 0u, 0u, 0u}; if (t >= 0) v = *(const v4u*)(F.proj + (size_t)(b * SEQ + t) * EVEN_IN + E_XR + ch0 + c8);
        LAS float* xp = xin + r * 64 + c8; xp[0] = bflo(v.x); xp[1] = bfhi(v.x); xp[2] = bflo(v.y); xp[3] = bfhi(v.y); xp[4] = bflo(v.z); xp[5] = bfhi(v.z); xp[6] = bflo(v.w); xp[7] = bfhi(v.w); }
    for (int i = F.tid; i < 1024; i += NTHR) { *(LAS f32x4*)(wa + 4 * i) = *(const f32x4*)(F.rg_wa + (size_t)nb * 4096 + 4 * i); *(LAS f32x4*)(wx + 4 * i) = *(const f32x4*)(F.rg_wx + (size_t)nb * 4096 + 4 * i); }
    { const int cc = F.tid & 63, chc = ch0 + cc;
      const float cw0 = F.rg_conv_w[0 * 1024 + chc], cw1 = F.rg_conv_w[1 * 1024 + chc], cw2 = F.rg_conv_w[2 * 1024 + chc], cw3 = F.rg_conv_w[3 * 1024 + chc], cbb = F.rg_conv_b[chc];
      __syncthreads();
      for (int i = F.tid; i < 64 * 64; i += NTHR) { const int tt = i >> 6;
          xc[i] = cw0 * xin[(tt + 0) * 64 + cc] + cw1 * xin[(tt + 1) * 64 + cc] + cw2 * xin[(tt + 2) * 64 + cc] + cw3 * xin[(tt + 3) * 64 + cc] + cbb; } }
    __syncthreads();
    const int d = F.tid & 63, tq = F.tid >> 6, ch = ch0 + d;
    float aa[8], ax[8];
#pragma unroll
    for (int i = 0; i < 8; ++i) { aa[i] = 0.f; ax[i] = 0.f; }
    for (int cc = 0; cc < 64; ++cc) { const float wac = wa[cc * 64 + d], wxc = wx[cc * 64 + d];
#pragma unroll
        for (int i = 0; i < 8; ++i) { const float xv = xc[(tq * 8 + i) * 64 + cc]; aa[i] += xv * wac; ax[i] += xv * wxc; } }
    const float ba = F.rg_ba[ch], bx = F.rg_bx[ch], lsl = logsigf_(F.rg_lambda[ch]);
    float hloc[8], pl[8]; float hprev = 0.f, pprev = 1.f;
#pragma unroll
    for (int i = 0; i < 8; ++i) {
        const float r = sigmoidf_(aa[i] + ba), ig = sigmoidf_(ax[i] + bx);
        const float la = 8.f * r * lsl, a = __expf(la);
        const float u = sqrtf(fmaxf(1.f - a * a, 0.f)) * (ig * xc[(tq * 8 + i) * 64 + d]);
        hprev = a * hprev + u; pprev = pprev * a; hloc[i] = hprev; pl[i] = pprev;
    }
    segP[tq * 64 + d] = pprev; segH[tq * 64 + d] = hprev;
    __syncthreads();
    float carry = 0.f, pp = 1.f;
    for (int s = 0; s < tq; ++s) { const float sp = segP[s * 64 + d]; carry = sp * carry + segH[s * 64 + d]; pp *= sp; }
#pragma unroll
    for (int i = 0; i < 8; ++i) { const size_t m = (size_t)(b * SEQ + t0 + tq * 8 + i);
        const float hv = hloc[i] + pl[i] * carry, pv = pl[i] * pp;
        F.hl[m * 1024 + ch] = hv; F.pc[m * 1024 + ch] = pv;
        if (tq == 7 && i == 7) { F.sumP[(size_t)(b * 32 + ck) * 1024 + ch] = pv; F.sumH[(size_t)(b * 32 + ck) * 1024 + ch] = hv; } }
    __syncthreads();
}

__device__ __forceinline__ void rglru_fix_unit(Frame& F, int unit) {
    const int cg = unit & 3, ck = (unit >> 2) & 31, b = unit >> 7;
    const int ch = cg * 256 + (F.tid & 255), th = F.tid >> 8;
    float carry = 0.f;
#pragma unroll 8
    for (int s = 0; s < ck; ++s) carry = F.sumP[(size_t)(b * 32 + s) * 1024 + ch] * carry + F.sumH[(size_t)(b * 32 + s) * 1024 + ch];
#pragma unroll 8
    for (int i = 0; i < 32; ++i) { const size_t m = (size_t)(b * SEQ + ck * 64 + th * 32 + i);
        const float hv = F.hl[m * 1024 + ch] + F.pc[m * 1024 + ch] * carry;
        const float gr = bf1(F.proj[m * EVEN_IN + E_GR + ch]);
        F.mix[m * DM + 1024 + ch] = (bf16)f2bf(hv * gelu_tanh(gr)); }
}

__device__ __forceinline__ unsigned nsa_select(const LAS float* imp, int t) {
    const int cur = t >> 6;
    unsigned mask = 1u | (1u << cur); if (cur >= 1) mask |= 1u << (cur - 1);
    int need = 8 - __builtin_popcount(mask);
    const unsigned valid = (cur >= 31) ? 0xffffffffu : ((2u << cur) - 1u);
    float v[32];
#pragma unroll
    for (int j = 0; j < 32; j += 4) { const f32x4 q = *(const LAS f32x4*)(imp + j); v[j] = q.x; v[j + 1] = q.y; v[j + 2] = q.z; v[j + 3] = q.w; }
    for (; need > 0; --need) {
        const unsigned cand = valid & ~mask; if (!cand) break;
        float best = -1.f; int bi = 0;
#pragma unroll
        for (int j = 0; j < 32; ++j) { const bool better = ((cand >> j) & 1u) && (v[j] > best); best = better ? v[j] : best; bi = better ? j : bi; }
        mask |= 1u << bi;
    }
    return mask;
}
__device__ __forceinline__ void router_block(Frame& F, int tb, const float* xin, const float* g, const float* modj) {
    LAS int* cntl = (LAS int*)(F.lds);
    if (F.tid < 8) cntl[F.tid] = 0;
    __syncthreads();
    for (int i = 0; i < 4; ++i) {
        const int m = tb * 32 + F.wave * 4 + i; f32x4 y[8];
        normmod_row<(FP8_MOE ? 1 : 0)>(xin + (size_t)m * DM, g, modj + (size_t)(m / SEQ) * 6144, (bf16*)((unsigned char*)F.h + (size_t)m * DM * (FP8_MOE ? 1 : 2)), F.lane, y);
        float lg[8];
#pragma unroll
        for (int e = 0; e < 8; ++e) lg[e] = 0.f;
#pragma unroll
        for (int j = 0; j < 8; ++j) {
#pragma unroll
            for (int q = 0; q < 4; ++q) { const int dcol = 4 * F.lane + 256 * j + q; const f32x4 w0 = *(const f32x4*)(F.router_w + (size_t)dcol * 8), w1 = *(const f32x4*)(F.router_w + (size_t)dcol * 8 + 4);
                const float yv = y[j][q];
                lg[0] += yv * w0.x; lg[1] += yv * w0.y; lg[2] += yv * w0.z; lg[3] += yv * w0.w; lg[4] += yv * w1.x; lg[5] += yv * w1.y; lg[6] += yv * w1.z; lg[7] += yv * w1.w; } }
#pragma unroll
        for (int e = 0; e < 8; ++e) lg[e] = wave_sum(lg[e]);
        if (F.lane == 0) {
            int e0 = 0; float v0 = lg[0];
#pragma unroll
            for (int e = 1; e < 8; ++e) if (lg[e] > v0) { v0 = lg[e]; e0 = e; }
            int e1 = -1; float v1 = -3.0e38f;
#pragma unroll
            for (int e = 0; e < 8; ++e) if (e != e0 && lg[e] > v1) { v1 = lg[e]; e1 = e; }
            const float p1 = 1.f / (1.f + __expf(v0 - v1)), p0 = 1.f - p1;
            int* r = F.route + (size_t)m * 8; r[0] = e0; r[1] = e1; ((float*)r)[2] = p0; ((float*)r)[3] = p1;
            __hip_atomic_fetch_add(&cntl[e0], 1, __ATOMIC_RELAXED, __HIP_MEMORY_SCOPE_WORKGROUP); __hip_atomic_fetch_add(&cntl[e1], 1, __ATOMIC_RELAXED, __HIP_MEMORY_SCOPE_WORKGROUP);
        }
    }
    __syncthreads();
    if (F.tid < 8) __hip_atomic_store(F.ctl + CW_CNT + tb * 8 + F.tid, (unsigned)cntl[F.tid], RLX_AGENT);
    __syncthreads();
}

__device__ __forceinline__ void moe_scatter_block(Frame& F, int tb) {
    LAS int* tot = (LAS int*)(F.lds);
    LAS int* bas = tot + 8;
    LAS int* seg = bas + 8;
    LAS int* re = seg + 16;
    LAS int* dst = re + 64;
    if (F.tid < 16) tot[F.tid] = 0;
    __syncthreads();
    { const int tb2 = F.tid >> 1, e4 = (F.tid & 1) * 4;
#pragma unroll
      for (int q = 0; q < 4; ++q) { const int v = (int)__hip_atomic_load(F.ctl + CW_CNT + tb2 * 8 + e4 + q, RLX_AGENT); __hip_atomic_fetch_add(&tot[e4 + q], v, __ATOMIC_RELAXED, __HIP_MEMORY_SCOPE_WORKGROUP); if (tb2 < tb) __hip_atomic_fetch_add(&bas[e4 + q], v, __ATOMIC_RELAXED, __HIP_MEMORY_SCOPE_WORKGROUP); } }
    if (F.tid < 64) { const int i = F.tid >> 1, k = F.tid & 1; re[F.tid] = F.route[(size_t)(tb * 32 + i) * 8 + k]; }
    __syncthreads();
    if (F.tid == 0) { int s = 0, tcum = 0; for (int e = 0; e < 8; ++e) { seg[e] = s; const int nt = (tot[e] + 255) >> 8; s += nt * 256;
            if (tb == 0) { __hip_atomic_store(F.ctl + CW_TILE + e, (unsigned)tcum, RLX_AGENT); } tcum += nt; }
        seg[8] = s; if (tb == 0) __hip_atomic_store(F.ctl + CW_TILE + 8, (unsigned)tcum, RLX_AGENT); }
    __syncthreads();
    if (F.tid < 64) { const int i = F.tid >> 1, k = F.tid & 1, e = re[F.tid]; int rank = 0;
        for (int q = 0; q < 2 * i; ++q) rank += (re[q] == e) ? 1 : 0;
        const int d = seg[e] + bas[e] + rank; dst[F.tid] = d;
        const size_t m = (size_t)(tb * 32 + i); F.route[m * 8 + 4 + k] = d; F.rowp[d] = ((const float*)F.route)[m * 8 + 2 + k] * (FP8_MOE ? W8_INV : 1.f); }
    __syncthreads();
    constexpr int RB = DM * (FP8_MOE ? 1 : 2);
    for (int r = F.wave; r < 64; r += NWAVES) { const size_t m = (size_t)(tb * 32 + (r >> 1)); const v4u* s = (const v4u*)((const unsigned char*)F.h + m * RB) + F.lane; v4u* o = (v4u*)((unsigned char*)F.hperm + (size_t)dst[r] * RB) + F.lane;
#pragma unroll
        for (int j = 0; j < RB / 1024; ++j) o[64 * j] = s[64 * j]; }
    __syncthreads();
}

__device__ __forceinline__ f32x4 moe_y4(const Frame& F, int p, int e, int j, int lane, int nwg, int nfull, int S) {
    if (nfull < nwg) {
        const int tce = (int)__hip_atomic_load(F.ctl + CW_TILE + e, RLX_AGENT), tce1 = (int)__hip_atomic_load(F.ctl + CW_TILE + e + 1, RLX_AGENT);
        const int wgid = tce * 8 + j * (tce1 - tce) + ((p >> 8) - tce), L = pg8::moe_unremap(wgid, nwg);
        if (L >= nfull) { const float* pp = F.part + (size_t)((L - nfull) * S) * 65536 + (p & 255) * 256 + 4 * lane; f32x4 a = *(const f32x4*)pp;
            for (int s = 1; s < S; ++s) a += *(const f32x4*)(pp + (size_t)s * 65536);
            return a; }
    }
    const uint2 a = ((const uint2*)((const bf16*)F.y + (size_t)p * DM) + lane)[64 * j];
    return (f32x4){bflo(a.x), bfhi(a.x), bflo(a.y), bfhi(a.y)};
}
__device__ __forceinline__ void final_phase(Frame& F, const float* xin, const float* gate) {
    const int gw = (int)blockIdx.x * NWAVES + F.wave, NGW = F.G * NWAVES;
    const int nwg = (int)__hip_atomic_load(F.ctl + CW_TILE + 8, RLX_AGENT) * 8; int nfull = nwg, nleft = 0, S = 1;
    if (MOE_SPLIT) pg8::moe_split_plan(nwg, F.G, DFF / 128, nfull, nleft, S);
    for (int m = gw; m < MTOK; m += NGW) {
        const int e0 = F.route[(size_t)m * 8 + 0], e1 = F.route[(size_t)m * 8 + 1], p0 = F.route[(size_t)m * 8 + 4], p1 = F.route[(size_t)m * 8 + 5];
        const f32x4* xr = (const f32x4*)(xin + (size_t)m * DM) + F.lane;
        const f32x4* gp = (const f32x4*)(gate + (size_t)(m / SEQ) * 6144) + F.lane; const f32x4* fg = (const f32x4*)F.final_norm_g + F.lane;
        f32x4 v[8]; float ss = 0.f;
#pragma unroll
        for (int j = 0; j < 8; ++j) { const f32x4 ys = moe_y4(F, p0, e0, j, F.lane, nwg, nfull, S) + moe_y4(F, p1, e1, j, F.lane, nwg, nfull, S);
            v[j] = xr[64 * j] + gp[64 * j] * ys; ss += (v[j].x * v[j].x + v[j].y * v[j].y) + (v[j].z * v[j].z + v[j].w * v[j].w); }
        const float rs = 1.f / sqrtf(wave_sum(ss) * (1.f / DM) + EPS);
        f32x4* o = (f32x4*)(F.out + (size_t)m * DM) + F.lane;
#pragma unroll
        for (int j = 0; j < 8; ++j) o[64 * j] = (v[j] * rs) * fg[64 * j];
    }
}

typedef short s16x4 __attribute__((ext_vector_type(4)));
typedef float f32x16 __attribute__((ext_vector_type(16)));
#define KSWZ(row, colB) ((row) * 256 + ((colB) ^ (((row) & 7) << 4)))
#define SBAR() __builtin_amdgcn_sched_barrier(0)
__device__ __forceinline__ int crow(int r, int hi) { return (r & 3) + 8 * (r >> 2) + 4 * hi; }
__device__ __forceinline__ constexpr int crow0(int r) { return (r & 3) + 8 * (r >> 2); }
__device__ __forceinline__ unsigned cvtpk(float lo, float hi) { unsigned r; asm volatile("v_cvt_pk_bf16_f32 %0, %1, %2" : "=v"(r) : "v"(lo), "v"(hi)); return r; }
__device__ __forceinline__ float xhalf_max(float v) { auto rr = __builtin_amdgcn_permlane32_swap(__float_as_uint(v), __float_as_uint(v), false, false); return fmaxf(__uint_as_float(rr[0]), __uint_as_float(rr[1])); }
__device__ __forceinline__ float xhalf_sum(float v) { auto rr = __builtin_amdgcn_permlane32_swap(__float_as_uint(v), __float_as_uint(v), false, false); return __uint_as_float(rr[0]) + __uint_as_float(rr[1]); }
__device__ __forceinline__ float xhalf_other(float v, int hi) { auto rr = __builtin_amdgcn_permlane32_swap(__float_as_uint(v), __float_as_uint(v), false, false); return hi ? __uint_as_float(rr[0]) : __uint_as_float(rr[1]); }
template <class T> __device__ __forceinline__ T* launder(T* p) { asm volatile("" : "+v"(p)); return p; }
template <int OFF> __device__ __forceinline__ void kread4(bf16x8 (&b)[4], unsigned a0, unsigned a1) {
    asm volatile("ds_read_b128 %0, %4 offset:%6\n\tds_read_b128 %1, %4 offset:%7\n\tds_read_b128 %2, %5 offset:%6\n\tds_read_b128 %3, %5 offset:%7\n\ts_waitcnt lgkmcnt(0)"
                 : "=&v"(b[0]), "=&v"(b[1]), "=&v"(b[2]), "=&v"(b[3]) : "v"(a0), "v"(a1), "i"(OFF), "i"(OFF + 8192) : "memory");
}
__device__ __forceinline__ void qkt(f32x16& p0, f32x16& p1, const LAS char* Ks, const bf16x8 (&qr)[8], int r32, int hi) {
    p0 = f32x16{}; p1 = f32x16{};
    const int x = (r32 & 7) << 4; const unsigned rb = (unsigned)(uintptr_t)Ks + r32 * 256 + ((hi * 16) ^ (x & 16));
    const unsigned a0 = rb + ((0 * 32) ^ (x & 96)), a1 = rb + ((1 * 32) ^ (x & 96)), a2 = rb + ((2 * 32) ^ (x & 96)), a3 = rb + ((3 * 32) ^ (x & 96));
    bf16x8 b[4];
#define QK_STEP(RD, QA, QB) RD; p0 = __builtin_amdgcn_mfma_f32_32x32x16_bf16(b[0], qr[QA], p0, 0, 0, 0); p1 = __builtin_amdgcn_mfma_f32_32x32x16_bf16(b[1], qr[QA], p1, 0, 0, 0); \
    p0 = __builtin_amdgcn_mfma_f32_32x32x16_bf16(b[2], qr[QB], p0, 0, 0, 0); p1 = __builtin_amdgcn_mfma_f32_32x32x16_bf16(b[3], qr[QB], p1, 0, 0, 0);
    QK_STEP(kread4<0>(b, a0, a1), 0, 1) QK_STEP(kread4<0>(b, a2, a3), 2, 3) QK_STEP(kread4<128>(b, a0, a1), 4, 5) QK_STEP(kread4<128>(b, a2, a3), 6, 7)
#undef QK_STEP
}
__device__ __forceinline__ int v_st(int k, int c) { const int kk = (k & ~0xC) | ((k & 4) << 1) | ((k & 8) >> 1); return ((kk >> 3) * 4 + (c >> 5)) * 512 + ((kk & 7) * 32 + (c & 31)) * 2; }
__device__ __forceinline__ int v_rd_base(int lane) { return ((lane & 3) << 3) | (((lane >> 2) & 3) << 6) | (((lane >> 4) & 1) << 5) | (((lane >> 5) & 1) << 8); }
constexpr int v_rd_off(int d0, int ks, int half) { return d0 * 512 + ks * 4096 + half * 2048; }
template <int OFF> __device__ __forceinline__ s16x4 tr_read(int vb) { s16x4 r; asm volatile("ds_read_b64_tr_b16 %0, %1 offset:%2" : "=&v"(r) : "v"(vb), "i"(OFF) : "memory"); return r; }
template <int D0> __device__ __forceinline__ void pv_one(f32x16& od, int vb, bf16x8 pa0, bf16x8 pa1, bf16x8 pa2, bf16x8 pa3) {
    const s16x4 l0 = tr_read<v_rd_off(D0, 0, 0)>(vb), h0 = tr_read<v_rd_off(D0, 0, 1)>(vb), l1 = tr_read<v_rd_off(D0, 1, 0)>(vb), h1 = tr_read<v_rd_off(D0, 1, 1)>(vb);
    const s16x4 l2 = tr_read<v_rd_off(D0, 2, 0)>(vb), h2 = tr_read<v_rd_off(D0, 2, 1)>(vb), l3 = tr_read<v_rd_off(D0, 3, 0)>(vb), h3 = tr_read<v_rd_off(D0, 3, 1)>(vb);
    asm volatile("s_waitcnt lgkmcnt(0)" ::: "memory"); SBAR();
#define PKV(L, H) (bf16x8){L[0], L[1], L[2], L[3], H[0], H[1], H[2], H[3]}
    od = __builtin_amdgcn_mfma_f32_32x32x16_bf16(pa0, PKV(l0, h0), od, 0, 0, 0);
    od = __builtin_amdgcn_mfma_f32_32x32x16_bf16(pa1, PKV(l1, h1), od, 0, 0, 0);
    od = __builtin_amdgcn_mfma_f32_32x32x16_bf16(pa2, PKV(l2, h2), od, 0, 0, 0);
    od = __builtin_amdgcn_mfma_f32_32x32x16_bf16(pa3, PKV(l3, h3), od, 0, 0, 0);
#undef PKV
}
__device__ __forceinline__ void pv_d0(f32x16 (&o)[4], int vb, bf16x8 pa0, bf16x8 pa1, bf16x8 pa2, bf16x8 pa3) {
    pv_one<0>(o[0], vb, pa0, pa1, pa2, pa3); pv_one<1>(o[1], vb, pa0, pa1, pa2, pa3); pv_one<2>(o[2], vb, pa0, pa1, pa2, pa3); pv_one<3>(o[3], vb, pa0, pa1, pa2, pa3);
}
__device__ __forceinline__ void pack_p(const f32x16& p0, const f32x16& p1, bf16x8& pa0, bf16x8& pa1, bf16x8& pa2, bf16x8& pa3) {
#define PK4(P, BASE, OUT) do { unsigned a0 = cvtpk(P[BASE + 0], P[BASE + 1]), a1 = cvtpk(P[BASE + 2], P[BASE + 3]);   \
    unsigned b0 = cvtpk(P[BASE + 4], P[BASE + 5]), b1 = cvtpk(P[BASE + 6], P[BASE + 7]);                              \
    auto r0 = __builtin_amdgcn_permlane32_swap(a0, b0, false, false); auto r1 = __builtin_amdgcn_permlane32_swap(a1, b1, false, false); \
    v4u w = {r0[0], r1[0], r0[1], r1[1]}; OUT = __builtin_bit_cast(bf16x8, w); } while (0)
    PK4(p0, 0, pa0); PK4(p0, 8, pa1); PK4(p1, 0, pa2); PK4(p1, 8, pa3);
#undef PK4
}
struct KVStage { bf16x8 k0, k1, v0, v1; };
__device__ __forceinline__ void kv_load(KVStage& s, const bf16* kb, const bf16* vb, size_t pitch, int sr, int sc) {
    s.k0 = *(const bf16x8*)(kb + (size_t)sr * pitch + sc); s.k1 = *(const bf16x8*)(kb + (size_t)(32 + sr) * pitch + sc);
    s.v0 = *(const bf16x8*)(vb + (size_t)sr * pitch + sc); s.v1 = *(const bf16x8*)(vb + (size_t)(32 + sr) * pitch + sc);
}
__device__ __forceinline__ void kv_write(const KVStage& s, LAS char* Kb, LAS char* Vb, int sr, int sc) {
    *(LAS bf16x8*)(Vb + v_st(sr, sc)) = s.v0; *(LAS bf16x8*)(Vb + v_st(32 + sr, sc)) = s.v1;
    *(LAS bf16x8*)(Kb + KSWZ(sr, sc * 2)) = s.k0; *(LAS bf16x8*)(Kb + KSWZ(32 + sr, sc * 2)) = s.k1;
}
struct DmaOff { unsigned k0, k1, v0, v1; };
__device__ __forceinline__ void dma_offsets(DmaOff& d, int wid, int lane, unsigned pitch_bytes) {
    { const int r0 = 8 * wid + (lane >> 4), r1 = r0 + 4; d.k0 = r0 * pitch_bytes + (((lane & 15) ^ (r0 & 7)) << 4); d.k1 = r1 * pitch_bytes + (((lane & 15) ^ (r1 & 7)) << 4); }
    { const int T0 = 4 * wid + (lane >> 5), T1 = T0 + 2, klo = (lane & 31) >> 2, cl = 8 * (lane & 3);
      const int kk0 = 8 * (T0 >> 2) + klo, kk1 = 8 * (T1 >> 2) + klo;
      const int k0 = (kk0 & ~0xC) | ((kk0 & 4) << 1) | ((kk0 & 8) >> 1), k1 = (kk1 & ~0xC) | ((kk1 & 4) << 1) | ((kk1 & 8) >> 1);
      d.v0 = k0 * pitch_bytes + (32 * (T0 & 3) + cl) * 2; d.v1 = k1 * pitch_bytes + (32 * (T1 & 3) + cl) * 2; }
}
__device__ __forceinline__ void glds_s(unsigned voff, const void* sbase, unsigned lds_dst) {
    const unsigned lo = (unsigned)__builtin_amdgcn_readfirstlane((int)(unsigned)(uintptr_t)sbase), hi = (unsigned)__builtin_amdgcn_readfirstlane((int)(unsigned)((uintptr_t)sbase >> 32));
    const unsigned long long sb = ((unsigned long long)hi << 32) | lo; const unsigned ld = (unsigned)__builtin_amdgcn_readfirstlane((int)lds_dst); unsigned keep;
    asm volatile("s_mov_b32 %0, m0\n\ts_mov_b32 m0, %3\n\ts_nop 0\n\tglobal_load_lds_dwordx4 %1, %2\n\ts_mov_b32 m0, %0" : "=&s"(keep) : "v"(voff), "s"(sb), "s"(ld) : "memory");
}
__device__ __forceinline__ void dma_tile(const DmaOff& d, const bf16* kb, const bf16* vb, unsigned ldsK, unsigned ldsV, int wid) {
    glds_s(d.k0, kb, ldsK + 2048 * wid); glds_s(d.k1, kb, ldsK + 2048 * wid + 1024);
    glds_s(d.v0, vb, ldsV + 2048 * wid); glds_s(d.v1, vb, ldsV + 2048 * wid + 1024);
}
#define DMA_WAIT() asm volatile("s_waitcnt vmcnt(0)" ::: "memory")
constexpr int AT_V = 0, AT_K = 49152, AT_WSF = 98304, AT_IMPW = 100352, AT_IMPS = AT_IMPW + 32768, AT_SEL = AT_IMPS + 8192, AT_MISC = AT_SEL + 256;
constexpr float SM_C = QSCALE * 1.4426950408889634f, SM_THR = 8.f / QSCALE;

__device__ __forceinline__ void sm_tile(f32x16& p0, f32x16& p1, int lo, int hi2, float& m_reg, float& l_reg, f32x16 (&o)[4], LAS float* wsf, int vb, int r32, int hi) {
    const bool partial = (lo >= 0) || (hi2 >= 0 && hi2 < 63);
    if (__any(partial)) {
        const int lo4 = lo - 4 * hi, hi4 = hi2 - 4 * hi;
#pragma unroll
        for (int r = 0; r < 16; ++r) { p0[r] = (crow0(r) > lo4 && crow0(r) <= hi4) ? p0[r] : -__builtin_inff(); p1[r] = (32 + crow0(r) > lo4 && 32 + crow0(r) <= hi4) ? p1[r] : -__builtin_inff(); }
    }
    const bool off = (hi2 < 0);
    float pmax = p0[0];
#pragma unroll
    for (int r = 1; r < 16; ++r) pmax = fmaxf(pmax, p0[r]);
#pragma unroll
    for (int r = 0; r < 16; ++r) pmax = fmaxf(pmax, p1[r]);
    pmax = xhalf_max(pmax);
    pmax = off ? -__builtin_inff() : pmax;
    float mn, alpha;
    if (__all(pmax - m_reg <= SM_THR)) { mn = m_reg; alpha = 1.f; }
    else { mn = fmaxf(m_reg, pmax); alpha = __builtin_amdgcn_exp2f((m_reg - mn) * SM_C); m_reg = mn; }
    const float mnC = off ? -__builtin_inff() : -mn * SM_C;
#pragma unroll
    for (int r = 0; r < 16; ++r) { p0[r] = __builtin_amdgcn_exp2f(fmaf(p0[r], SM_C, mnC)); p1[r] = __builtin_amdgcn_exp2f(fmaf(p1[r], SM_C, mnC)); }
    float ps = 0.f;
#pragma unroll
    for (int r = 0; r < 16; ++r) ps += p0[r] + p1[r];
    ps = xhalf_sum(ps);
    l_reg = l_reg * alpha + ps;
    if (__any(alpha < 1.f)) { if (hi == 0) wsf[r32] = alpha; asm volatile("s_waitcnt lgkmcnt(0)" ::: "memory");
#pragma unroll
        for (int r = 0; r < 16; ++r) { const float a = (wsf + 4 * hi)[crow0(r)];
#pragma unroll
            for (int d = 0; d < 4; ++d) o[d][r] *= a; } }
    bf16x8 pa0, pa1, pa2, pa3; pack_p(p0, p1, pa0, pa1, pa2, pa3);
    pv_d0(o, vb, pa0, pa1, pa2, pa3);
}

__device__ __forceinline__ void nsa_mfma_unit(Frame& F, int unit) {
    const int qt = unit & 31, g = (unit >> 5) & 3, b = unit >> 7;
    const int tid = F.tid, wid = F.wave, lane = F.lane, r32 = lane & 31, hi = lane >> 5;
    const int hg = wid & 3, qh = wid >> 2, head = g * 4 + hg, qrel = qh * 32 + r32, tq = qt * 64 + qrel;
    LAS char* L = (LAS char*)F.lds;
    LAS float* wsf = (LAS float*)(L + AT_WSF) + wid * 64;
    LAS float* impw = (LAS float*)(L + AT_IMPW);
    LAS float* imps = (LAS float*)(L + AT_IMPS);
    LAS unsigned* selm = (LAS unsigned*)(L + AT_SEL);
    LAS unsigned* misc = (LAS unsigned*)(L + AT_MISC);
    const int vb0 = (int)(unsigned)(uintptr_t)(L + AT_V) + v_rd_base(lane);
    const int sr = tid >> 4, sc = (tid & 15) * 8;
    const bf16* pbase = F.proj + (size_t)b * SEQ * NSA_INP;
    bf16x8 qr[8];
    { const bf16* qp = pbase + (size_t)tq * NSA_INP + N_Q + head * 128 + hi * 8;
#pragma unroll
      for (int d0 = 0; d0 < 8; ++d0) qr[d0] = *(const bf16x8*)(qp + d0 * 16); }
#define NSA_GATE(br) sigmoidf_(bf1(pbase[(size_t)tq * NSA_INP + N_G + head * 3 + (br)]))
    float* orow = F.y + (size_t)(b * SEQ + qt * 64 + qh * 32 + 4 * hi) * DM + head * 128 + r32;
    f32x16 o[4];
    const unsigned ldsK0 = (unsigned)(uintptr_t)(L + AT_K), ldsV0 = (unsigned)(uintptr_t)(L + AT_V);
    { const bf16* kc = F.kcmpb + (size_t)(b * 4 + g) * 128 * 128; const bf16* vc = F.vcmpb + (size_t)(b * 4 + g) * 128 * 128;
      DmaOff dc; dma_offsets(dc, wid, lane, 128 * 2);
      dma_tile(dc, kc, vc, ldsK0, ldsV0, wid); dma_tile(dc, kc + 64 * 128, vc + 64 * 128, ldsK0 + 16384u, ldsV0 + 16384u, wid); DMA_WAIT(); }
    if (tid == 0) misc[0] = 0u;
    __syncthreads();
#ifndef NSA_SKIP_CMP
    {
        const int nv = (tq >= 31) ? ((tq - 31) >> 4) + 1 : 0;
        float m_c = -1.0e30f, l_c = 0.f;
#pragma unroll
        for (int d = 0; d < 4; ++d) o[d] = f32x16{};
        { f32x16 p0, p1; qkt(p0, p1, L + AT_K, qr, r32, hi); sm_tile(p0, p1, -1, nv - 1, m_c, l_c, o, wsf, vb0, r32, hi); }
        { f32x16 p0, p1; qkt(p0, p1, L + AT_K + 16384, qr, r32, hi); sm_tile(p0, p1, -1, nv - 65, m_c, l_c, o, wsf, vb0 + 16384, r32, hi); }
        const float inv = (nv > 0) ? 1.f / l_c : 0.f;
        if (hi == 0) wsf[r32] = NSA_GATE(0) * inv;
        asm volatile("s_waitcnt lgkmcnt(0)" ::: "memory");
        { float* ob_ = launder(orow);
#pragma unroll
          for (int r = 0; r < 16; ++r) { const float s = (wsf + 4 * hi)[crow0(r)]; float* op = ob_ + (size_t)crow0(r) * DM;
#pragma unroll
            for (int d = 0; d < 4; ++d) op[32 * d] = o[d][r] * s; } }
        {
            LAS float* iw = impw + (wid * 32 + r32) * 32;
            float prevL = 0.f; const float mnC = -m_c * SM_C;
#define IMP_STEP(C, TS) _Pragma("unroll") for (int rg = 0; rg < 4; ++rg) { const float Gs = (C[4 * rg] + C[4 * rg + 1]) + (C[4 * rg + 2] + C[4 * rg + 3]); \
                const float Lc = xhalf_other(C[4 * rg + 3], hi); iw[8 * TS + 2 * rg + hi] = (Gs + (hi ? Lc : prevL)) * inv; prevL = Lc; }
#define IMP_TILE(KOFF, NB) { f32x16 p0, p1; qkt(p0, p1, L + AT_K + KOFF, qr, r32, hi); const int lim = nv - NB - 4 * hi; \
            _Pragma("unroll") for (int r = 0; r < 16; ++r) { p0[r] = (crow0(r) < lim) ? __builtin_amdgcn_exp2f(fmaf(p0[r], SM_C, mnC)) : 0.f; p1[r] = (32 + crow0(r) < lim) ? __builtin_amdgcn_exp2f(fmaf(p1[r], SM_C, mnC)) : 0.f; } \
            IMP_STEP(p0, (NB / 32)) IMP_STEP(p1, (NB / 32 + 1)) }
            IMP_TILE(0, 0) IMP_TILE(16384, 64)
#undef IMP_TILE
#undef IMP_STEP
        }
    }
#endif
    __syncthreads();
    { const int q = tid >> 3, m4 = (tid & 7) * 4;
      const int w0 = (q >> 5) * 4, rr = q & 31;
#pragma unroll
      for (int i = 0; i < 4; ++i) { const int m = m4 + i;
          imps[q * 32 + m] = (impw[((w0 + 0) * 32 + rr) * 32 + m] + impw[((w0 + 1) * 32 + rr) * 32 + m]) + (impw[((w0 + 2) * 32 + rr) * 32 + m] + impw[((w0 + 3) * 32 + rr) * 32 + m]); } }
    __syncthreads();
    if (tid < 64) { const unsigned mk = nsa_select(imps + tid * 32, qt * 64 + tid); selm[tid] = mk; __hip_atomic_fetch_or(&misc[0], mk, __ATOMIC_RELAXED, __HIP_MEMORY_SCOPE_WORKGROUP); }
    __syncthreads();
    if (tid == 0) { unsigned un = misc[0]; int n = 0;
        for (int j = 0; j <= qt; ++j) if ((un >> j) & 1u) misc[2 + n++] = 0x100u | (unsigned)j;
        for (int j = (qt >= 8 ? qt - 8 : 0); j <= qt; ++j) misc[2 + n++] = 0x200u | (unsigned)j;
        misc[1] = (unsigned)n; }
    DmaOff dof; dma_offsets(dof, wid, lane, NSA_INP * 2);
    dma_tile(dof, pbase + N_KS + g * 128, pbase + N_VS + g * 128, ldsK0, ldsV0, wid);
    __syncthreads();
    const int nt = (int)misc[1];
#define NSA_TILE_SRC(IDX) (pbase + (size_t)(64 * (int)(misc[2 + (IDX)] & 255u)) * NSA_INP + ((misc[2 + (IDX)] >> 8) == 1u ? N_KS : N_KW) + g * 128)
    if (nt > 1) { const bf16* kb1 = NSA_TILE_SRC(1); dma_tile(dof, kb1, kb1 + 512, ldsK0 + 16384u, ldsV0 + 16384u, wid); asm volatile("s_waitcnt vmcnt(4)" ::: "memory"); }
    else DMA_WAIT();
    __syncthreads();
    float m_reg = -1.0e30f, l_reg = 0.f;
#pragma unroll
    for (int d = 0; d < 4; ++d) o[d] = f32x16{};
    int prevkind = 1;
#ifndef NSA_SKIP_LOOP
    for (int i = 0; i < nt; ++i) {
        const unsigned ent = misc[2 + i]; const int kind = (int)(ent >> 8), j = (int)(ent & 255u);
        if (i + 2 < nt) { const bf16* kb = NSA_TILE_SRC(i + 2); const unsigned nb = (unsigned)(((i + 2) % 3) * 16384);
            dma_tile(dof, kb, kb + 512, ldsK0 + nb, ldsV0 + nb, wid); }
#ifndef NSA_SKIP_TRANS
        if (kind != prevkind) {
            if (hi == 0) wsf[r32] = NSA_GATE(1) / l_reg;
            asm volatile("s_waitcnt lgkmcnt(0)" ::: "memory");
            float* ob_ = launder(orow);
#pragma unroll
            for (int r = 0; r < 16; ++r) { const float s = (wsf + 4 * hi)[crow0(r)]; float* op = ob_ + (size_t)crow0(r) * DM;
#pragma unroll
                for (int d = 0; d < 4; ++d) { op[32 * d] += o[d][r] * s; } }
            asm volatile("s_waitcnt vmcnt(0)" ::: "memory");
#pragma unroll
            for (int d = 0; d < 4; ++d) o[d] = f32x16{};
            m_reg = -1.0e30f; l_reg = 0.f; prevkind = kind;
        }
#endif
        int lo = -1, hi2 = 63;
        if (kind == 1) { if (!((selm[qrel] >> j) & 1u)) hi2 = -1; else if (j == qt) hi2 = qrel; }
        else { if (j == qt) hi2 = qrel; else if (j == qt - 8) lo = qrel; }
        const int bo = (i % 3) * 16384;
        f32x16 p0, p1;
        qkt(p0, p1, L + AT_K + bo, qr, r32, hi);
        sm_tile(p0, p1, lo, hi2, m_reg, l_reg, o, wsf, vb0 + bo, r32, hi);
        if (i + 2 < nt) asm volatile("s_waitcnt vmcnt(4)" ::: "memory"); else DMA_WAIT();
        __syncthreads();
    }
#endif
#undef NSA_TILE_SRC
    if (hi == 0) wsf[r32] = NSA_GATE(2) / l_reg;
    asm volatile("s_waitcnt lgkmcnt(0)" ::: "memory");
    const float* ob_ = launder(orow);
#if FP8_P13
    unsigned char* mrow = launder((unsigned char*)F.mix + (size_t)(b * SEQ + qt * 64 + qh * 32 + 4 * hi) * DM + head * 128 + r32);
#pragma unroll
    for (int r = 0; r < 16; ++r) { const float s = (wsf + 4 * hi)[crow0(r)]; const float* op = ob_ + (size_t)crow0(r) * DM; unsigned char* mp = mrow + (size_t)crow0(r) * DM;
#pragma unroll
        for (int d = 0; d < 4; ++d) mp[32 * d] = (unsigned char)(__builtin_amdgcn_cvt_pk_fp8_f32(pg8::clamp448(op[32 * d] + o[d][r] * s), 0.f, 0, false) & 255); }
#else
    bf16* mrow = launder(F.mix + (size_t)(b * SEQ + qt * 64 + qh * 32 + 4 * hi) * DM + head * 128 + r32);
#pragma unroll
    for (int r = 0; r < 16; ++r) { const float s = (wsf + 4 * hi)[crow0(r)]; const float* op = ob_ + (size_t)crow0(r) * DM; bf16* mp = mrow + (size_t)crow0(r) * DM;
#pragma unroll
        for (int d = 0; d < 4; ++d) mp[32 * d] = (bf16)f2bf(op[32 * d] + o[d][r] * s); }
#endif
    __syncthreads();
}

__device__ __forceinline__ void sb_mfma_unit(Frame& F, int unit) {
    const int qb = unit & 7, hh = (unit >> 3) & 7, b = unit >> 6;
    const int tid = F.tid, wid = F.wave, lane = F.lane, r32 = lane & 31, hi = lane >> 5;
    const int tq0 = qb * 256 + wid * 32, tq = tq0 + r32;
    LAS char* L = (LAS char*)F.lds;
    LAS unsigned* actf = (LAS unsigned*)(L + AT_MISC);
    const int vb0 = (int)(unsigned)(uintptr_t)(L + AT_V) + v_rd_base(lane);
    const int sr = tid >> 4, sc = (tid & 15) * 8;
    const bf16* pbase = F.proj + (size_t)b * SEQ * EVEN_IN + hh * 128;
    bf16x8 qr[8];
    { const bf16* qp = pbase + (size_t)tq * EVEN_IN + E_Q + hi * 8;
#pragma unroll
      for (int d0 = 0; d0 < 8; ++d0) qr[d0] = *(const bf16x8*)(qp + d0 * 16); }
    f32x16 o[4];
#pragma unroll
    for (int d = 0; d < 4; ++d) o[d] = f32x16{};
    float R = 0.f;
    KVStage st;
    int jt = qb * 4 + 3;
    DmaOff dof; dma_offsets(dof, wid, lane, EVEN_IN * 2);
    const unsigned ldsK0 = (unsigned)(uintptr_t)(L + AT_K), ldsV0 = (unsigned)(uintptr_t)(L + AT_V);
    dma_tile(dof, pbase + (size_t)(64 * jt) * EVEN_IN + E_K, pbase + (size_t)(64 * jt) * EVEN_IN + E_V, ldsK0, ldsV0, wid);
    DMA_WAIT();
    __syncthreads();
    for (int it = 0;; ++it, --jt) {
        const int bo = (it & 1) * 16384;
        if (jt > 0) dma_tile(dof, pbase + (size_t)(64 * (jt - 1)) * EVEN_IN + E_K, pbase + (size_t)(64 * (jt - 1)) * EVEN_IN + E_V, ldsK0 + (16384u - (unsigned)bo), ldsV0 + (16384u - (unsigned)bo), wid);
        const bool act = (64 * jt < tq0 + 32) && __any(R > -120.f);
        if (act) {
            f32x16 p0, p1;
            qkt(p0, p1, L + AT_K + bo, qr, r32, hi);
            const int kbase = 64 * jt;
            f32x16 k0, k1;
            const int thr = tq - kbase - 4 * hi;
#pragma unroll
            for (int r = 0; r < 16; ++r) {
                const float z0 = p0[r] * QSCALE, z1 = p1[r] * QSCALE;
                const float lb0 = logsigf_(z0), lb1 = logsigf_(z1);
                k0[r] = (crow0(r) < thr) ? lb0 - z0 : 0.f; k1[r] = (32 + crow0(r) < thr) ? lb1 - z1 : 0.f;
                p0[r] = (crow0(r) < thr) ? lb0 : -__builtin_inff(); p1[r] = (32 + crow0(r) < thr) ? lb1 : -__builtin_inff(); }
            float run = R;
#pragma unroll
            for (int ti = 1; ti >= 0; --ti)
#pragma unroll
                for (int rg = 3; rg >= 0; --rg) {
                    const float a0 = ti ? k1[4 * rg] : k0[4 * rg], a1 = ti ? k1[4 * rg + 1] : k0[4 * rg + 1], a2 = ti ? k1[4 * rg + 2] : k0[4 * rg + 2], a3 = ti ? k1[4 * rg + 3] : k0[4 * rg + 3];
                    const float gs_ = (a0 + a1) + (a2 + a3), go_ = xhalf_other(gs_, hi);
                    const float godd = hi ? gs_ : go_, gev = hi ? go_ : gs_;
                    const float sx = hi ? run : run + godd;
                    run += godd + gev;
                    const float e3 = sx, e2 = sx + a3, e1 = e2 + a2, e0 = e1 + a1;
                    if (ti) { p1[4 * rg] = __expf(p1[4 * rg] + e0); p1[4 * rg + 1] = __expf(p1[4 * rg + 1] + e1); p1[4 * rg + 2] = __expf(p1[4 * rg + 2] + e2); p1[4 * rg + 3] = __expf(p1[4 * rg + 3] + e3); }
                    else    { p0[4 * rg] = __expf(p0[4 * rg] + e0); p0[4 * rg + 1] = __expf(p0[4 * rg + 1] + e1); p0[4 * rg + 2] = __expf(p0[4 * rg + 2] + e2); p0[4 * rg + 3] = __expf(p0[4 * rg + 3] + e3); }
                }
            R = run;
            bf16x8 pa0, pa1, pa2, pa3; pack_p(p0, p1, pa0, pa1, pa2, pa3);
            pv_d0(o, vb0 + bo, pa0, pa1, pa2, pa3);
        }
        const bool actn = (jt > 0) && (64 * (jt - 1) < tq0 + 32) && __any(R > -120.f);
        if (lane == 0) actf[(it & 1) * 8 + wid] = actn ? 1u : 0u;
        DMA_WAIT();
        __syncthreads();
        unsigned any = 0u;
#pragma unroll
        for (int w = 0; w < 8; ++w) any |= actf[(it & 1) * 8 + w];
        if (!any) break;
    }
    bf16* mrow = launder(F.mix + (size_t)(b * SEQ + tq0 + 4 * hi) * DM + hh * 128 + r32);
#pragma unroll
    for (int r = 0; r < 16; ++r) { bf16* mp = mrow + (size_t)crow0(r) * DM;
#pragma unroll
        for (int d = 0; d < 4; ++d) mp[32 * d] = (bf16)f2bf(o[d][r]); }
    __syncthreads();
}

__device__ __forceinline__ void cmp_posbias(Frame& F, int idx) {
    const int which = idx >> 5, part = idx & 31;
    const float* w1 = which ? F.cmp_v_w1 : F.cmp_k_w1; const float* pos = which ? F.cmp_pos_v : F.cmp_pos_k;
    LAS float* red = (LAS float*)(F.lds);
    const int dout = F.tid & 127, ks = F.tid >> 7; float acc = 0.f;
    const int kb = part * 128 + ks * 32;
#pragma unroll 16
    for (int k = 0; k < 32; ++k) acc += pos[kb + k] * w1[(size_t)(kb + k) * 128 + dout];
    __syncthreads();
    red[F.tid] = acc;
    __syncthreads();
    if (F.tid < 128) F.cmp_pb[(which * 32 + part) * 128 + F.tid] = (red[F.tid] + red[128 + F.tid]) + (red[256 + F.tid] + red[384 + F.tid]);
    __syncthreads();
}
__device__ __forceinline__ void cmp_mfma_unit(Frame& F, int unit) {
    const int mt = unit % 5, bg = (unit / 5) & 15, which = unit / 80;
    const int b = bg >> 2, g = bg & 3, m0 = 31 * mt;
    const int tid = F.tid, wid = F.wave, lane = F.lane, r32 = lane & 31, hi = lane >> 5, kq = wid & 3, nh = wid >> 2;
    const bf16* W1t = which ? F.Wc1v : F.Wc1k; const bf16* W2t = which ? F.Wc2v : F.Wc2k;
    bf16* outb = which ? F.vcmpb : F.kcmpb;
    const int coff = (which ? N_VC : N_KC) + g * 128;
    LAS float* part = (LAS float*)(F.lds);
    LAS char* hidb = (LAS char*)(F.lds) + 131072;
    LAS float* pb = (LAS float*)(F.lds + 131072 + 32 * 272);
    if (tid < 128) { float s = 0.f; for (int p = 0; p < 32; ++p) s += F.cmp_pb[(which * 32 + p) * 128 + tid]; pb[tid] = s; }
    const int m = m0 + r32; const bool mv = m < 128;
    const bf16* arow = F.proj + ((size_t)b * SEQ + 16 * (mv ? m : 0)) * NSA_INP + coff + 8 * hi;
    const bf16* brow = W1t + (size_t)(nh * 128 + r32) * 2048 + 8 * hi;
    f32x16 acc[4];
#pragma unroll
    for (int i = 0; i < 4; ++i) acc[i] = f32x16{};
#pragma unroll 4
    for (int s = 0; s < 32; ++s) { const int ksg = kq * 32 + s;
        bf16x8 a = *(const bf16x8*)(arow + (size_t)(ksg >> 3) * NSA_INP + (ksg & 7) * 16);
        if (!mv) a = bf16x8{};
#pragma unroll
        for (int nt = 0; nt < 4; ++nt) { const bf16x8 bb = *(const bf16x8*)(brow + (size_t)(nt * 32) * 2048 + ksg * 16);
            acc[nt] = __builtin_amdgcn_mfma_f32_32x32x16_bf16(a, bb, acc[nt], 0, 0, 0); } }
    { LAS float* pp = part + (kq * 32 + 4 * hi) * 256 + nh * 128 + r32;
#pragma unroll
      for (int r = 0; r < 16; ++r)
#pragma unroll
        for (int nt = 0; nt < 4; ++nt) pp[crow0(r) * 256 + nt * 32] = acc[nt][r]; }
    __syncthreads();
    { const int nl = tid >> 4, d8 = (tid & 15) * 8;
      unsigned pk[4];
#pragma unroll
      for (int i = 0; i < 4; ++i) { float hv[2];
#pragma unroll
          for (int q = 0; q < 2; ++q) { const int dd = d8 + 2 * i + q; float u = 0.f;
              if (nl < 31) { u = pb[dd];
#pragma unroll
                  for (int k4 = 0; k4 < 4; ++k4) u += part[(k4 * 32 + nl) * 256 + dd] + part[(k4 * 32 + nl + 1) * 256 + 128 + dd];
                  u = gelu_tanh(u); }
              hv[q] = u; }
          pk[i] = pk2(hv[0], hv[1]); }
      *(LAS v4u*)(hidb + nl * 272 + d8 * 2) = (v4u){pk[0], pk[1], pk[2], pk[3]}; }
    __syncthreads();
    if (wid < 4) {
        f32x16 a2 = f32x16{};
#pragma unroll
        for (int ks = 0; ks < 8; ++ks) { const bf16x8 a = *(const LAS bf16x8*)(hidb + r32 * 272 + (ks * 16 + 8 * hi) * 2);
            const bf16x8 bb = *(const bf16x8*)(W2t + (size_t)(wid * 32 + r32) * 128 + ks * 16 + 8 * hi);
            a2 = __builtin_amdgcn_mfma_f32_32x32x16_bf16(a, bb, a2, 0, 0, 0); }
#pragma unroll
        for (int r = 0; r < 16; ++r) { const int nl = crow0(r) + 4 * hi, n = m0 + nl;
            if (nl < 31 && n < 128) outb[((size_t)bg * 128 + n) * 128 + wid * 32 + r32] = (n < NCMP) ? (bf16)f2bf(a2[r]) : (bf16)0; }
    }
    __syncthreads();
}

__device__ __forceinline__ int lane_now() { int l; asm volatile("v_mbcnt_lo_u32_b32 %0, -1, 0\n\tv_mbcnt_hi_u32_b32 %0, -1, %0" : "=v"(l)); return l; }
struct Args { const float* in[33]; float* out; unsigned char* ws; int ph_lo, ph_hi; };
#define CAS __attribute__((address_space(4)))
__device__ __forceinline__ void load_frame(Frame& F) {
    const CAS Args* ap = (const CAS Args*)__builtin_amdgcn_kernarg_segment_ptr();
    asm volatile("" : "+s"(ap));
    unsigned char* ws = ap->ws;
    F.ctl = (gu32*)(ws + WS_CTL);
    F.x = ap->in[0]; F.c = ap->in[1]; F.ada_mix_w = ap->in[2]; F.ada_mix_b = ap->in[3]; F.norm_mix_g = ap->in[4]; F.ada_ffn_w = ap->in[5]; F.ada_ffn_b = ap->in[6]; F.norm_ffn_g = ap->in[7];
    F.even_in_w = ap->in[8]; F.rg_conv_w = ap->in[9]; F.rg_conv_b = ap->in[10]; F.rg_wa = ap->in[11]; F.rg_ba = ap->in[12]; F.rg_wx = ap->in[13]; F.rg_bx = ap->in[14]; F.rg_lambda = ap->in[15];
    F.even_out_w = ap->in[16]; F.dense_w_gate = ap->in[17]; F.dense_w_up = ap->in[18]; F.dense_w_down = ap->in[19]; F.nsa_in_w = ap->in[20]; F.cmp_pos_k = ap->in[21]; F.cmp_pos_v = ap->in[22];
    F.cmp_k_w1 = ap->in[23]; F.cmp_k_w2 = ap->in[24]; F.cmp_v_w1 = ap->in[25]; F.cmp_v_w2 = ap->in[26]; F.nsa_out_w = ap->in[27]; F.router_w = ap->in[28];
    F.moe_w_gate = ap->in[29]; F.moe_w_up = ap->in[30]; F.moe_w_down = ap->in[31]; F.final_norm_g = ap->in[32]; F.out = ap->out;
    F.Win0 = (bf16*)(ws + WS_WIN0); F.Wout0 = (bf16*)(ws + WS_WOUT0); F.Wgu0 = (bf16*)(ws + WS_WGU0); F.Wdn0 = (bf16*)(ws + WS_WDN0); F.Win1 = (bf16*)(ws + WS_WIN1); F.Wout1 = (bf16*)(ws + WS_WOUT1);
    F.Wmgu = (bf16*)(ws + WS_WMGU); F.Wmdn = (bf16*)(ws + WS_WMDN);
    F.mod = (float*)(ws + WS_MOD); F.xa = (float*)(ws + WS_XA); F.xb = (float*)(ws + WS_XB); F.kcmp = (float*)(ws + WS_KCMP); F.vcmp = (float*)(ws + WS_VCMP);
    F.sumP = (float*)(ws + WS_SUMP); F.sumH = (float*)(ws + WS_SUMH); F.hl = (float*)(ws + WS_HL); F.pc = (float*)(ws + WS_PC); F.y = (float*)(ws + WS_Y); F.rowp = (float*)(ws + WS_ROWP);
    F.route = (int*)(ws + WS_ROUTE);
    F.h = (bf16*)(ws + WS_H); F.proj = (bf16*)(ws + WS_PROJ); F.mix = (bf16*)(ws + WS_MIX); F.act = (bf16*)(ws + WS_ACT); F.hperm = (bf16*)(ws + WS_HPERM); F.kcmpb = (bf16*)(ws + WS_KCMPB); F.vcmpb = (bf16*)(ws + WS_VCMPB); F.Wc1k = (bf16*)(ws + WS_WC1K); F.Wc1v = (bf16*)(ws + WS_WC1V); F.Wc2k = (bf16*)(ws + WS_WC2K); F.Wc2v = (bf16*)(ws + WS_WC2V); F.cmp_pb = (float*)(ws + WS_CMPPB); F.rowsa = (float*)(ws + WS_ROWSA); F.part = (float*)(ws + WS_PART);
}
__global__ void __launch_bounds__(NTHR, 2) mk_fwd(Args args) {
    extern __shared__ __attribute__((aligned(16))) unsigned char lds[];
    Frame F;
    F.lds = (LAS unsigned char*)lds;
    F.MISC = (volatile LAS unsigned*)(F.lds + MISC_OFF);
    const int wave0 = __builtin_amdgcn_readfirstlane((int)threadIdx.x >> 6);
    F.lane = lane_now(); F.wave = wave0; F.tid = wave0 * 64 + F.lane;
    F.G = gridDim.x; { const int bx = blockIdx.x; F.vcu = (F.G % 8 == 0) ? (bx % 8) * (F.G / 8) + bx / 8 : bx; }
    load_frame(F);
    for (int u = F.tid; u < (LDS_BYTES - LDSCTL_OFF) / 4; u += NTHR) ((LAS unsigned*)(F.lds + LDSCTL_OFF))[u] = 0u;
    __syncthreads();
    XcdBarrier bar; bar.bar = (unsigned*)(F.ctl + CW_BAR); bar.x = 0; bar.st = nullptr;
    if (N_LAUNCHES == 1) bar = xcd_barrier_post((unsigned*)(F.ctl + CW_BAR), F.MISC + 8, F.tid);
    const int lo = args.ph_lo, hi = args.ph_hi;
#define IN(k) (lo <= (k) && (k) < hi)
#define SEAM(k) do { if (IN(k) && IN((k) + 1)) xcd_barrier(bar, wave0 * 64 + lane_now()); } while (0)
#ifndef PROBE_DUP
#define PROBE_DUP -1
#endif
#define REP(k) for (int rep_ = (load_frame(F), F.lane = lane_now(), F.wave = wave0, F.tid = wave0 * 64 + F.lane, 0); rep_ < ((PROBE_DUP) == (k) ? 2 : 1); ++rep_)
#define mod0 (F.mod)
#define mod1 (F.mod + 4 * 6144)
#define mod2 (F.mod + 8 * 6144)
#define mod3 (F.mod + 12 * 6144)

    if (IN(0)) REP(0) { p0_adaln(F); p0_zero_pad(F);
        { CvtSeg sg; const int aLo = I8_P2 ? 2560 : 0;
          const int gLo = 3584, gN = I8_DUP ? 7168 : 0;
          const int nLo = 14336, nN = I8_P10 ? 2592 : 0;
          sg.n0 = gLo - aLo; sg.b0 = aLo; sg.n1 = nLo - (gLo + gN); sg.b1 = gLo + gN; sg.b2 = nLo + nN; sg.nv = sg.n0 + sg.n1 + (CVT_TOTAL - sg.b2) - (F.G == 256 ? LATE_ALL : 0);
          p0_convert(F, sg, 0.f); }
        if (I8_DUP) p0_absmax(F, F.dense_w_gate, F.dense_w_up, DM * DFF / 4, CW_WMAX);
#ifdef ABSMAX_PROBE
        for (int rr = 0; rr < 8; ++rr) { asm volatile("" ::: "memory"); p0_absmax(F, F.dense_w_gate, F.dense_w_up, DM * DFF / 4, CW_WMAX); }
#endif
        if (I8_P2) p0_absmax(F, F.even_in_w, F.even_in_w, DM * EVEN_IN / 4, CW_WMAX + 1);
        if (I8_P10) p0_absmax(F, F.nsa_in_w, F.nsa_in_w, DM * NSA_IN / 4, CW_WMAX + 2);
    } SEAM(0);
    if (IN(1)) REP(1) {
        if (I8_DUP) { const float wm = __builtin_bit_cast(float, __hip_atomic_load(F.ctl + CW_WMAX, RLX_AGENT)); CvtSeg sg{7168, 3584, 0, 0, 0, 7168}; p0_convert(F, sg, wm > 0.f ? 127.f / wm : 0.f); }
        if (I8_P2) { const float w1 = __builtin_bit_cast(float, __hip_atomic_load(F.ctl + CW_WMAX + 1, RLX_AGENT)); CvtSeg s1{2560, 0, 0, 0, 0, 2560}; p0_convert(F, s1, w1 > 0.f ? 127.f / w1 : 0.f); }
        if (I8_P10) { const float w2 = __builtin_bit_cast(float, __hip_atomic_load(F.ctl + CW_WMAX + 2, RLX_AGENT)); CvtSeg s2{2592, 14336, 0, 0, 0, 2592}; p0_convert(F, s2, w2 > 0.f ? 127.f / w2 : 0.f); }
        __syncthreads();
        normmod_phase<(I8_P2 ? 2 : 0)>(F, F.x, F.norm_mix_g, mod0); for (int i = F.vcu; i < 64; i += F.G) cmp_posbias(F, i); } SEAM(1);
    if (IN(2)) REP(2) { pg8::StaticOrder S; S.init(MTOK, EVEN_IN, F.G, (int)blockIdx.x);
#if I8_P2
        const float wm = __builtin_bit_cast(float, __hip_atomic_load(F.ctl + CW_WMAX + 1, RLX_AGENT));
        pg8::Gemm g{(const pg8::bf16_t*)F.h, (const pg8::bf16_t*)F.Win0, MTOK, EVEN_IN, DM / 2};
        pg8::EpiBf16Pi8 E{F.proj, EVEN_IN, F.rowsa, wm * (1.f / 127.f)};
        pg8::gemm_phase<pg8::EpiBf16Pi8, pg8::StaticOrder, true, true, 2>(F.lds + RING_OFF, g, S, E, F.tid);
#else
        pg8::Gemm g{F.h, F.Win0, MTOK, EVEN_IN, DM};
        pg8::EpiBf16P E{F.proj, EVEN_IN};
        pg8::gemm_phase<pg8::EpiBf16P, pg8::StaticOrder, true, true>(F.lds + RING_OFF, g, S, E, F.tid);
#endif
        if (LATE_P2 && F.G == 256 && blockIdx.x >= 128) { CvtSeg sl{LATE_P2, CVT_TOTAL - LATE_ALL, 0, 0, 0, LATE_P2}; p0_convert(F, sl, 0.f, ((int)blockIdx.x - 128) * NWAVES + F.wave, 128 * NWAVES); }
    } SEAM(2);
    if (IN(3)) REP(3) { for (int u = F.vcu; u < 256; u += F.G) sb_mfma_unit(F, u);
#ifdef PROBE_SB
        for (int u = F.vcu; u < 256; u += F.G) sb_mfma_unit(F, u);
#endif
        for (int u = F.vcu; u < 2048; u += F.G) rglru_local_unit(F, u);
#ifdef PROBE_RG
        for (int u = F.vcu; u < 2048; u += F.G) rglru_local_unit(F, u);
#endif
    } SEAM(3);
    if (IN(4)) REP(4) { for (int u = F.vcu; u < 512; u += F.G) rglru_fix_unit(F, u); } SEAM(4);
    if (IN(5)) REP(5) { pg8::Gemm g{F.mix, F.Wout0, MTOK, DM, DM}; pg8::StaticOrder S; S.init(MTOK, DM, F.G, (int)blockIdx.x);
        pg8::EpiResid E{F.x, F.xa, DM, mod0 + 4096, 6144, SEQ, 1.f};
        pg8::gemm_phase<pg8::EpiResid, pg8::StaticOrder, false, true>(F.lds + RING_OFF, g, S, E, F.tid); } SEAM(5);
    if (IN(6)) REP(6) { normmod_phase<(I8_DUP ? 2 : (FP8_DUP ? 1 : 0))>(F, F.xa, F.norm_ffn_g, mod1); } SEAM(6);
    if (IN(7)) REP(7) { pg8::StaticOrder S; S.init(MTOK, 2 * DFF, F.G, (int)blockIdx.x);
#if I8_DUP
        const float wm = __builtin_bit_cast(float, __hip_atomic_load(F.ctl + CW_WMAX, RLX_AGENT));
        pg8::Gemm g{(const pg8::bf16_t*)F.h, (const pg8::bf16_t*)F.Wgu0, MTOK, 2 * DFF, DM / 2};
        pg8::EpiSwiGLUi8<FP8_DDN != 0> E{F.act, DFF, F.rowsa, wm * (1.f / 127.f)};
        pg8::gemm_phase<pg8::EpiSwiGLUi8<FP8_DDN != 0>, pg8::StaticOrder, true, true, 2>(F.lds + RING_OFF, g, S, E, F.tid);
#elif FP8_DUP && FP8_DDN
        pg8::Gemm g{(const pg8::bf16_t*)F.h, (const pg8::bf16_t*)F.Wgu0, MTOK, 2 * DFF, DM / 2};
        pg8::EpiSwiGLU8 E{(unsigned char*)F.act, DFF, W8_INV};
        pg8::gemm_phase<pg8::EpiSwiGLU8, pg8::StaticOrder, true, true, 1>(F.lds + RING_OFF, g, S, E, F.tid);
#elif FP8_DUP
        pg8::Gemm g{(const pg8::bf16_t*)F.h, (const pg8::bf16_t*)F.Wgu0, MTOK, 2 * DFF, DM / 2};
        pg8::EpiSwiGLU E{F.act, DFF, W8_INV};
        pg8::gemm_phase<pg8::EpiSwiGLU, pg8::StaticOrder, true, true, 1>(F.lds + RING_OFF, g, S, E, F.tid);
#else
        pg8::Gemm g{F.h, F.Wgu0, MTOK, 2 * DFF, DM};
        pg8::EpiSwiGLU E{F.act, DFF, 1.f};
        pg8::gemm_phase<pg8::EpiSwiGLU, pg8::StaticOrder, true, true>(F.lds + RING_OFF, g, S, E, F.tid);
#endif
    } SEAM(7);
    if (IN(8)) REP(8) { pg8::StaticOrder S; S.init(MTOK, DM, F.G, (int)blockIdx.x);
#if FP8_DDN
        pg8::Gemm g{(const pg8::bf16_t*)F.act, (const pg8::bf16_t*)F.Wdn0, MTOK, DM, DFF / 2};
        pg8::EpiResid E{F.xa, F.xb, DM, mod1 + 4096, 6144, SEQ, W8_INV};
        pg8::gemm_phase<pg8::EpiResid, pg8::StaticOrder, false, true, 1>(F.lds + RING_OFF, g, S, E, F.tid);
#else
        pg8::Gemm g{F.act, F.Wdn0, MTOK, DM, DFF};
        pg8::EpiResid E{F.xa, F.xb, DM, mod1 + 4096, 6144, SEQ, 1.f};
        pg8::gemm_phase<pg8::EpiResid, pg8::StaticOrder, false, true>(F.lds + RING_OFF, g, S, E, F.tid);
#endif
    } SEAM(8);
    if (IN(9)) REP(9) { normmod_phase<(I8_P10 ? 2 : 0)>(F, F.xb, F.norm_mix_g + DM, mod2); } SEAM(9);
    if (IN(10)) REP(10) { pg8::StaticOrder S; S.init(MTOK, NSA_INP, F.G, (int)blockIdx.x);
#if I8_P10
        const float wm = __builtin_bit_cast(float, __hip_atomic_load(F.ctl + CW_WMAX + 2, RLX_AGENT));
        pg8::Gemm g{(const pg8::bf16_t*)F.h, (const pg8::bf16_t*)F.Win1, MTOK, NSA_INP, DM / 2};
        pg8::EpiBf16Pi8 E{F.proj, NSA_INP, F.rowsa, wm * (1.f / 127.f)};
        pg8::gemm_phase<pg8::EpiBf16Pi8, pg8::StaticOrder, true, true, 2>(F.lds + RING_OFF, g, S, E, F.tid);
#else
        pg8::Gemm g{F.h, F.Win1, MTOK, NSA_INP, DM};
        pg8::EpiBf16P E{F.proj, NSA_INP};
        pg8::gemm_phase<pg8::EpiBf16P, pg8::StaticOrder, true, true>(F.lds + RING_OFF, g, S, E, F.tid);
#endif
        if (LATE_P10 && F.G == 256 && blockIdx.x >= 160) { CvtSeg sl{LATE_P10, CVT_TOTAL - LATE_ALL + LATE_P2, 0, 0, 0, LATE_P10}; p0_convert(F, sl, 0.f, ((int)blockIdx.x - 160) * NWAVES + F.wave, 96 * NWAVES); }
    } SEAM(10);
    if (IN(11)) REP(11) { for (int u = F.vcu; u < 160; u += F.G) cmp_mfma_unit(F, u);
        if (LATE_P11 && F.G == 256 && F.vcu >= 160) { CvtSeg sl{LATE_P11, CVT_TOTAL - LATE_ALL + LATE_P2 + LATE_P10, 0, 0, 0, LATE_P11}; p0_convert(F, sl, 0.f, (F.vcu - 160) * NWAVES + F.wave, 96 * NWAVES); }
    } SEAM(11);
    if (IN(12)) REP(12) { for (int idx = F.vcu; idx < 256; idx += F.G) { const int bg = idx >> 4, q16 = idx & 15; nsa_mfma_unit(F, (bg << 5) | q16); nsa_mfma_unit(F, (bg << 5) | (31 - q16)); } } SEAM(12);
    if (IN(13)) REP(13) { pg8::StaticOrder S; S.init(MTOK, DM, F.G, (int)blockIdx.x);
#if FP8_P13
        pg8::Gemm g{(const pg8::bf16_t*)F.mix, (const pg8::bf16_t*)F.Wout1, MTOK, DM, DM / 2};
        pg8::EpiResid E{F.xb, F.xa, DM, mod2 + 4096, 6144, SEQ, W8_INV};
        pg8::gemm_phase<pg8::EpiResid, pg8::StaticOrder, false, true, 1>(F.lds + RING_OFF, g, S, E, F.tid);
#else
        pg8::Gemm g{F.mix, F.Wout1, MTOK, DM, DM};
        pg8::EpiResid E{F.xb, F.xa, DM, mod2 + 4096, 6144, SEQ, 1.f};
        pg8::gemm_phase<pg8::EpiResid, pg8::StaticOrder, false, true>(F.lds + RING_OFF, g, S, E, F.tid);
#endif
    } SEAM(13);
    if (IN(14)) REP(14) { for (int tb = F.vcu; tb < 256; tb += F.G) router_block(F, tb, F.xa, F.norm_ffn_g + DM, mod3); } SEAM(14);
    if (IN(15)) REP(15) { for (int tb = F.vcu; tb < 256; tb += F.G) moe_scatter_block(F, tb); } SEAM(15);
    if (IN(16)) REP(16) { pg8::MoeOrder S;
#pragma unroll
        for (int e = 0; e < 9; ++e) S.tc[e] = __builtin_amdgcn_readfirstlane((int)__hip_atomic_load(F.ctl + CW_TILE + e, RLX_AGENT));
        S.nN = 2 * DFF / 256; S.G = F.G; S.c = (int)blockIdx.x; S.plan(0, 0);
#if FP8_MOE
        S.estride = 2u * DFF * DM;
        pg8::Gemm g{(const pg8::bf16_t*)F.hperm, (const pg8::bf16_t*)F.Wmgu, MOE_ROWS, 2 * DFF, DM / 2};
        pg8::EpiSwiGLU8 E{(unsigned char*)F.act, DFF, W8_INV};
        pg8::gemm_phase<pg8::EpiSwiGLU8, pg8::MoeOrder, true, true, 1>(F.lds + RING_OFF, g, S, E, F.tid);
#else
        S.estride = 2u * DFF * DM * 2u;
        pg8::Gemm g{F.hperm, F.Wmgu, MOE_ROWS, 2 * DFF, DM};
        pg8::EpiSwiGLU E{F.act, DFF, 1.f};
        pg8::gemm_phase<pg8::EpiSwiGLU, pg8::MoeOrder, true, true>(F.lds + RING_OFF, g, S, E, F.tid);
#endif
    } SEAM(16);
    if (IN(17)) REP(17) {
#if FP8_MOE
        pg8::MoeOrderT<MOE_SPLIT != 0> S;
#pragma unroll
        for (int e = 0; e < 9; ++e) S.tc[e] = __builtin_amdgcn_readfirstlane((int)__hip_atomic_load(F.ctl + CW_TILE + e, RLX_AGENT));
        S.nN = DM / 256; S.G = F.G; S.c = (int)blockIdx.x; S.estride = (unsigned)DFF * DM; S.plan(DFF / 128, DFF);
        typedef pg8::EpiMoeDown<WS_Y, WS_ROWP, WS_PART, DM> EpiMD; EpiMD E{(unsigned char*)F.mod - WS_MOD};
        pg8::Gemm g{(const pg8::bf16_t*)F.act, (const pg8::bf16_t*)F.Wmdn, MOE_ROWS, DM, DFF / 2};
        pg8::gemm_phase<EpiMD, pg8::MoeOrderT<MOE_SPLIT != 0>, true, true, 1>(F.lds + RING_OFF, g, S, E, F.tid);
#else
        pg8::MoeOrder S;
#pragma unroll
        for (int e = 0; e < 9; ++e) S.tc[e] = __builtin_amdgcn_readfirstlane((int)__hip_atomic_load(F.ctl + CW_TILE + e, RLX_AGENT));
        S.nN = DM / 256; S.G = F.G; S.c = (int)blockIdx.x; S.estride = (unsigned)DFF * DM * 2u; S.plan(DFF / 64, DFF * 2);
        typedef pg8::EpiMoeDown<WS_Y, WS_ROWP, WS_PART, DM> EpiMD; EpiMD E{(unsigned char*)F.mod - WS_MOD};
        pg8::Gemm g{F.act, F.Wmdn, MOE_ROWS, DM, DFF};
        pg8::gemm_phase<EpiMD, pg8::MoeOrder, true, true>(F.lds + RING_OFF, g, S, E, F.tid);
#endif
    } SEAM(17);
    if (IN(18)) REP(18) { final_phase(F, F.xa, mod3 + 4096); }
#undef IN
#undef SEAM
#undef mod0
#undef mod1
#undef mod2
#undef mod3
}

extern "C" void kernel_launch(void* const* d_in, const int* in_sizes, int n_in, void* d_out, int out_size, void* d_ws, size_t ws_size, hipStream_t stream) {
    static int grid = 0;
    if (grid == 0) {
        if (n_in != 33 || in_sizes[0] != MTOK * DM || out_size != MTOK * DM || ws_size < WS_END) {
            fprintf(stderr, "kernel_launch: built for 33 inputs, x/out of %d floats, >= %zu bytes of workspace; got n_in %d, in0 %d, out %d, ws %zu; nothing launched\n", MTOK * DM, (size_t)WS_END, n_in, n_in > 0 ? in_sizes[0] : -1, out_size, ws_size); grid = -1; return; }
        int dev = 0, cus = 0, per_cu = 0;
        if (hipGetDevice(&dev) != hipSuccess || hipDeviceGetAttribute(&cus, hipDeviceAttributeMultiprocessorCount, dev) != hipSuccess) { fprintf(stderr, "kernel_launch: device query failed\n"); grid = -1; return; }
        if (hipFuncSetAttribute((const void*)mk_fwd, hipFuncAttributeMaxDynamicSharedMemorySize, LDS_BYTES) != hipSuccess) { fprintf(stderr, "kernel_launch: hipFuncSetAttribute failed\n"); grid = -1; return; }
        if (hipOccupancyMaxActiveBlocksPerMultiprocessor(&per_cu, (const void*)mk_fwd, NTHR, LDS_BYTES) != hipSuccess || per_cu < 1)
            fprintf(stderr, "kernel_launch: note: occupancy query reports %d workgroups per CU\n", per_cu);
        (void)hipGetLastError();
        grid = cus;
    }
    if (grid < 0) return;
    if (hipMemsetAsync((char*)d_ws + WS_CTL, 0, CTL_ZERO_BYTES, stream) != hipSuccess) { fprintf(stderr, "kernel_launch: memset failed\n"); return; }
    Args a{};
    for (int i = 0; i < 33; ++i) a.in[i] = (const float*)d_in[i];
    a.out = (float*)d_out; a.ws = (unsigned char*)d_ws;
    for (int li = 0; li < N_LAUNCHES; ++li) {
        a.ph_lo = (N_LAUNCHES == 1) ? 0 : li; a.ph_hi = (N_LAUNCHES == 1) ? NPH : li + 1;
        hipLaunchKernelGGL(mk_fwd, dim3(grid), dim3(NTHR), LDS_BYTES, stream, a);
        const hipError_t le = hipPeekAtLastError();
        if (le != hipSuccess) { fprintf(stderr, "kernel_launch: launch %d failed: %s\n", li, hipGetErrorName(le)); break; }
    }
}
```

```cpp
#include <hip/hip_runtime.h>
#include <cstdio>
#include <cstdint>
namespace pg8 {
#define PG8_LAS __attribute__((address_space(3)))
typedef unsigned short bf16_t;
typedef short bf16x8 __attribute__((ext_vector_type(8)));
typedef float f32x4 __attribute__((ext_vector_type(4)));
typedef unsigned u32x4 __attribute__((ext_vector_type(4)));
typedef int v4i_t __attribute__((ext_vector_type(4)));
constexpr int BM = 256, BK = 64, HALF = 128, HTB = HALF * BK * 2  , STAGE_BYTES = 8 * HTB, NXCD = 8, WGM = 8;

__host__ __device__ __forceinline__ int lds_byte(int r, int c) { const int st = (r >> 4) * 2 + (c >> 5), rr = r & 15, cc = c & 31, ob = rr * 64 + cc * 2; return st * 1024 + (ob ^ (((ob >> 9) & 1) << 5)); }
__host__ __device__ __forceinline__ void stage_rc(int b, int& R, int& C) { const int st = b / 1024, sb = b % 1024, swz = sb ^ (((sb >> 9) & 1) << 5); R = (st >> 1) * 16 + swz / 64; C = (st & 1) * 32 + (swz % 64) / 2; }
__host__ __device__ __forceinline__ int perm32(int rho) { const int n = rho >> 4, i = rho & 15; return 8 * (i >> 2) + 4 * n + (i & 3); }

struct Unit { int pm, pn; size_t boff; unsigned aoff; int nt, part; };
struct Gemm { const bf16_t* A; const bf16_t* Bt; int M, N, K; };

struct StaticOrder {
    static constexpr bool VARK = false;
    int nM, nN, nwg, G, c;
    __host__ __device__ void init(int M, int N, int G_, int c_) { nM = M / BM; nN = N / BM; nwg = nM * nN; G = G_; c = c_; }
    __host__ __device__ bool next(int i, Unit& u) const {
        const long L = (long)i * G + c; if (L >= nwg) return false;
        int wgid = (int)L; { const int q = nwg / NXCD, r = nwg % NXCD, xcd = wgid % NXCD, off = wgid / NXCD; wgid = (xcd < r ? xcd * (q + 1) : r * (q + 1) + (xcd - r) * q) + off; }
        const int nig = WGM * nN, gid = wgid / nig, fm = gid * WGM, gsz = (nM - fm) < WGM ? (nM - fm) : WGM;
        u.pm = fm + ((wgid % nig) % gsz); u.pn = (wgid % nig) / gsz; u.boff = 0; u.aoff = 0; u.nt = 0; u.part = -1; return true;
    }
    __device__ __forceinline__ void a_ready(const Unit&) const {}
    __device__ __forceinline__ void done(const Unit&) const {}
};

__device__ __forceinline__ unsigned cvt_pk_bf16(float lo, float hi) { unsigned r; asm volatile("v_cvt_pk_bf16_f32 %0, %1, %2" : "=v"(r) : "v"(lo), "v"(hi)); return r; }

struct EpiBf16P {
    static constexpr bool PERM = true, AFTER_DRAIN = false;
    bf16_t* O; int ldc;
    __device__ __forceinline__ void operator()(const f32x4 (&acc)[2][2][4][2], const Unit& u, int wr, int wc, int fr, int fq) const {
        const int row0 = u.pm * BM + wr * 64 + fr, col0 = u.pn * BM + wc * 32 + 8 * fq;
#pragma unroll
        for (int ai = 0; ai < 2; ++ai)
#pragma unroll
            for (int m = 0; m < 4; ++m) { bf16_t* rowp = O + (size_t)(row0 + ai * HALF + m * 16) * ldc + col0;
#pragma unroll
                for (int bj = 0; bj < 2; ++bj) { const f32x4 v0 = acc[ai][bj][m][0], v1 = acc[ai][bj][m][1];
                    u32x4 w; w.x = cvt_pk_bf16(v0[0], v0[1]); w.y = cvt_pk_bf16(v0[2], v0[3]); w.z = cvt_pk_bf16(v1[0], v1[1]); w.w = cvt_pk_bf16(v1[2], v1[3]);
                    *(u32x4*)(rowp + bj * HALF) = w; } }
    }
};

struct EpiBf16Pi8 {
    static constexpr bool PERM = true, AFTER_DRAIN = false;
    bf16_t* O; int ldc; const float* rowscale; float wscale;
    __device__ __forceinline__ static float cf(float bits, float s) { return (float)__builtin_bit_cast(int, bits) * s; }
    __device__ __forceinline__ void operator()(const f32x4 (&acc)[2][2][4][2], const Unit& u, int wr, int wc, int fr, int fq) const {
        const int row0 = u.pm * BM + wr * 64 + fr, col0 = u.pn * BM + wc * 32 + 8 * fq;
#pragma unroll
        for (int ai = 0; ai < 2; ++ai)
#pragma unroll
            for (int m = 0; m < 4; ++m) { const int r = row0 + ai * HALF + m * 16; const float s = rowscale[r] * wscale; bf16_t* rowp = O + (size_t)r * ldc + col0;
#pragma unroll
                for (int bj = 0; bj < 2; ++bj) { const f32x4 v0 = acc[ai][bj][m][0], v1 = acc[ai][bj][m][1];
                    u32x4 w; w.x = cvt_pk_bf16(cf(v0[0], s), cf(v0[1], s)); w.y = cvt_pk_bf16(cf(v0[2], s), cf(v0[3], s)); w.z = cvt_pk_bf16(cf(v1[0], s), cf(v1[1], s)); w.w = cvt_pk_bf16(cf(v1[2], s), cf(v1[3], s));
                    *(u32x4*)(rowp + bj * HALF) = w; } }
    }
};

struct EpiResid {
    static constexpr bool PERM = false, AFTER_DRAIN = false;
    const float* xin; float* xout; int ldc; const float* gate; int gpitch; int rows_per_batch; float sc;
    __device__ __forceinline__ void operator()(const f32x4 (&acc)[2][2][4][2], const Unit& u, int wr, int wc, int fr, int fq) const {
        const int row0 = u.pm * BM + wr * 64 + fr, col0 = u.pn * BM + wc * 32 + 4 * fq;
        const float* gp = gate + (size_t)((u.pm * BM) / rows_per_batch) * gpitch + col0;
        f32x4 gv[2][2];
#pragma unroll
        for (int bj = 0; bj < 2; ++bj)
#pragma unroll
            for (int n = 0; n < 2; ++n) gv[bj][n] = *(const f32x4*)(gp + bj * HALF + n * 16) * sc;
#pragma unroll
        for (int ai = 0; ai < 2; ++ai)
#pragma unroll
            for (int m = 0; m < 4; ++m) { const size_t off = (size_t)(row0 + ai * HALF + m * 16) * ldc + col0;
#pragma unroll
                for (int bj = 0; bj < 2; ++bj)
#pragma unroll
                    for (int n = 0; n < 2; ++n) { const f32x4 xi = *(const f32x4*)(xin + off + bj * HALF + n * 16);
                        *(f32x4*)(xout + off + bj * HALF + n * 16) = xi + gv[bj][n] * acc[ai][bj][m][n]; } }
    }
};

template <bool XIN_F32> struct EpiResidB {
    static constexpr bool PERM = true, AFTER_DRAIN = false;
    const void* xin; bf16_t* xout; int ldc; const float* gate; int gpitch; int rows_per_batch; float sc;
    __device__ __forceinline__ static float lo(unsigned u) { return __builtin_bit_cast(float, u << 16); }
    __device__ __forceinline__ static float hi(unsigned u) { return __builtin_bit_cast(float, u & 0xffff0000u); }
    __device__ __forceinline__ void operator()(const f32x4 (&acc)[2][2][4][2], const Unit& u, int wr, int wc, int fr, int fq) const {
        const int row0 = u.pm * BM + wr * 64 + fr, col0 = u.pn * BM + wc * 32 + 8 * fq;
        const float* gp = gate + (size_t)((u.pm * BM) / rows_per_batch) * gpitch + col0;
        f32x4 gv[2][2];
#pragma unroll
        for (int bj = 0; bj < 2; ++bj)
#pragma unroll
            for (int n = 0; n < 2; ++n) gv[bj][n] = *(const f32x4*)(gp + bj * HALF + n * 4) * sc;
#pragma unroll
        for (int ai = 0; ai < 2; ++ai)
#pragma unroll
            for (int m = 0; m < 4; ++m) { const size_t off = (size_t)(row0 + ai * HALF + m * 16) * ldc + col0;
#pragma unroll
                for (int bj = 0; bj < 2; ++bj) { f32x4 x0, x1;
                    if constexpr (XIN_F32) { x0 = *(const f32x4*)((const float*)xin + off + bj * HALF); x1 = *(const f32x4*)((const float*)xin + off + bj * HALF + 4); }
                    else { const u32x4 q = *(const u32x4*)((const bf16_t*)xin + off + bj * HALF); x0 = (f32x4){lo(q.x), hi(q.x), lo(q.y), hi(q.y)}; x1 = (f32x4){lo(q.z), hi(q.z), lo(q.w), hi(q.w)}; }
                    const f32x4 v0 = x0 + gv[bj][0] * acc[ai][bj][m][0], v1 = x1 + gv[bj][1] * acc[ai][bj][m][1];
                    u32x4 w; w.x = cvt_pk_bf16(v0[0], v0[1]); w.y = cvt_pk_bf16(v0[2], v0[3]); w.z = cvt_pk_bf16(v1[0], v1[1]); w.w = cvt_pk_bf16(v1[2], v1[3]);
                    *(u32x4*)(xout + off + bj * HALF) = w; } }
    }
};

struct EpiSwiGLU {
    static constexpr bool PERM = true, AFTER_DRAIN = false;
    bf16_t* O; int ldc; float sc;
    __device__ __forceinline__ float silu_mul(float g, float u) const { g *= sc; u *= sc; return g * u * __builtin_amdgcn_rcpf(1.f + __builtin_amdgcn_exp2f(-1.44269504089f * g)); }
    __device__ __forceinline__ void operator()(const f32x4 (&acc)[2][2][4][2], const Unit& u, int wr, int wc, int fr, int fq) const {
        const int row0 = u.pm * BM + wr * 64 + fr, col0 = u.pn * HALF + wc * 32 + 8 * fq;
#pragma unroll
        for (int ai = 0; ai < 2; ++ai)
#pragma unroll
            for (int m = 0; m < 4; ++m) { bf16_t* rowp = O + (size_t)(row0 + ai * HALF + m * 16) * ldc + col0;
                const f32x4 g0 = acc[ai][0][m][0], g1 = acc[ai][0][m][1], u0 = acc[ai][1][m][0], u1 = acc[ai][1][m][1];
                u32x4 w; w.x = cvt_pk_bf16(silu_mul(g0[0], u0[0]), silu_mul(g0[1], u0[1])); w.y = cvt_pk_bf16(silu_mul(g0[2], u0[2]), silu_mul(g0[3], u0[3]));
                w.z = cvt_pk_bf16(silu_mul(g1[0], u1[0]), silu_mul(g1[1], u1[1])); w.w = cvt_pk_bf16(silu_mul(g1[2], u1[2]), silu_mul(g1[3], u1[3]));
                *(u32x4*)rowp = w; }
    }
};

__device__ __forceinline__ float clamp448(float v) { return __builtin_fminf(__builtin_fmaxf(v, -448.f), 448.f); }
__device__ __forceinline__ unsigned pk4_fp8(float a, float b, float c, float d) { int p = __builtin_amdgcn_cvt_pk_fp8_f32(clamp448(a), clamp448(b), 0, false); p = __builtin_amdgcn_cvt_pk_fp8_f32(clamp448(c), clamp448(d), p, true); return (unsigned)p; }
template <bool OUT8> struct EpiSwiGLUi8 {
    static constexpr bool PERM = true, AFTER_DRAIN = false;
    bf16_t* O; int ldc; const float* rowscale; float wscale;
    __device__ __forceinline__ static float sm(float g, float u) { return g * u * __builtin_amdgcn_rcpf(1.f + __builtin_amdgcn_exp2f(-1.44269504089f * g)); }
    __device__ __forceinline__ static float cf(float bits, float s) { return (float)__builtin_bit_cast(int, bits) * s; }
    __device__ __forceinline__ void operator()(const f32x4 (&acc)[2][2][4][2], const Unit& u, int wr, int wc, int fr, int fq) const {
        const int row0 = u.pm * BM + wr * 64 + fr, col0 = u.pn * HALF + wc * 32 + 8 * fq;
#pragma unroll
        for (int ai = 0; ai < 2; ++ai)
#pragma unroll
            for (int m = 0; m < 4; ++m) { const int r = row0 + ai * HALF + m * 16; const float s = rowscale[r] * wscale;
                const f32x4 g0 = acc[ai][0][m][0], g1 = acc[ai][0][m][1], u0 = acc[ai][1][m][0], u1 = acc[ai][1][m][1];
                const float v0 = sm(cf(g0[0], s), cf(u0[0], s)), v1 = sm(cf(g0[1], s), cf(u0[1], s)), v2 = sm(cf(g0[2], s), cf(u0[2], s)), v3 = sm(cf(g0[3], s), cf(u0[3], s));
                const float v4 = sm(cf(g1[0], s), cf(u1[0], s)), v5 = sm(cf(g1[1], s), cf(u1[1], s)), v6 = sm(cf(g1[2], s), cf(u1[2], s)), v7 = sm(cf(g1[3], s), cf(u1[3], s));
                if constexpr (OUT8) { uint2 w; w.x = pk4_fp8(v0, v1, v2, v3); w.y = pk4_fp8(v4, v5, v6, v7); *(uint2*)((unsigned char*)O + (size_t)r * ldc + col0) = w; }
                else { u32x4 w; w.x = cvt_pk_bf16(v0, v1); w.y = cvt_pk_bf16(v2, v3); w.z = cvt_pk_bf16(v4, v5); w.w = cvt_pk_bf16(v6, v7); *(u32x4*)(O + (size_t)r * ldc + col0) = w; } }
    }
};

struct EpiSwiGLU8 {
    static constexpr bool PERM = true, AFTER_DRAIN = false;
    unsigned char* O; int ldc; float sc;
    __device__ __forceinline__ float sm(float g, float u) const { g *= sc; u *= sc; return g * u * __builtin_amdgcn_rcpf(1.f + __builtin_amdgcn_exp2f(-1.44269504089f * g)); }
    __device__ __forceinline__ void operator()(const f32x4 (&acc)[2][2][4][2], const Unit& u, int wr, int wc, int fr, int fq) const {
        const int row0 = u.pm * BM + wr * 64 + fr, col0 = u.pn * HALF + wc * 32 + 8 * fq;
#pragma unroll
        for (int ai = 0; ai < 2; ++ai)
#pragma unroll
            for (int m = 0; m < 4; ++m) { unsigned char* rowp = O + (size_t)(row0 + ai * HALF + m * 16) * ldc + col0;
                const f32x4 g0 = acc[ai][0][m][0], g1 = acc[ai][0][m][1], u0 = acc[ai][1][m][0], u1 = acc[ai][1][m][1];
                uint2 w; w.x = pk4_fp8(sm(g0[0], u0[0]), sm(g0[1], u0[1]), sm(g0[2], u0[2]), sm(g0[3], u0[3]));
                w.y = pk4_fp8(sm(g1[0], u1[0]), sm(g1[1], u1[1]), sm(g1[2], u1[2]), sm(g1[3], u1[3]));
                *(uint2*)rowp = w; }
    }
};

struct EpiScaleRow {
    static constexpr bool PERM = false, AFTER_DRAIN = false;
    float* C; int ldc; const float* rowscale;
    __device__ __forceinline__ void operator()(const f32x4 (&acc)[2][2][4][2], const Unit& u, int wr, int wc, int fr, int fq) const {
        const int row0 = u.pm * BM + wr * 64 + fr, col0 = u.pn * BM + wc * 32 + 4 * fq;
#pragma unroll
        for (int ai = 0; ai < 2; ++ai)
#pragma unroll
            for (int m = 0; m < 4; ++m) { const int r = row0 + ai * HALF + m * 16; const float s = rowscale[r]; float* rowp = C + (size_t)r * ldc + col0;
#pragma unroll
                for (int bj = 0; bj < 2; ++bj)
#pragma unroll
                    for (int n = 0; n < 2; ++n) *(f32x4*)(rowp + bj * HALF + n * 16) = acc[ai][bj][m][n] * s; }
    }
};

struct EpiScaleRowBf16 {
    static constexpr bool PERM = true, AFTER_DRAIN = false;
    bf16_t* O; int ldc; const float* rowscale;
    __device__ __forceinline__ void operator()(const f32x4 (&acc)[2][2][4][2], const Unit& u, int wr, int wc, int fr, int fq) const {
        const int row0 = u.pm * BM + wr * 64 + fr, col0 = u.pn * BM + wc * 32 + 8 * fq;
#pragma unroll
        for (int ai = 0; ai < 2; ++ai)
#pragma unroll
            for (int m = 0; m < 4; ++m) { const int r = row0 + ai * HALF + m * 16; const float s = rowscale[r]; bf16_t* rowp = O + (size_t)r * ldc + col0;
#pragma unroll
                for (int bj = 0; bj < 2; ++bj) { const f32x4 v0 = acc[ai][bj][m][0] * s, v1 = acc[ai][bj][m][1] * s;
                    u32x4 w; w.x = cvt_pk_bf16(v0[0], v0[1]); w.y = cvt_pk_bf16(v0[2], v0[3]); w.z = cvt_pk_bf16(v1[0], v1[1]); w.w = cvt_pk_bf16(v1[2], v1[3]);
                    *(u32x4*)(rowp + bj * HALF) = w; } }
    }
};

template <size_t OFF_Y, size_t OFF_ROWP, size_t OFF_PART, int LDC> struct EpiMoeDown {
    static constexpr bool PERM = true, AFTER_DRAIN = false;
    unsigned char* ws;
    __device__ __forceinline__ void operator()(const f32x4 (&acc)[2][2][4][2], const Unit& u, int wr, int wc, int fr, int fq) const {
        const int rl0 = wr * 64 + fr, cl0 = wc * 32 + 8 * fq; constexpr int ldc = LDC;
        bf16_t* O = (bf16_t*)(ws + OFF_Y); const float* rowscale = (const float*)(ws + OFF_ROWP); float* part = (float*)(ws + OFF_PART);
        if (u.part < 0) {
#pragma unroll
            for (int ai = 0; ai < 2; ++ai)
#pragma unroll
                for (int m = 0; m < 4; ++m) { const int r = u.pm * BM + rl0 + ai * HALF + m * 16; const float s = rowscale[r]; bf16_t* rowp = O + (size_t)r * ldc + u.pn * BM + cl0;
#pragma unroll
                    for (int bj = 0; bj < 2; ++bj) { const f32x4 v0 = acc[ai][bj][m][0] * s, v1 = acc[ai][bj][m][1] * s;
                        u32x4 w; w.x = cvt_pk_bf16(v0[0], v0[1]); w.y = cvt_pk_bf16(v0[2], v0[3]); w.z = cvt_pk_bf16(v1[0], v1[1]); w.w = cvt_pk_bf16(v1[2], v1[3]);
                        *(u32x4*)(rowp + bj * HALF) = w; } }
        } else {
            float* pb = part + (size_t)u.part * 65536;
#pragma unroll
            for (int ai = 0; ai < 2; ++ai)
#pragma unroll
                for (int m = 0; m < 4; ++m) { const int rl = rl0 + ai * HALF + m * 16; const float s = rowscale[u.pm * BM + rl]; float* rowp = pb + rl * 256 + cl0;
#pragma unroll
                    for (int bj = 0; bj < 2; ++bj) { *(f32x4*)(rowp + bj * HALF) = acc[ai][bj][m][0] * s; *(f32x4*)(rowp + bj * HALF + 4) = acc[ai][bj][m][1] * s; } }
        }
    }
};

__device__ __forceinline__ int moe_unremap(int wgid, int nwg) {
    const int q = nwg / NXCD, r = nwg % NXCD; int xcd, off;
    if (wgid < r * (q + 1)) { xcd = wgid / (q + 1); off = wgid - xcd * (q + 1); } else { const int w = wgid - r * (q + 1); xcd = r + w / q; off = w - (xcd - r) * q; }
    return off * NXCD + xcd;
}
__device__ __forceinline__ void moe_split_plan(int nwg, int G, int ktiles, int& nfull, int& nleft, int& S) {
    nfull = nwg; nleft = 0; S = 1;
    if (G == 256) { const int rounds = nwg / G, rem = nwg - rounds * G;
        if (rounds >= 1 && rem > 0 && rem <= 64) { const int s = (rem <= 36) ? 7 : 4; if (ktiles % (2 * s) == 0) { S = s; nfull = rounds * G; nleft = rem; } } }
}
template <bool SPLIT> struct MoeOrderT {
    static constexpr bool VARK = SPLIT;
    int tc[9]; int nN, G, c; unsigned estride;
    int ntfull, nfull, nleft, S, kslice;
    __device__ __forceinline__ void plan(int ktiles, int kbytes) { ntfull = ktiles; nfull = tc[8] * nN; nleft = 0; S = 1; kslice = 0;
        if (SPLIT) { moe_split_plan(tc[8] * nN, G, ktiles, nfull, nleft, S); kslice = kbytes / S; } }
    __device__ __forceinline__ bool next(int i, Unit& u) const {
        const int nwg = tc[8] * nN; int L = i * G + c; int s = 0, slot = -1;
        if (SPLIT && L >= nfull) { const int t = L - nfull; if (t >= nleft * S) return false; s = t % S; slot = t; L = nfull + t / S; }
        if (L >= nwg) return false;
        int wgid = L; { const int q = nwg / NXCD, r = nwg % NXCD, xcd = wgid % NXCD, off = wgid / NXCD; wgid = (xcd < r ? xcd * (q + 1) : r * (q + 1) + (xcd - r) * q) + off; }
        int e = 0, start = 0, nt = tc[1];
#pragma unroll
        for (int k = 1; k < 8; ++k) { if (wgid >= tc[k] * nN) { e = k; start = tc[k]; nt = tc[k + 1] - tc[k]; } }
        const int r2 = wgid - start * nN;
        u.pn = r2 / nt; u.pm = start + r2 % nt; u.aoff = (unsigned)(s * kslice); u.boff = (size_t)((unsigned)e * estride + (unsigned)(s * kslice)); u.nt = (slot >= 0) ? ntfull / S : ntfull; u.part = slot; return true;
    }
    __device__ __forceinline__ void a_ready(const Unit&) const {}
    __device__ __forceinline__ void done(const Unit&) const {}
};
typedef MoeOrderT<false> MoeOrder;

template <class Epi, class Sched, bool ALIGN_EPI = false, bool SP2 = false, int MODE = 0>
__device__ __forceinline__ void gemm_phase(PG8_LAS unsigned char* lds, const Gemm g, const Sched& S, const Epi& E, const int tid_in) {
    constexpr bool F8 = (MODE == 1);
    const int tid = tid_in, wid = __builtin_amdgcn_readfirstlane(tid >> 6), lane = tid & 63, wr = wid >> 2, wc = wid & 3, fr = lane & 15, fq = lane >> 4;
    const int K = g.K, nt = K / BK;
    unsigned voffA[2], voffB[2];
#pragma unroll
    for (int i = 0; i < 2; ++i) { int R, C; stage_rc(tid * 16 + i * 8192, R, C); const int Rb = Epi::PERM ? ((R & ~31) + perm32(R & 31)) : R;
        voffA[i] = (unsigned)(R * K + C) * 2u; voffB[i] = (unsigned)(Rb * K + C) * 2u; }
    const size_t kstep = (size_t)(BK * 2);
    const size_t hstep = (size_t)HALF * K * 2;
    const size_t tstep = 2 * hstep;
    const unsigned ldsbase = (unsigned)__builtin_amdgcn_readfirstlane((int)((unsigned)(uintptr_t)lds + (unsigned)wid * 1024u));
    const unsigned ldsw = (unsigned)wid * 1024u;
    const int aoff = lds_byte(wr * 64 + fr, fq * 8), boff = lds_byte(wc * 32 + fr, fq * 8);
#define PG8_SA(b, h) (((b) * 2 + (h)) * HTB)
#define PG8_SB(b, h) ((4 + (b) * 2 + (h)) * HTB)
#define PG8_STAGE(bufoff, gbase, voff) do { _Pragma("unroll") for (int _i = 0; _i < 2; ++_i) { \
        if constexpr (F8) { unsigned keep_; asm volatile("s_mov_b32 %0, m0\n\ts_mov_b32 m0, %3\n\ts_nop 0\n\tglobal_load_lds_dwordx4 %1, %2\n\ts_mov_b32 m0, %0" : "=&s"(keep_) : "v"((voff)[_i]), "s"((const char*)(gbase)), "s"(ldsbase + (unsigned)((bufoff) + _i * 8192)) : "memory"); } \
        else __builtin_amdgcn_global_load_lds((const unsigned*)((const char*)(gbase) + (voff)[_i]), (PG8_LAS unsigned*)(lds + (bufoff) + ldsw + _i * 8192), 16, 0, 0); } } while (0)
#define PG8_LDA(dst, b, h) do { _Pragma("unroll") for (int m = 0; m < 4; ++m) _Pragma("unroll") for (int k = 0; k < 2; ++k) dst[m][k] = *(const PG8_LAS bf16x8*)(lds + PG8_SA(b, h) + aoff + m * 2048 + k * 1024); } while (0)
#define PG8_LDB(dst, b, h) do { _Pragma("unroll") for (int n = 0; n < 2; ++n) _Pragma("unroll") for (int k = 0; k < 2; ++k) dst[n][k] = *(const PG8_LAS bf16x8*)(lds + PG8_SB(b, h) + boff + n * 2048 + k * 1024); } while (0)
#define PG8_CAT8(x) __builtin_shufflevector(__builtin_bit_cast(v4i_t, (x)[0]), __builtin_bit_cast(v4i_t, (x)[1]), 0, 1, 2, 3, 4, 5, 6, 7)
#define PG8_MMA(ai, bj, At, Bt) do { __builtin_amdgcn_s_setprio(1); _Pragma("unroll") for (int m = 0; m < 4; ++m) _Pragma("unroll") for (int n = 0; n < 2; ++n) { \
        if constexpr (F8) { acc[ai][bj][m][n] = __builtin_amdgcn_mfma_scale_f32_16x16x128_f8f6f4(PG8_CAT8(Bt[n]), PG8_CAT8(At[m]), acc[ai][bj][m][n], 0, 0, 0, 0x7F7F7F7F, 0, 0x7F7F7F7F); } \
        else if constexpr (MODE == 2) { _Pragma("unroll") for (int k = 0; k < 2; ++k) acc[ai][bj][m][n] = __builtin_bit_cast(f32x4, __builtin_amdgcn_mfma_i32_16x16x64_i8(__builtin_bit_cast(v4i_t, Bt[n][k]), __builtin_bit_cast(v4i_t, At[m][k]), __builtin_bit_cast(v4i_t, acc[ai][bj][m][n]), 0, 0, 0)); } \
        else { _Pragma("unroll") for (int k = 0; k < 2; ++k) acc[ai][bj][m][n] = __builtin_amdgcn_mfma_f32_16x16x32_bf16(Bt[n][k], At[m][k], acc[ai][bj][m][n], 0, 0, 0); } } __builtin_amdgcn_s_setprio(0); } while (0)
#define PG8_WAIT_V(n) asm volatile("s_waitcnt vmcnt(" #n ")" ::: "memory")
#define PG8_WAIT_L(n) asm volatile("s_waitcnt lgkmcnt(" #n ")" ::: "memory")
#define PG8_BAR __builtin_amdgcn_s_barrier()
#define PG8_SCHED __builtin_amdgcn_sched_barrier(0)
    Unit cur, nxt; int ui = 0;
    if (!S.next(0, cur)) return;
    f32x4 acc[2][2][4][2];
#pragma unroll
    for (int a = 0; a < 2; ++a)
#pragma unroll
        for (int b = 0; b < 2; ++b)
#pragma unroll
            for (int m = 0; m < 4; ++m)
#pragma unroll
                for (int n = 0; n < 2; ++n) acc[a][b][m][n] = (f32x4){0.f, 0.f, 0.f, 0.f};
    bf16x8 At[4][2], B0[2][2], B1[2][2];
    int ntc = nt; if constexpr (Sched::VARK) ntc = cur.nt;
    const char* cA = (const char*)g.A + (size_t)cur.pm * tstep + (Sched::VARK ? cur.aoff : 0u); const char* cB = (const char*)g.Bt + (size_t)cur.pn * tstep + cur.boff;
    S.a_ready(cur);
    if constexpr (SP2) {
        PG8_STAGE(PG8_SB(0, 0), cB, voffB); PG8_STAGE(PG8_SB(0, 1), cB + hstep, voffB); PG8_STAGE(PG8_SA(0, 0), cA, voffA); PG8_STAGE(PG8_SA(0, 1), cA + hstep, voffA);
        if (wr == 1) PG8_BAR;
        PG8_WAIT_V(2); PG8_BAR;
        PG8_STAGE(PG8_SB(1, 0), cB + kstep, voffB); PG8_STAGE(PG8_SA(1, 0), cA + kstep, voffA); PG8_STAGE(PG8_SB(1, 1), cB + hstep + kstep, voffB);
        PG8_WAIT_V(6); PG8_BAR;
    } else {
        PG8_STAGE(PG8_SB(0, 0), cB, voffB); PG8_STAGE(PG8_SA(0, 0), cA, voffA); PG8_STAGE(PG8_SB(0, 1), cB + hstep, voffB); PG8_STAGE(PG8_SA(0, 1), cA + hstep, voffA);
        if (wr == 1) PG8_BAR;
        PG8_WAIT_V(4); PG8_BAR;
        PG8_STAGE(PG8_SB(1, 0), cB + kstep, voffB); PG8_STAGE(PG8_SA(1, 0), cA + kstep, voffA); PG8_STAGE(PG8_SB(1, 1), cB + hstep + kstep, voffB);
        PG8_WAIT_V(6); PG8_BAR;
    }
    for (;;) {
        const bool has_next = S.next(ui + 1, nxt);
        const char* nA = has_next ? (const char*)g.A + (size_t)nxt.pm * tstep + (Sched::VARK ? nxt.aoff : 0u) : cA; const char* nB = has_next ? (const char*)g.Bt + (size_t)nxt.pn * tstep + nxt.boff : cB;
        for (int t = 0; t < ntc; t += 2) {
            const bool last = (t == ntc - 2);
            const char* a1 = cA + (size_t)(t + 1) * kstep;
            const char* a2 = last ? nA : cA + (size_t)(t + 2) * kstep; const char* b2 = last ? nB : cB + (size_t)(t + 2) * kstep;
            const char* a3 = a2 + kstep; const char* b3 = b2 + kstep;
            if (last && has_next) S.a_ready(nxt);
            if constexpr (SP2) {
            PG8_LDB(B0, 0, 0); PG8_LDB(B1, 0, 1); PG8_SCHED; PG8_LDA(At, 0, 0); PG8_STAGE(PG8_SA(1, 1), a1 + hstep, voffA);
            PG8_WAIT_V(8); PG8_WAIT_L(0); PG8_BAR; PG8_MMA(0, 0, At, B0); PG8_MMA(0, 1, At, B1); PG8_BAR; PG8_SCHED;
            PG8_LDA(At, 0, 1); PG8_STAGE(PG8_SB(0, 0), b2, voffB); PG8_STAGE(PG8_SB(0, 1), b2 + hstep, voffB); PG8_STAGE(PG8_SA(0, 0), a2, voffA);
            PG8_WAIT_V(8); PG8_WAIT_L(0); PG8_BAR; PG8_MMA(1, 0, At, B0); PG8_MMA(1, 1, At, B1); PG8_BAR; PG8_SCHED;
            PG8_LDB(B0, 1, 0); PG8_LDB(B1, 1, 1); PG8_SCHED; PG8_LDA(At, 1, 0); PG8_STAGE(PG8_SA(0, 1), a2 + hstep, voffA);
            PG8_WAIT_V(8); PG8_WAIT_L(0); PG8_BAR; PG8_MMA(0, 0, At, B0); PG8_MMA(0, 1, At, B1); PG8_BAR; PG8_SCHED;
            PG8_LDA(At, 1, 1); PG8_STAGE(PG8_SB(1, 0), b3, voffB); PG8_STAGE(PG8_SB(1, 1), b3 + hstep, voffB); PG8_STAGE(PG8_SA(1, 0), a3, voffA);
            PG8_WAIT_V(8); PG8_WAIT_L(0); PG8_BAR; PG8_MMA(1, 0, At, B0); PG8_MMA(1, 1, At, B1); PG8_BAR; PG8_SCHED;
            } else {
            PG8_LDB(B0, 0, 0); PG8_SCHED; PG8_LDA(At, 0, 0); PG8_STAGE(PG8_SA(1, 1), a1 + hstep, voffA);
            PG8_WAIT_L(8); PG8_BAR; PG8_WAIT_L(0); PG8_MMA(0, 0, At, B0); PG8_BAR; PG8_SCHED;
            PG8_LDB(B1, 0, 1); PG8_STAGE(PG8_SB(0, 0), b2, voffB);
            PG8_BAR; PG8_WAIT_L(0); PG8_MMA(0, 1, At, B1); PG8_BAR;
            PG8_LDA(At, 0, 1); PG8_STAGE(PG8_SA(0, 0), a2, voffA);
            PG8_BAR; PG8_WAIT_L(0); PG8_MMA(1, 0, At, B0); PG8_BAR; PG8_SCHED;
            PG8_STAGE(PG8_SB(0, 1), b2 + hstep, voffB);
            PG8_WAIT_V(6); PG8_BAR; PG8_MMA(1, 1, At, B1); PG8_BAR;
            PG8_LDB(B0, 1, 0); PG8_SCHED; PG8_LDA(At, 1, 0); PG8_STAGE(PG8_SA(0, 1), a2 + hstep, voffA);
            PG8_WAIT_L(8); PG8_BAR; PG8_WAIT_L(0); PG8_MMA(0, 0, At, B0); PG8_BAR; PG8_SCHED;
            PG8_LDB(B1, 1, 1); PG8_STAGE(PG8_SB(1, 0), b3, voffB);
            PG8_BAR; PG8_WAIT_L(0); PG8_MMA(0, 1, At, B1); PG8_BAR;
            PG8_LDA(At, 1, 1); PG8_STAGE(PG8_SA(1, 0), a3, voffA);
            PG8_BAR; PG8_WAIT_L(0); PG8_MMA(1, 0, At, B0); PG8_BAR; PG8_SCHED;
            PG8_STAGE(PG8_SB(1, 1), b3 + hstep, voffB);
            PG8_WAIT_V(6); PG8_BAR; PG8_MMA(1, 1, At, B1); PG8_BAR;
            }
        }
        if constexpr (ALIGN_EPI) { if (wr == 0) PG8_BAR; }
        if constexpr (!Epi::AFTER_DRAIN) { int t2_ = tid; asm volatile("" : "+v"(t2_)); const int l2_ = t2_ & 63;
            E(acc, cur, wr, wc, l2_ & 15, l2_ >> 4); S.done(cur); }
        if (!has_next) break;
#pragma unroll
        for (int a = 0; a < 2; ++a)
#pragma unroll
            for (int b = 0; b < 2; ++b)
#pragma unroll
                for (int m = 0; m < 4; ++m)
#pragma unroll
                    for (int n = 0; n < 2; ++n) acc[a][b][m][n] = (f32x4){0.f, 0.f, 0.f, 0.f};
        cur = nxt; cA = nA; cB = nB; ++ui; if constexpr (Sched::VARK) ntc = cur.nt;
        if constexpr (ALIGN_EPI) { if (wr == 1) PG8_BAR; }
    }
    PG8_WAIT_V(0);
    if constexpr (!ALIGN_EPI) { if (wr == 0) PG8_BAR; }
    PG8_BAR;
    if constexpr (Epi::AFTER_DRAIN) { E.fused(acc, cur, wr, wc, fr, fq, lds, wid, lane); S.done(cur); }
#undef PG8_SA
#undef PG8_SB
#undef PG8_STAGE
#undef PG8_LDA
#undef PG8_LDB
#undef PG8_MMA
#undef PG8_CAT8
#undef PG8_WAIT_V
#undef PG8_WAIT_L
#undef PG8_BAR
#undef PG8_SCHED
}
}
#define GAS __attribute__((address_space(1)))
#define LAS __attribute__((address_space(3)))
typedef unsigned short bf16;
typedef unsigned v4u __attribute__((ext_vector_type(4)));
typedef float f32x4 __attribute__((ext_vector_type(4)));
typedef short bf16x8 __attribute__((ext_vector_type(8)));
typedef GAS unsigned gu32;
typedef GAS unsigned long long gu64;
#define RLX_AGENT __ATOMIC_RELAXED, __HIP_MEMORY_SCOPE_AGENT
#define LDS_WAIT() asm volatile("s_waitcnt lgkmcnt(0)" ::: "memory")
#define VM_WAIT() asm volatile("s_waitcnt vmcnt(0)" ::: "memory")
__device__ __forceinline__ unsigned long long rt() { return __builtin_amdgcn_s_memrealtime(); }
__device__ __forceinline__ unsigned f2bf(float f) { unsigned u = __builtin_bit_cast(unsigned, f); return (u + 0x7fffu + ((u >> 16) & 1u)) >> 16; }
__device__ __forceinline__ unsigned pk2(float lo, float hi) { return f2bf(lo) | (f2bf(hi) << 16); }

#define XB_TMO      128
#define XB_XCNT(j)  (256  + 64 * (j))
#define XB_XSUB(j)  (1280 + 64 * (j))
#define XB_XGEN(j)  (2304 + 64 * (j))
#define XB_TOP      3328
#define XB_TOPGEN   3392
#define XCD_BAR_WORDS 3456
#define XB_SPIN_CAP (1u << 18)

__device__ __forceinline__ unsigned xb_ld(unsigned* p)              { return __hip_atomic_load(p, __ATOMIC_RELAXED, __HIP_MEMORY_SCOPE_AGENT); }
__device__ __forceinline__ unsigned xb_add(unsigned* p, unsigned v) { return __hip_atomic_fetch_add(p, v, __ATOMIC_RELAXED, __HIP_MEMORY_SCOPE_AGENT); }
__device__ __forceinline__ unsigned xb_xcc_id() { return (unsigned)__builtin_amdgcn_s_getreg((3 << 11) | 20) & 0xFu; }
#define XB_SPIN(cond, bar) do { unsigned _sp = 0; while (cond) { __builtin_amdgcn_s_sleep(1); \
    if ((++_sp & 255u) == 0u) { if (xb_ld(&(bar)[XB_TMO])) break; if (_sp > XB_SPIN_CAP) { atomicAdd(&(bar)[XB_TMO], 1u); break; } } } } while (0)

struct XcdBarrier {
    unsigned* bar; unsigned x;
    volatile LAS unsigned* st;
};

__device__ __forceinline__ XcdBarrier xcd_barrier_post(unsigned* bar, volatile LAS unsigned* st, const int xb_tid) {
    XcdBarrier b; b.bar = bar; b.x = xb_xcc_id(); b.st = st;
    if (xb_tid == 0) (void)xb_add(&bar[XB_XCNT(b.x)], 1u);
    return b;
}
__device__ __forceinline__ void xcd_barrier_complete(unsigned* bar, unsigned x, unsigned& nloc, unsigned& nx) {
    const unsigned G = gridDim.x * gridDim.y * gridDim.z;
    unsigned sum, cnt, mine, sp = 0u;
    for (;;) {
        sum = 0u; cnt = 0u; mine = 0u;
#pragma unroll
        for (unsigned j = 0; j < 16; ++j) { const unsigned c = xb_ld(&bar[XB_XCNT(j)]); sum += c; cnt += (c > 0u) ? 1u : 0u; mine = (j == x) ? c : mine; }
        if (sum == G) break;
        __builtin_amdgcn_s_sleep(1);
        if ((++sp & 255u) == 0u) { if (xb_ld(&bar[XB_TMO])) break; if (sp > XB_SPIN_CAP) { atomicAdd(&bar[XB_TMO], 1u); break; } }
    }
    nloc = mine > 0u ? mine : 1u; nx = cnt > 0u ? cnt : 1u;
}

__device__ __forceinline__ void xcd_barrier(const XcdBarrier& b, const int xb_tid) {
    asm volatile("s_waitcnt vmcnt(0)" ::: "memory");
    __syncthreads();
    if (xb_tid == 0) {
        unsigned* bar = b.bar;
        __builtin_amdgcn_s_waitcnt(0);
        unsigned nloc = b.st[0], nx = b.st[1];
        if (nloc == 0u) { xcd_barrier_complete(bar, b.x, nloc, nx); b.st[0] = nloc; b.st[1] = nx; }
        const unsigned old = xb_add(&bar[XB_XSUB(b.x)], 1u);
        const unsigned gen = old / nloc;
        if (old + 1u == (gen + 1u) * nloc) {
            __builtin_amdgcn_fence(__ATOMIC_RELEASE, "agent");
            asm volatile("s_waitcnt vmcnt(0)" ::: "memory");
            const unsigned og = xb_add(&bar[XB_TOP], 1u);
            const unsigned tg = og / nx;
            if (og + 1u == (tg + 1u) * nx) xb_add(&bar[XB_TOPGEN], 1u);
            else XB_SPIN(xb_ld(&bar[XB_TOPGEN]) == tg, bar);
            __builtin_amdgcn_fence(__ATOMIC_ACQUIRE, "agent");
            xb_add(&bar[XB_XGEN(b.x)], 1u);
            asm volatile("s_waitcnt vmcnt(0)" ::: "memory");
        } else {
            XB_SPIN(xb_ld(&bar[XB_XGEN(b.x)]) == gen, bar);
            __builtin_amdgcn_fence(__ATOMIC_ACQUIRE, "agent");
            asm volatile("s_waitcnt vmcnt(0)" ::: "memory");
        }
    }
    __syncthreads();
}


constexpr int NWAVES = 8, NTHR = 512;
constexpr int BATCH = 4, SEQ = 2048, DM = 2048, MTOK = BATCH * SEQ;
constexpr int EVEN_IN = 5120, NSA_IN = 5168, NSA_INP = 5376, DFF = 7168, NEXP = 8, MOE_ROWS = 18432;
constexpr int NCMP = 127;
constexpr float EPS = 1e-6f, QSCALE = 0.08838834764831845f;
constexpr int E_Q = 0, E_K = 1024, E_V = 2048, E_XR = 3072, E_GR = 4096;
constexpr int N_Q = 0, N_KC = 2048, N_VC = 2560, N_KS = 3072, N_VS = 3584, N_KW = 4096, N_VW = 4608, N_G = 5120;
#ifndef MK_N_LAUNCHES
#define MK_N_LAUNCHES 1
#endif
constexpr int NPH = 19;
constexpr int N_LAUNCHES = MK_N_LAUNCHES;

constexpr size_t MiB = 1u << 20;
constexpr size_t WS_CTL = 0, CTL_ZERO_BYTES = 1 * MiB;
constexpr size_t WS_MOD = 1 * MiB;
constexpr size_t WS_ROUTE = 2 * MiB;
constexpr size_t WS_ROWP = 2 * MiB + 512 * 1024;
constexpr size_t WS_KCMP = 3 * MiB, WS_VCMP = 4 * MiB;
constexpr size_t WS_KCMPB = 6 * MiB, WS_VCMPB = 6 * MiB + 512 * 1024;
constexpr size_t WS_WC1K = 149 * MiB, WS_WC1V = 7 * MiB, WS_WC2K = 2 * MiB + 768 * 1024, WS_WC2V = WS_WC2K + 32768, WS_CMPPB = WS_WC2V + 32768;
constexpr size_t WS_ROWSA = 2 * MiB + 896 * 1024;
constexpr size_t WS_SUMP = 5 * MiB, WS_SUMH = 5 * MiB + 512 * 1024;
constexpr size_t WS_WIN0 = 8 * MiB, WS_WOUT0 = 28 * MiB, WS_WGU0 = 36 * MiB, WS_WDN0 = 92 * MiB, WS_WIN1 = 120 * MiB, WS_WOUT1 = 141 * MiB;
constexpr size_t WS_WMGU = 150 * MiB, WS_WMDN = 598 * MiB;
constexpr size_t WS_XA = 822 * MiB, WS_XB = 886 * MiB, WS_H = 950 * MiB, WS_PROJ = 982 * MiB, WS_MIX = 1066 * MiB;
constexpr size_t WS_ACT = 1098 * MiB, WS_HPERM = 1350 * MiB, WS_Y = 1422 * MiB, WS_PART = 1566 * MiB  , WS_END = 1632 * MiB;
constexpr size_t WS_HL = WS_ACT, WS_PC = WS_ACT + 32 * MiB;
constexpr int CW_TMO = 0, CW_CODE = 1, CW_BAR = 4096, CW_CNT = 8192  , CW_TILE = 12288  , CW_WMAX = 12352  ;

constexpr int RING_OFF = 0, RING_BYTES = 131072;
constexpr int LDSCTL_OFF = 147456 - 448, MISC_OFF = LDSCTL_OFF + 320;
constexpr int LDS_BYTES = 147456;

struct Frame {
    LAS unsigned char* lds;
    volatile LAS unsigned* MISC;
    gu32* ctl;
    int tid, lane, wave;
    int vcu, G;
    const float *x, *c, *ada_mix_w, *ada_mix_b, *norm_mix_g, *ada_ffn_w, *ada_ffn_b, *norm_ffn_g;
    const float *even_in_w, *rg_conv_w, *rg_conv_b, *rg_wa, *rg_ba, *rg_wx, *rg_bx, *rg_lambda, *even_out_w;
    const float *dense_w_gate, *dense_w_up, *dense_w_down, *nsa_in_w, *cmp_pos_k, *cmp_pos_v, *cmp_k_w1, *cmp_k_w2, *cmp_v_w1, *cmp_v_w2;
    const float *nsa_out_w, *router_w, *moe_w_gate, *moe_w_up, *moe_w_down, *final_norm_g;
    float* out;
    bf16 *Win0, *Wout0, *Wgu0, *Wdn0, *Win1, *Wout1, *Wmgu, *Wmdn;
    float *mod, *xa, *xb, *kcmp, *vcmp, *sumP, *sumH, *hl, *pc, *y, *rowp;
    int* route;
    bf16 *h, *proj, *mix, *act, *hperm, *kcmpb, *vcmpb, *Wc1k, *Wc1v, *Wc2k, *Wc2v;
    float* cmp_pb; float* rowsa; float* part;
};

__device__ __forceinline__ float wave_sum(float v) {
#pragma unroll
    for (int o = 1; o < 64; o <<= 1) v += __shfl_xor(v, o);
    return v;
}
__device__ __forceinline__ float grp8_sum(float v) { v += __shfl_xor(v, 1); v += __shfl_xor(v, 2); v += __shfl_xor(v, 4); return v; }
__device__ __forceinline__ float bflo(unsigned u) { return __builtin_bit_cast(float, u << 16); }
__device__ __forceinline__ float bfhi(unsigned u) { return __builtin_bit_cast(float, u & 0xffff0000u); }
__device__ __forceinline__ float bf1(bf16 u) { return __builtin_bit_cast(float, ((unsigned)u) << 16); }
__device__ __forceinline__ void ld16bf(const bf16* p, float (&o)[16]) {
    const v4u a = *(const v4u*)p, b = *(const v4u*)(p + 8);
    o[0] = bflo(a.x); o[1] = bfhi(a.x); o[2] = bflo(a.y); o[3] = bfhi(a.y); o[4] = bflo(a.z); o[5] = bfhi(a.z); o[6] = bflo(a.w); o[7] = bfhi(a.w);
    o[8] = bflo(b.x); o[9] = bfhi(b.x); o[10] = bflo(b.y); o[11] = bfhi(b.y); o[12] = bflo(b.z); o[13] = bfhi(b.z); o[14] = bflo(b.w); o[15] = bfhi(b.w);
}
__device__ __forceinline__ void st16bf(bf16* p, const float (&o)[16]) {
    v4u a, b; a.x = pk2(o[0], o[1]); a.y = pk2(o[2], o[3]); a.z = pk2(o[4], o[5]); a.w = pk2(o[6], o[7]);
    b.x = pk2(o[8], o[9]); b.y = pk2(o[10], o[11]); b.z = pk2(o[12], o[13]); b.w = pk2(o[14], o[15]);
    *(v4u*)p = a; *(v4u*)(p + 8) = b;
}
__device__ __forceinline__ float sigmoidf_(float v) { return 1.f / (1.f + __expf(-v)); }
__device__ __forceinline__ float logsigf_(float z) { return fminf(z, 0.f) - __logf(1.f + __expf(-fabsf(z))); }
__device__ __forceinline__ float gelu_tanh(float v) { const float u = 0.7978845608028654f * (v + 0.044715f * v * v * v); const float t = 1.f - 2.f / (1.f + __expf(2.f * u)); return 0.5f * v * (1.f + t); }

__device__ __forceinline__ void p0_adaln(Frame& F) {
    LAS float* sc = (LAS float*)(F.lds);
    LAS float* red = (LAS float*)(F.lds + 32768);
    __syncthreads();
    for (int i = F.tid; i < BATCH * DM; i += NTHR) { const float v = F.c[i]; sc[i] = v / (1.f + __expf(-v)); }
    __syncthreads();
    for (int u = F.vcu; u < 384; u += F.G) {
        const int j = u / 96, cb = u % 96;
        const float* W = ((j & 1) ? F.ada_ffn_w : F.ada_mix_w) + (size_t)(j >> 1) * DM * 6144;
        const float* Bv = ((j & 1) ? F.ada_ffn_b : F.ada_mix_b) + (size_t)(j >> 1) * 6144;
        const int r = F.lane >> 4, cx = (F.lane & 15) * 4;
        float acc[4][4];
#pragma unroll
        for (int b = 0; b < 4; ++b)
#pragma unroll
            for (int q = 0; q < 4; ++q) acc[b][q] = 0.f;
        const int kbase = F.wave * 256;
#pragma unroll 8
        for (int i = 0; i < 64; ++i) {
            const int k = kbase + 4 * i + r;
            const f32x4 w = *(const f32x4*)(W + (size_t)k * 6144 + cb * 64 + cx);
#pragma unroll
            for (int b = 0; b < 4; ++b) { const float s = sc[b * DM + k]; acc[b][0] += s * w.x; acc[b][1] += s * w.y; acc[b][2] += s * w.z; acc[b][3] += s * w.w; }
        }
#pragma unroll
        for (int b = 0; b < 4; ++b)
#pragma unroll
            for (int q = 0; q < 4; ++q) { float v = acc[b][q]; v += __shfl_xor(v, 16); v += __shfl_xor(v, 32); acc[b][q] = v; }
        if (F.lane < 16) {
#pragma unroll
            for (int b = 0; b < 4; ++b)
#pragma unroll
                for (int q = 0; q < 4; ++q) red[(F.wave * 4 + b) * 64 + cx + q] = acc[b][q];
        }
        __syncthreads();
        if (F.tid < 256) { const int b = F.tid >> 6, col = F.tid & 63; float s = 0.f;
#pragma unroll
            for (int w = 0; w < 8; ++w) s += red[(w * 4 + b) * 64 + col];
            F.mod[(size_t)(j * 4 + b) * 6144 + cb * 64 + col] = s + Bv[cb * 64 + col]; }
        __syncthreads();
    }
}

struct CvtDesc { const float* src; unsigned char* dst; int N, K, n0, mode, f8; float qs; };
#ifndef FP8_DUP
#define FP8_DUP 0
#endif
#ifndef FP8_P13
#define FP8_P13 0
#endif
#ifndef I8_P2
#define I8_P2 0
#endif
#ifndef I8_P10
#define I8_P10 1
#endif
#ifndef I8_DUP
#define I8_DUP 1
#endif
#ifndef FP8_DDN
#define FP8_DDN 1
#endif
#ifndef FP8_MOE
#define FP8_MOE 1
#endif
constexpr float W8_PRESCALE = 64.f, W8_INV = 1.f / 64.f;
constexpr int CVT_NMAT = 10;
__device__ __forceinline__ bool cvt_decode(const Frame& F, int it, CvtDesc& d) {
    constexpr int C0 = 2560, C1 = C0 + 1024, C2 = C1 + 3584, C3 = C2 + 3584, C4 = C3 + 3584, C5 = C4 + 2592, C6 = C5 + 1024, C7 = C6 + 128, C8 = C7 + 128, C9 = C8 + 4, C10 = C9 + 4, C11 = C10 + 28672, C12 = C11 + 28672, C13 = C12 + 28672;
    if (it >= C13) return false;
    const float* src; bf16* dst; int K, N, mode = 0, r, f8 = 0; size_t dstb = 0;
    if (it < C0) { src = F.even_in_w; dst = F.Win0; K = DM; N = EVEN_IN; r = it; f8 = I8_P2 ? 2 : 0; }
    else if (it < C1) { src = F.even_out_w; dst = F.Wout0; K = DM; N = DM; r = it - C0; }
    else if (it < C2) { src = F.dense_w_gate; dst = F.Wgu0; f8 = I8_DUP ? 2 : FP8_DUP; K = DM; N = DFF; mode = 1; r = it - C1; }
    else if (it < C3) { src = F.dense_w_up; dst = F.Wgu0; f8 = I8_DUP ? 2 : FP8_DUP; K = DM; N = DFF; mode = 2; r = it - C2; }
    else if (it < C4) { src = F.dense_w_down; dst = F.Wdn0; f8 = FP8_DDN; K = DFF; N = DM; r = it - C3; }
    else if (it < C5) { src = F.nsa_in_w; dst = F.Win1; K = DM; N = NSA_IN; r = it - C4; f8 = I8_P10 ? 2 : 0; }
    else if (it < C6) { src = F.nsa_out_w; dst = F.Wout1; K = DM; N = DM; r = it - C5; f8 = FP8_P13; }
    else if (it < C7) { src = F.cmp_k_w1; dst = F.Wc1k; K = 2048; N = 128; r = it - C6; dstb = (size_t)128 * 2048; }
    else if (it < C8) { src = F.cmp_v_w1; dst = F.Wc1v; K = 2048; N = 128; r = it - C7; dstb = (size_t)128 * 2048; }
    else if (it < C9) { src = F.cmp_k_w2; dst = F.Wc2k; K = 128; N = 128; r = it - C8; }
    else if (it < C10) { src = F.cmp_v_w2; dst = F.Wc2v; K = 128; N = 128; r = it - C9; }
    else if (it < C11) { src = F.moe_w_gate; dst = F.Wmgu; f8 = FP8_MOE; K = DM; N = DFF; mode = 1; r = it - C10; dstb = (size_t)2 * DFF * DM; }
    else if (it < C12) { src = F.moe_w_up; dst = F.Wmgu; f8 = FP8_MOE; K = DM; N = DFF; mode = 2; r = it - C11; dstb = (size_t)2 * DFF * DM; }
    else { src = F.moe_w_down; dst = F.Wmdn; f8 = FP8_MOE; K = DFF; N = DM; r = it - C12; dstb = (size_t)DFF * DM; }
    const int nblk = (N + 63) >> 6, ipb = (K >> 6) * nblk;
    const int nkb = K >> 6; const int e = r / ipb, r2 = r - e * ipb, nb = r2 / nkb, kb = r2 - nb * nkb;
    d.N = N; d.K = K; d.n0 = nb * 64; d.mode = mode; d.f8 = f8; d.qs = 0.f;
    d.src = src + (size_t)e * K * N + (size_t)(kb * 64) * N + nb * 64;
    d.dst = (unsigned char*)dst + ((size_t)e * dstb + kb * 64) * (f8 ? 1 : 2);
    return true;
}
__device__ __forceinline__ void cvt_load(const CvtDesc& d, int lane, f32x4 (&v)[16]) {
    const int r = lane >> 4, cx = (lane & 15) * 4; const bool ok = (d.n0 + cx) < d.N;
#pragma unroll
    for (int i = 0; i < 16; ++i) v[i] = ok ? __builtin_nontemporal_load((const f32x4*)(d.src + (size_t)(4 * i + r) * d.N + cx)) : (f32x4){0.f, 0.f, 0.f, 0.f};
#ifdef CVT_PROBE_LD
    asm volatile("" ::: "memory");
#pragma unroll
    for (int i = 0; i < 16; ++i) { const f32x4 w = ok ? __builtin_nontemporal_load((const f32x4*)(d.src + (size_t)(4 * i + r) * d.N + cx)) : (f32x4){0.f, 0.f, 0.f, 0.f}; v[i] = (v[i] + w) * 0.5f; }
#endif
}
__device__ __forceinline__ void cvt_store(const CvtDesc& d, int lane, const f32x4 (&v)[16], LAS float* scr) {
    const int r = lane >> 4, cx = (lane & 15) * 4;
#pragma unroll
    for (int i = 0; i < 16; ++i) { LAS float* p = scr + (4 * i + r) * 65 + cx; p[0] = v[i].x; p[1] = v[i].y; p[2] = v[i].z; p[3] = v[i].w; }
    LDS_WAIT(); asm volatile("" ::: "memory");
#ifdef CVT_PROBE_LDS
    for (int rep = 0; rep < 2; ++rep) {
#pragma unroll
    for (int i = 0; i < 16; ++i) { LAS float* p = scr + (4 * i + r) * 65 + cx; p[0] = v[i].x; p[1] = v[i].y; p[2] = v[i].z; p[3] = v[i].w; }
    LDS_WAIT(); asm volatile("" ::: "memory"); }
#endif
    if (d.f8 == 2) {
        const int c = lane & 3; const float qs = d.qs;
#define Q8(v) (__builtin_amdgcn_fmed3f(__builtin_rintf((v) * qs), -127.f, 127.f))
#define PK8(a, b, c2, d2) (((unsigned)(int)Q8(a) & 255u) | (((unsigned)(int)Q8(b) & 255u) << 8) | (((unsigned)(int)Q8(c2) & 255u) << 16) | (((unsigned)(int)Q8(d2)) << 24))
#pragma unroll
        for (int j = 0; j < 4; ++j) { const int nl = (lane >> 2) + 16 * j, n = d.n0 + nl; const LAS float* s = scr + (16 * c) * 65 + nl;
            v4u o; o.x = PK8(s[0 * 65], s[1 * 65], s[2 * 65], s[3 * 65]); o.y = PK8(s[4 * 65], s[5 * 65], s[6 * 65], s[7 * 65]);
            o.z = PK8(s[8 * 65], s[9 * 65], s[10 * 65], s[11 * 65]); o.w = PK8(s[12 * 65], s[13 * 65], s[14 * 65], s[15 * 65]);
            const int row = d.mode == 0 ? n : ((n >> 7) * 256 + (n & 127) + (d.mode == 2 ? 128 : 0));
            if (n < d.N) *(v4u*)(d.dst + (size_t)row * d.K + 16 * c) = o; }
#undef PK8
#undef Q8
    } else if (d.f8) {
        const int c = lane & 3;
#pragma unroll
        for (int j = 0; j < 4; ++j) { const int nl = (lane >> 2) + 16 * j, n = d.n0 + nl; const LAS float* s = scr + (16 * c) * 65 + nl;
            v4u o; o.x = pg8::pk4_fp8(W8_PRESCALE * s[0 * 65], W8_PRESCALE * s[1 * 65], W8_PRESCALE * s[2 * 65], W8_PRESCALE * s[3 * 65]);
            o.y = pg8::pk4_fp8(W8_PRESCALE * s[4 * 65], W8_PRESCALE * s[5 * 65], W8_PRESCALE * s[6 * 65], W8_PRESCALE * s[7 * 65]);
            o.z = pg8::pk4_fp8(W8_PRESCALE * s[8 * 65], W8_PRESCALE * s[9 * 65], W8_PRESCALE * s[10 * 65], W8_PRESCALE * s[11 * 65]);
            o.w = pg8::pk4_fp8(W8_PRESCALE * s[12 * 65], W8_PRESCALE * s[13 * 65], W8_PRESCALE * s[14 * 65], W8_PRESCALE * s[15 * 65]);
            const int row = d.mode == 0 ? n : ((n >> 7) * 256 + (n & 127) + (d.mode == 2 ? 128 : 0));
            if (n < d.N) *(v4u*)(d.dst + (size_t)row * d.K + 16 * c) = o; }
    } else {
    const int c = lane & 7;
#pragma unroll
    for (int j = 0; j < 8; ++j) { const int nl = (lane >> 3) + 8 * j, n = d.n0 + nl; const LAS float* s = scr + (8 * c) * 65 + nl;
        v4u o; o.x = pg8::cvt_pk_bf16(s[0 * 65], s[1 * 65]); o.y = pg8::cvt_pk_bf16(s[2 * 65], s[3 * 65]); o.z = pg8::cvt_pk_bf16(s[4 * 65], s[5 * 65]); o.w = pg8::cvt_pk_bf16(s[6 * 65], s[7 * 65]);
        const int row = d.mode == 0 ? n : ((n >> 7) * 256 + (n & 127) + (d.mode == 2 ? 128 : 0));
        if (n < d.N) *(v4u*)(d.dst + ((size_t)row * d.K + 8 * c) * 2) = o; }
    }
    LDS_WAIT(); asm volatile("" ::: "memory");
}
constexpr int CVT_TOTAL = 103968 + 264;
#ifndef RES_BF16
#define RES_BF16 1
#endif
#ifndef MOE_SPLIT
#define MOE_SPLIT 0
#endif
#ifndef CVT_LATE
#define CVT_LATE 1
#endif
constexpr int LATE_P2 = CVT_LATE ? 10 * 128 * 8 : 0, LATE_P10 = CVT_LATE ? 4 * 96 * 8 : 0, LATE_P11 = CVT_LATE ? 8 * 96 * 8 : 0, LATE_ALL = LATE_P2 + LATE_P10 + LATE_P11;
struct CvtSeg { int n0, b0, n1, b1, b2, nv; };
__device__ __forceinline__ int cvt_real(const CvtSeg& s, int v) { return v < s.n0 ? s.b0 + v : (v < s.n0 + s.n1 ? s.b1 + (v - s.n0) : s.b2 + (v - s.n0 - s.n1)); }
__device__ __forceinline__ void p0_convert(Frame& F, const CvtSeg sg, const float qs, const int gw_in = -1, const int ngw_in = 0) {
    LAS float* scr = (LAS float*)(F.lds + F.wave * 16640);
    const int gw = gw_in >= 0 ? gw_in : (int)blockIdx.x * NWAVES + F.wave, NGW = gw_in >= 0 ? ngw_in : F.G * NWAVES;
    CvtDesc dA, dB; f32x4 vA[16], vB[16];
#define CVT_DEC(V, D) (((V) < sg.nv) && cvt_decode(F, cvt_real(sg, (V)), D) && ((D).qs = qs, true))
    int it = gw; bool okA = CVT_DEC(it, dA);
    if (okA) cvt_load(dA, F.lane, vA);
    while (okA) {
        const bool okB = CVT_DEC(it + NGW, dB);
        if (okB) cvt_load(dB, F.lane, vB);
        cvt_store(dA, F.lane, vA, scr);
        if (!okB) break;
        okA = CVT_DEC(it + 2 * NGW, dA);
        if (okA) cvt_load(dA, F.lane, vA);
        cvt_store(dB, F.lane, vB, scr);
        it += 2 * NGW;
    }
#undef CVT_DEC
}
__device__ __forceinline__ void p0_zero_pad(Frame& F) {
    const int gt = F.vcu * NTHR + F.tid; constexpr int ESZ = I8_P10 ? 1 : 2;
    v4u* z = (v4u*)((unsigned char*)F.Win1 + (size_t)NSA_IN * DM * ESZ); const int nz = (NSA_INP - NSA_IN) * DM * ESZ / 16;
    for (int i = gt; i < nz; i += F.G * NTHR) z[i] = (v4u){0u, 0u, 0u, 0u};
}
__device__ __forceinline__ void p0_absmax(Frame& F, const float* pa, const float* pb, const int n4, const int word) {
    const int gt = (int)blockIdx.x * NTHR + F.tid, NT = F.G * NTHR;
    const f32x4* a = (const f32x4*)pa; const f32x4* b = (const f32x4*)pb; float m = 0.f;
#pragma unroll 4
    for (int i = gt; i < n4; i += NT) { const f32x4 x = a[i], y = b[i];
        m = fmaxf(m, fmaxf(fmaxf(fabsf(x.x), fabsf(x.y)), fmaxf(fabsf(x.z), fabsf(x.w)))); m = fmaxf(m, fmaxf(fmaxf(fabsf(y.x), fabsf(y.y)), fmaxf(fabsf(y.z), fabsf(y.w)))); }
#pragma unroll
    for (int o = 1; o < 64; o <<= 1) m = fmaxf(m, __shfl_xor(m, o));
    if (F.lane == 0) __hip_atomic_fetch_max(F.ctl + word, __builtin_bit_cast(unsigned, m), __ATOMIC_RELAXED, __HIP_MEMORY_SCOPE_AGENT);
}

template <int OM, bool XB = false> __device__ __forceinline__ void normmod_row(const float* xrow, const float* g, const float* modb, bf16* orow, int lane, f32x4 (&y)[8], float* rowsa = nullptr) {
    const f32x4* xr = (const f32x4*)xrow + lane; const uint2* xb2 = (const uint2*)xrow + lane; float ss = 0.f;
#pragma unroll
    for (int j = 0; j < 8; ++j) { if constexpr (XB) { const uint2 q = xb2[64 * j]; y[j] = (f32x4){bflo(q.x), bfhi(q.x), bflo(q.y), bfhi(q.y)}; } else y[j] = xr[64 * j]; ss += (y[j].x * y[j].x + y[j].y * y[j].y) + (y[j].z * y[j].z + y[j].w * y[j].w); }
    const float rs = 1.f / sqrtf(wave_sum(ss) * (1.f / DM) + EPS);
    const f32x4* gp = (const f32x4*)g + lane; const f32x4* sh = (const f32x4*)modb + lane; const f32x4* scl = (const f32x4*)(modb + DM) + lane;
    unsigned long long* o8 = (unsigned long long*)orow + lane;
#pragma unroll
    for (int j = 0; j < 8; ++j) { const f32x4 gg = gp[64 * j], s = sh[64 * j], c = scl[64 * j];
        y[j] = (y[j] * rs) * gg * (c + 1.f) + s;
        if constexpr (OM == 1) ((unsigned*)orow + lane)[64 * j] = pg8::pk4_fp8(y[j].x, y[j].y, y[j].z, y[j].w);
        else if constexpr (OM == 0) o8[64 * j] = (unsigned long long)pk2(y[j].x, y[j].y) | ((unsigned long long)pk2(y[j].z, y[j].w) << 32); }
    if constexpr (OM == 2) {
        float am = 0.f;
#pragma unroll
        for (int j = 0; j < 8; ++j) am = fmaxf(am, fmaxf(fmaxf(fabsf(y[j].x), fabsf(y[j].y)), fmaxf(fabsf(y[j].z), fabsf(y[j].w))));
#pragma unroll
        for (int o = 1; o < 64; o <<= 1) am = fmaxf(am, __shfl_xor(am, o));
        const float q = (am > 0.f) ? 127.f / am : 0.f;
        if (lane == 0) *rowsa = (am > 0.f) ? am * (1.f / 127.f) : 1.f;
#pragma unroll
        for (int j = 0; j < 8; ++j) { const int a = (int)__builtin_rintf(y[j].x * q), b = (int)__builtin_rintf(y[j].y * q), c = (int)__builtin_rintf(y[j].z * q), d = (int)__builtin_rintf(y[j].w * q);
            ((unsigned*)orow + lane)[64 * j] = ((unsigned)a & 255u) | (((unsigned)b & 255u) << 8) | (((unsigned)c & 255u) << 16) | ((unsigned)d << 24); }
    }
}
template <int OM, bool XB = false> __device__ __forceinline__ void normmod_phase(Frame& F, const float* xin, const float* g, const float* modj) {
    const int gw = (int)blockIdx.x * NWAVES + F.wave, NGW = F.G * NWAVES;
    for (int m = gw; m < MTOK; m += NGW) { f32x4 y[8]; normmod_row<OM, XB>((const float*)((const unsigned char*)xin + (size_t)m * DM * (XB ? 2 : 4)), g, modj + (size_t)(m / SEQ) * 6144, (bf16*)((unsigned char*)F.h + (size_t)m * DM * (OM ? 1 : 2)), F.lane, y, F.rowsa + m); }
}

__device__ __forceinline__ void rglru_local_unit(Frame& F, int unit) {
    const int nb = unit & 15, ck = (unit >> 4) & 31, b = unit >> 9;
    LAS float* xin = (LAS float*)(F.lds);
    LAS float* xc = xin + 67 * 64;
    LAS float* wa = xc + 64 * 64;
    LAS float* wx = wa + 64 * 64;
    LAS float* segP = wx + 64 * 64;
    LAS float* segH = segP + 8 * 64;
    const int t0 = ck * 64, ch0 = nb * 64;
    for (int i = F.tid; i < 67 * 8; i += NTHR) { const int r = i >> 3, c8 = (i & 7) * 8, t = t0 - 3 + r;
        v4u v = (v4u){0u, 0u, 0u, 0u}; if (t >= 0) v = *(const v4u*)(F.proj + (size_t)(b * SEQ + t) * EVEN_IN + E_XR + ch0 + c8);
        LAS float* xp = xin + r * 64 + c8; xp[0] = bflo(v.x); xp[1] = bfhi(v.x); xp[2] = bflo(v.y); xp[3] = bfhi(v.y); xp[4] = bflo(v.z); xp[5] = bfhi(v.z); xp[6] = bflo(v.w); xp[7] = bfhi(v.w); }
    for (int i = F.tid; i < 1024; i += NTHR) { *(LAS f32x4*)(wa + 4 * i) = *(const f32x4*)(F.rg_wa + (size_t)nb * 4096 + 4 * i); *(LAS f32x4*)(wx + 4 * i) = *(const f32x4*)(F.rg_wx + (size_t)nb * 4096 + 4 * i); }
    { const int cc = F.tid & 63, chc = ch0 + cc;
      const float cw0 = F.rg_conv_w[0 * 1024 + chc], cw1 = F.rg_conv_w[1 * 1024 + chc], cw2 = F.rg_conv_w[2 * 1024 + chc], cw3 = F.rg_conv_w[3 * 1024 + chc], cbb = F.rg_conv_b[chc];
      __syncthreads();
      for (int i = F.tid; i < 64 * 64; i += NTHR) { const int tt = i >> 6;
          xc[i] = cw0 * xin[(tt + 0) * 64 + cc] + cw1 * xin[(tt + 1) * 64 + cc] + cw2 * xin[(tt + 2) * 64 + cc] + cw3 * xin[(tt + 3) * 64 + cc] + cbb; } }
    __syncthreads();
    const int d = F.tid & 63, tq = F.tid >> 6, ch = ch0 + d;
    float aa[8], ax[8];
#pragma unroll
    for (int i = 0; i < 8; ++i) { aa[i] = 0.f; ax[i] = 0.f; }
    for (int cc = 0; cc < 64; ++cc) { const float wac = wa[cc * 64 + d], wxc = wx[cc * 64 + d];
#pragma unroll
        for (int i = 0; i < 8; ++i) { const float xv = xc[(tq * 8 + i) * 64 + cc]; aa[i] += xv * wac; ax[i] += xv * wxc; } }
    const float ba = F.rg_ba[ch], bx = F.rg_bx[ch], lsl = logsigf_(F.rg_lambda[ch]);
    float hloc[8], pl[8]; float hprev = 0.f, pprev = 1.f;
#pragma unroll
    for (int i = 0; i < 8; ++i) {
        const float r = sigmoidf_(aa[i] + ba), ig = sigmoidf_(ax[i] + bx);
        const float la = 8.f * r * lsl, a = __expf(la);
        const float u = sqrtf(fmaxf(1.f - a * a, 0.f)) * (ig * xc[(tq * 8 + i) * 64 + d]);
        hprev = a * hprev + u; pprev = pprev * a; hloc[i] = hprev; pl[i] = pprev;
    }
    segP[tq * 64 + d] = pprev; segH[tq * 64 + d] = hprev;
    __syncthreads();
    float carry = 0.f, pp = 1.f;
    for (int s = 0; s < tq; ++s) { const float sp = segP[s * 64 + d]; carry = sp * carry + segH[s * 64 + d]; pp *= sp; }
#pragma unroll
    for (int i = 0; i < 8; ++i) { const size_t m = (size_t)(b * SEQ + t0 + tq * 8 + i);
        const float hv = hloc[i] + pl[i] * carry, pv = pl[i] * pp;
        F.hl[m * 1024 + ch] = hv; F.pc[m * 1024 + ch] = pv;
        if (tq == 7 && i == 7) { F.sumP[(size_t)(b * 32 + ck) * 1024 + ch] = pv; F.sumH[(size_t)(b * 32 + ck) * 1024 + ch] = hv; } }
    __syncthreads();
}

__device__ __forceinline__ void rglru_fix_unit(Frame& F, int unit) {
    const int cg = unit & 3, ck = (unit >> 2) & 31, b = unit >> 7;
    const int ch = cg * 256 + (F.tid & 255), th = F.tid >> 8;
    float carry = 0.f;
#pragma unroll 8
    for (int s = 0; s < ck; ++s) carry = F.sumP[(size_t)(b * 32 + s) * 1024 + ch] * carry + F.sumH[(size_t)(b * 32 + s) * 1024 + ch];
#pragma unroll 8
    for (int i = 0; i < 32; ++i) { const size_t m = (size_t)(b * SEQ + ck * 64 + th * 32 + i);
        const float hv = F.hl[m * 1024 + ch] + F.pc[m * 1024 + ch] * carry;
        const float gr = bf1(F.proj[m * EVEN_IN + E_GR + ch]);
        F.mix[m * DM + 1024 + ch] = (bf16)f2bf(hv * gelu_tanh(gr)); }
}

__device__ __forceinline__ unsigned nsa_select(const LAS float* imp, int t) {
    const int cur = t >> 6;
    unsigned mask = 1u | (1u << cur); if (cur >= 1) mask |= 1u << (cur - 1);
    int need = 8 - __builtin_popcount(mask);
    const unsigned valid = (cur >= 31) ? 0xffffffffu : ((2u << cur) - 1u);
    float v[32];
#pragma unroll
    for (int j = 0; j < 32; j += 4) { const f32x4 q = *(const LAS f32x4*)(imp + j); v[j] = q.x; v[j + 1] = q.y; v[j + 2] = q.z; v[j + 3] = q.w; }
    for (; need > 0; --need) {
        const unsigned cand = valid & ~mask; if (!cand) break;
        float best = -1.f; int bi = 0;
#pragma unroll
        for (int j = 0; j < 32; ++j) { const bool better = ((cand >> j) & 1u) && (v[j] > best); best = better ? v[j] : best; bi = better ? j : bi; }
        mask |= 1u << bi;
    }
    return mask;
}
__device__ __forceinline__ void router_block(Frame& F, int tb, const float* xin, const float* g, const float* modj) {
    LAS int* cntl = (LAS int*)(F.lds);
    if (F.tid < 8) cntl[F.tid] = 0;
    __syncthreads();
    for (int i = 0; i < 4; ++i) {
        const int m = tb * 32 + F.wave * 4 + i; f32x4 y[8];
        normmod_row<(FP8_MOE ? 1 : 0), RES_BF16 != 0>((const float*)((const unsigned char*)xin + (size_t)m * DM * (RES_BF16 ? 2 : 4)), g, modj + (size_t)(m / SEQ) * 6144, (bf16*)((unsigned char*)F.h + (size_t)m * DM * (FP8_MOE ? 1 : 2)), F.lane, y);
        float lg[8];
#pragma unroll
        for (int e = 0; e < 8; ++e) lg[e] = 0.f;
#pragma unroll
        for (int j = 0; j < 8; ++j) {
#pragma unroll
            for (int q = 0; q < 4; ++q) { const int dcol = 4 * F.lane + 256 * j + q; const f32x4 w0 = *(const f32x4*)(F.router_w + (size_t)dcol * 8), w1 = *(const f32x4*)(F.router_w + (size_t)dcol * 8 + 4);
                const float yv = y[j][q];
                lg[0] += yv * w0.x; lg[1] += yv * w0.y; lg[2] += yv * w0.z; lg[3] += yv * w0.w; lg[4] += yv * w1.x; lg[5] += yv * w1.y; lg[6] += yv * w1.z; lg[7] += yv * w1.w; } }
#pragma unroll
        for (int e = 0; e < 8; ++e) lg[e] = wave_sum(lg[e]);
        if (F.lane == 0) {
            int e0 = 0; float v0 = lg[0];
#pragma unroll
            for (int e = 1; e < 8; ++e) if (lg[e] > v0) { v0 = lg[e]; e0 = e; }
            int e1 = -1; float v1 = -3.0e38f;
#pragma unroll
            for (int e = 0; e < 8; ++e) if (e != e0 && lg[e] > v1) { v1 = lg[e]; e1 = e; }
            const float p1 = 1.f / (1.f + __expf(v0 - v1)), p0 = 1.f - p1;
            int* r = F.route + (size_t)m * 8; r[0] = e0; r[1] = e1; ((float*)r)[2] = p0; ((float*)r)[3] = p1;
            __hip_atomic_fetch_add(&cntl[e0], 1, __ATOMIC_RELAXED, __HIP_MEMORY_SCOPE_WORKGROUP); __hip_atomic_fetch_add(&cntl[e1], 1, __ATOMIC_RELAXED, __HIP_MEMORY_SCOPE_WORKGROUP);
        }
    }
    __syncthreads();
    if (F.tid < 8) __hip_atomic_store(F.ctl + CW_CNT + tb * 8 + F.tid, (unsigned)cntl[F.tid], RLX_AGENT);
    __syncthreads();
}

__device__ __forceinline__ void moe_scatter_block(Frame& F, int tb) {
    LAS int* tot = (LAS int*)(F.lds);
    LAS int* bas = tot + 8;
    LAS int* seg = bas + 8;
    LAS int* re = seg + 16;
    LAS int* dst = re + 64;
    if (F.tid < 16) tot[F.tid] = 0;
    __syncthreads();
    { const int tb2 = F.tid >> 1, e4 = (F.tid & 1) * 4;
#pragma unroll
      for (int q = 0; q < 4; ++q) { const int v = (int)__hip_atomic_load(F.ctl + CW_CNT + tb2 * 8 + e4 + q, RLX_AGENT); __hip_atomic_fetch_add(&tot[e4 + q], v, __ATOMIC_RELAXED, __HIP_MEMORY_SCOPE_WORKGROUP); if (tb2 < tb) __hip_atomic_fetch_add(&bas[e4 + q], v, __ATOMIC_RELAXED, __HIP_MEMORY_SCOPE_WORKGROUP); } }
    if (F.tid < 64) { const int i = F.tid >> 1, k = F.tid & 1; re[F.tid] = F.route[(size_t)(tb * 32 + i) * 8 + k]; }
    __syncthreads();
    if (F.tid == 0) { int s = 0, tcum = 0; for (int e = 0; e < 8; ++e) { seg[e] = s; const int nt = (tot[e] + 255) >> 8; s += nt * 256;
            if (tb == 0) { __hip_atomic_store(F.ctl + CW_TILE + e, (unsigned)tcum, RLX_AGENT); } tcum += nt; }
        seg[8] = s; if (tb == 0) __hip_atomic_store(F.ctl + CW_TILE + 8, (unsigned)tcum, RLX_AGENT); }
    __syncthreads();
    if (F.tid < 64) { const int i = F.tid >> 1, k = F.tid & 1, e = re[F.tid]; int rank = 0;
        for (int q = 0; q < 2 * i; ++q) rank += (re[q] == e) ? 1 : 0;
        const int d = seg[e] + bas[e] + rank; dst[F.tid] = d;
        const size_t m = (size_t)(tb * 32 + i); F.route[m * 8 + 4 + k] = d; F.rowp[d] = ((const float*)F.route)[m * 8 + 2 + k] * (FP8_MOE ? W8_INV : 1.f); }
    __syncthreads();
    constexpr int RB = DM * (FP8_MOE ? 1 : 2);
    for (int r = F.wave; r < 64; r += NWAVES) { const size_t m = (size_t)(tb * 32 + (r >> 1)); const v4u* s = (const v4u*)((const unsigned char*)F.h + m * RB) + F.lane; v4u* o = (v4u*)((unsigned char*)F.hperm + (size_t)dst[r] * RB) + F.lane;
#pragma unroll
        for (int j = 0; j < RB / 1024; ++j) o[64 * j] = s[64 * j]; }
    __syncthreads();
}

__device__ __forceinline__ f32x4 moe_y4(const Frame& F, int p, int e, int j, int lane, int nwg, int nfull, int S) {
    if (nfull < nwg) {
        const int tce = (int)__hip_atomic_load(F.ctl + CW_TILE + e, RLX_AGENT), tce1 = (int)__hip_atomic_load(F.ctl + CW_TILE + e + 1, RLX_AGENT);
        const int wgid = tce * 8 + j * (tce1 - tce) + ((p >> 8) - tce), L = pg8::moe_unremap(wgid, nwg);
        if (L >= nfull) { const float* pp = F.part + (size_t)((L - nfull) * S) * 65536 + (p & 255) * 256 + 4 * lane; f32x4 a = *(const f32x4*)pp;
            for (int s = 1; s < S; ++s) a += *(const f32x4*)(pp + (size_t)s * 65536);
            return a; }
    }
    const uint2 a = ((const uint2*)((const bf16*)F.y + (size_t)p * DM) + lane)[64 * j];
    return (f32x4){bflo(a.x), bfhi(a.x), bflo(a.y), bfhi(a.y)};
}
__device__ __forceinline__ void final_phase(Frame& F, const float* xin, const float* gate) {
    const int gw = (int)blockIdx.x * NWAVES + F.wave, NGW = F.G * NWAVES;
    const int nwg = (int)__hip_atomic_load(F.ctl + CW_TILE + 8, RLX_AGENT) * 8; int nfull = nwg, nleft = 0, S = 1;
    if (MOE_SPLIT) pg8::moe_split_plan(nwg, F.G, DFF / 128, nfull, nleft, S);
    for (int m = gw; m < MTOK; m += NGW) {
        const int e0 = F.route[(size_t)m * 8 + 0], e1 = F.route[(size_t)m * 8 + 1], p0 = F.route[(size_t)m * 8 + 4], p1 = F.route[(size_t)m * 8 + 5];
        const f32x4* xr = (const f32x4*)(xin + (size_t)m * DM) + F.lane; const uint2* xb2 = (const uint2*)((const bf16*)xin + (size_t)m * DM) + F.lane;
        const f32x4* gp = (const f32x4*)(gate + (size_t)(m / SEQ) * 6144) + F.lane; const f32x4* fg = (const f32x4*)F.final_norm_g + F.lane;
        f32x4 v[8]; float ss = 0.f;
#pragma unroll
        for (int j = 0; j < 8; ++j) { const f32x4 ys = moe_y4(F, p0, e0, j, F.lane, nwg, nfull, S) + moe_y4(F, p1, e1, j, F.lane, nwg, nfull, S);
            f32x4 xv; if (RES_BF16) { const uint2 q = xb2[64 * j]; xv = (f32x4){bflo(q.x), bfhi(q.x), bflo(q.y), bfhi(q.y)}; } else xv = xr[64 * j];
            v[j] = xv + gp[64 * j] * ys; ss += (v[j].x * v[j].x + v[j].y * v[j].y) + (v[j].z * v[j].z + v[j].w * v[j].w); }
        const float rs = 1.f / sqrtf(wave_sum(ss) * (1.f / DM) + EPS);
        f32x4* o = (f32x4*)(F.out + (size_t)m * DM) + F.lane;
#pragma unroll
        for (int j = 0; j < 8; ++j) o[64 * j] = (v[j] * rs) * fg[64 * j];
    }
}

typedef short s16x4 __attribute__((ext_vector_type(4)));
typedef float f32x16 __attribute__((ext_vector_type(16)));
#define KSWZ(row, colB) ((row) * 256 + ((colB) ^ (((row) & 7) << 4)))
#define SBAR() __builtin_amdgcn_sched_barrier(0)
__device__ __forceinline__ int crow(int r, int hi) { return (r & 3) + 8 * (r >> 2) + 4 * hi; }
__device__ __forceinline__ constexpr int crow0(int r) { return (r & 3) + 8 * (r >> 2); }
__device__ __forceinline__ unsigned cvtpk(float lo, float hi) { unsigned r; asm volatile("v_cvt_pk_bf16_f32 %0, %1, %2" : "=v"(r) : "v"(lo), "v"(hi)); return r; }
__device__ __forceinline__ float xhalf_max(float v) { auto rr = __builtin_amdgcn_permlane32_swap(__float_as_uint(v), __float_as_uint(v), false, false); return fmaxf(__uint_as_float(rr[0]), __uint_as_float(rr[1])); }
__device__ __forceinline__ float xhalf_sum(float v) { auto rr = __builtin_amdgcn_permlane32_swap(__float_as_uint(v), __float_as_uint(v), false, false); return __uint_as_float(rr[0]) + __uint_as_float(rr[1]); }
__device__ __forceinline__ float xhalf_other(float v, int hi) { auto rr = __builtin_amdgcn_permlane32_swap(__float_as_uint(v), __float_as_uint(v), false, false); return hi ? __uint_as_float(rr[0]) : __uint_as_float(rr[1]); }
template <class T> __device__ __forceinline__ T* launder(T* p) { asm volatile("" : "+v"(p)); return p; }
template <int OFF> __device__ __forceinline__ void kread4(bf16x8 (&b)[4], unsigned a0, unsigned a1) {
    asm volatile("ds_read_b128 %0, %4 offset:%6\n\tds_read_b128 %1, %4 offset:%7\n\tds_read_b128 %2, %5 offset:%6\n\tds_read_b128 %3, %5 offset:%7\n\ts_waitcnt lgkmcnt(0)"
                 : "=&v"(b[0]), "=&v"(b[1]), "=&v"(b[2]), "=&v"(b[3]) : "v"(a0), "v"(a1), "i"(OFF), "i"(OFF + 8192) : "memory");
}
__device__ __forceinline__ void qkt(f32x16& p0, f32x16& p1, const LAS char* Ks, const bf16x8 (&qr)[8], int r32, int hi) {
    p0 = f32x16{}; p1 = f32x16{};
    const int x = (r32 & 7) << 4; const unsigned rb = (unsigned)(uintptr_t)Ks + r32 * 256 + ((hi * 16) ^ (x & 16));
    const unsigned a0 = rb + ((0 * 32) ^ (x & 96)), a1 = rb + ((1 * 32) ^ (x & 96)), a2 = rb + ((2 * 32) ^ (x & 96)), a3 = rb + ((3 * 32) ^ (x & 96));
    bf16x8 b[4];
#define QK_STEP(RD, QA, QB) RD; p0 = __builtin_amdgcn_mfma_f32_32x32x16_bf16(b[0], qr[QA], p0, 0, 0, 0); p1 = __builtin_amdgcn_mfma_f32_32x32x16_bf16(b[1], qr[QA], p1, 0, 0, 0); \
    p0 = __builtin_amdgcn_mfma_f32_32x32x16_bf16(b[2], qr[QB], p0, 0, 0, 0); p1 = __builtin_amdgcn_mfma_f32_32x32x16_bf16(b[3], qr[QB], p1, 0, 0, 0);
    QK_STEP(kread4<0>(b, a0, a1), 0, 1) QK_STEP(kread4<0>(b, a2, a3), 2, 3) QK_STEP(kread4<128>(b, a0, a1), 4, 5) QK_STEP(kread4<128>(b, a2, a3), 6, 7)
#undef QK_STEP
}
__device__ __forceinline__ int v_st(int k, int c) { const int kk = (k & ~0xC) | ((k & 4) << 1) | ((k & 8) >> 1); return ((kk >> 3) * 4 + (c >> 5)) * 512 + ((kk & 7) * 32 + (c & 31)) * 2; }
__device__ __forceinline__ int v_rd_base(int lane) { return ((lane & 3) << 3) | (((lane >> 2) & 3) << 6) | (((lane >> 4) & 1) << 5) | (((lane >> 5) & 1) << 8); }
constexpr int v_rd_off(int d0, int ks, int half) { return d0 * 512 + ks * 4096 + half * 2048; }
template <int OFF> __device__ __forceinline__ s16x4 tr_read(int vb) { s16x4 r; asm volatile("ds_read_b64_tr_b16 %0, %1 offset:%2" : "=&v"(r) : "v"(vb), "i"(OFF) : "memory"); return r; }
template <int D0> __device__ __forceinline__ void pv_one(f32x16& od, int vb, bf16x8 pa0, bf16x8 pa1, bf16x8 pa2, bf16x8 pa3) {
    const s16x4 l0 = tr_read<v_rd_off(D0, 0, 0)>(vb), h0 = tr_read<v_rd_off(D0, 0, 1)>(vb), l1 = tr_read<v_rd_off(D0, 1, 0)>(vb), h1 = tr_read<v_rd_off(D0, 1, 1)>(vb);
    const s16x4 l2 = tr_read<v_rd_off(D0, 2, 0)>(vb), h2 = tr_read<v_rd_off(D0, 2, 1)>(vb), l3 = tr_read<v_rd_off(D0, 3, 0)>(vb), h3 = tr_read<v_rd_off(D0, 3, 1)>(vb);
    asm volatile("s_waitcnt lgkmcnt(0)" ::: "memory"); SBAR();
#define PKV(L, H) (bf16x8){L[0], L[1], L[2], L[3], H[0], H[1], H[2], H[3]}
    od = __builtin_amdgcn_mfma_f32_32x32x16_bf16(pa0, PKV(l0, h0), od, 0, 0, 0);
    od = __builtin_amdgcn_mfma_f32_32x32x16_bf16(pa1, PKV(l1, h1), od, 0, 0, 0);
    od = __builtin_amdgcn_mfma_f32_32x32x16_bf16(pa2, PKV(l2, h2), od, 0, 0, 0);
    od = __builtin_amdgcn_mfma_f32_32x32x16_bf16(pa3, PKV(l3, h3), od, 0, 0, 0);
#undef PKV
}
__device__ __forceinline__ void pv_d0(f32x16 (&o)[4], int vb, bf16x8 pa0, bf16x8 pa1, bf16x8 pa2, bf16x8 pa3) {
    pv_one<0>(o[0], vb, pa0, pa1, pa2, pa3); pv_one<1>(o[1], vb, pa0, pa1, pa2, pa3); pv_one<2>(o[2], vb, pa0, pa1, pa2, pa3); pv_one<3>(o[3], vb, pa0, pa1, pa2, pa3);
}
__device__ __forceinline__ void pack_p(const f32x16& p0, const f32x16& p1, bf16x8& pa0, bf16x8& pa1, bf16x8& pa2, bf16x8& pa3) {
#define PK4(P, BASE, OUT) do { unsigned a0 = cvtpk(P[BASE + 0], P[BASE + 1]), a1 = cvtpk(P[BASE + 2], P[BASE + 3]);   \
    unsigned b0 = cvtpk(P[BASE + 4], P[BASE + 5]), b1 = cvtpk(P[BASE + 6], P[BASE + 7]);                              \
    auto r0 = __builtin_amdgcn_permlane32_swap(a0, b0, false, false); auto r1 = __builtin_amdgcn_permlane32_swap(a1, b1, false, false); \
    v4u w = {r0[0], r1[0], r0[1], r1[1]}; OUT = __builtin_bit_cast(bf16x8, w); } while (0)
    PK4(p0, 0, pa0); PK4(p0, 8, pa1); PK4(p1, 0, pa2); PK4(p1, 8, pa3);
#undef PK4
}
struct KVStage { bf16x8 k0, k1, v0, v1; };
__device__ __forceinline__ void kv_load(KVStage& s, const bf16* kb, const bf16* vb, size_t pitch, int sr, int sc) {
    s.k0 = *(const bf16x8*)(kb + (size_t)sr * pitch + sc); s.k1 = *(const bf16x8*)(kb + (size_t)(32 + sr) * pitch + sc);
    s.v0 = *(const bf16x8*)(vb + (size_t)sr * pitch + sc); s.v1 = *(const bf16x8*)(vb + (size_t)(32 + sr) * pitch + sc);
}
__device__ __forceinline__ void kv_write(const KVStage& s, LAS char* Kb, LAS char* Vb, int sr, int sc) {
    *(LAS bf16x8*)(Vb + v_st(sr, sc)) = s.v0; *(LAS bf16x8*)(Vb + v_st(32 + sr, sc)) = s.v1;
    *(LAS bf16x8*)(Kb + KSWZ(sr, sc * 2)) = s.k0; *(LAS bf16x8*)(Kb + KSWZ(32 + sr, sc * 2)) = s.k1;
}
struct DmaOff { unsigned k0, k1, v0, v1; };
__device__ __forceinline__ void dma_offsets(DmaOff& d, int wid, int lane, unsigned pitch_bytes) {
    { const int r0 = 8 * wid + (lane >> 4), r1 = r0 + 4; d.k0 = r0 * pitch_bytes + (((lane & 15) ^ (r0 & 7)) << 4); d.k1 = r1 * pitch_bytes + (((lane & 15) ^ (r1 & 7)) << 4); }
    { const int T0 = 4 * wid + (lane >> 5), T1 = T0 + 2, klo = (lane & 31) >> 2, cl = 8 * (lane & 3);
      const int kk0 = 8 * (T0 >> 2) + klo, kk1 = 8 * (T1 >> 2) + klo;
      const int k0 = (kk0 & ~0xC) | ((kk0 & 4) << 1) | ((kk0 & 8) >> 1), k1 = (kk1 & ~0xC) | ((kk1 & 4) << 1) | ((kk1 & 8) >> 1);
      d.v0 = k0 * pitch_bytes + (32 * (T0 & 3) + cl) * 2; d.v1 = k1 * pitch_bytes + (32 * (T1 & 3) + cl) * 2; }
}
__device__ __forceinline__ void glds_s(unsigned voff, const void* sbase, unsigned lds_dst) {
    const unsigned lo = (unsigned)__builtin_amdgcn_readfirstlane((int)(unsigned)(uintptr_t)sbase), hi = (unsigned)__builtin_amdgcn_readfirstlane((int)(unsigned)((uintptr_t)sbase >> 32));
    const unsigned long long sb = ((unsigned long long)hi << 32) | lo; const unsigned ld = (unsigned)__builtin_amdgcn_readfirstlane((int)lds_dst); unsigned keep;
    asm volatile("s_mov_b32 %0, m0\n\ts_mov_b32 m0, %3\n\ts_nop 0\n\tglobal_load_lds_dwordx4 %1, %2\n\ts_mov_b32 m0, %0" : "=&s"(keep) : "v"(voff), "s"(sb), "s"(ld) : "memory");
}
__device__ __forceinline__ void dma_tile(const DmaOff& d, const bf16* kb, const bf16* vb, unsigned ldsK, unsigned ldsV, int wid) {
    glds_s(d.k0, kb, ldsK + 2048 * wid); glds_s(d.k1, kb, ldsK + 2048 * wid + 1024);
    glds_s(d.v0, vb, ldsV + 2048 * wid); glds_s(d.v1, vb, ldsV + 2048 * wid + 1024);
}
#define DMA_WAIT() asm volatile("s_waitcnt vmcnt(0)" ::: "memory")
constexpr int AT_V = 0, AT_K = 49152, AT_WSF = 98304, AT_IMPW = 100352, AT_IMPS = AT_IMPW + 32768, AT_SEL = AT_IMPS + 8192, AT_MISC = AT_SEL + 256;
constexpr float SM_C = QSCALE * 1.4426950408889634f, SM_THR = 8.f / QSCALE;

__device__ __forceinline__ void sm_tile(f32x16& p0, f32x16& p1, int lo, int hi2, float& m_reg, float& l_reg, f32x16 (&o)[4], LAS float* wsf, int vb, int r32, int hi) {
    const bool partial = (lo >= 0) || (hi2 >= 0 && hi2 < 63);
    if (__any(partial)) {
        const int lo4 = lo - 4 * hi, hi4 = hi2 - 4 * hi;
#pragma unroll
        for (int r = 0; r < 16; ++r) { p0[r] = (crow0(r) > lo4 && crow0(r) <= hi4) ? p0[r] : -__builtin_inff(); p1[r] = (32 + crow0(r) > lo4 && 32 + crow0(r) <= hi4) ? p1[r] : -__builtin_inff(); }
    }
    const bool off = (hi2 < 0);
    float pmax = p0[0];
#pragma unroll
    for (int r = 1; r < 16; ++r) pmax = fmaxf(pmax, p0[r]);
#pragma unroll
    for (int r = 0; r < 16; ++r) pmax = fmaxf(pmax, p1[r]);
    pmax = xhalf_max(pmax);
    pmax = off ? -__builtin_inff() : pmax;
    float mn, alpha;
    if (__all(pmax - m_reg <= SM_THR)) { mn = m_reg; alpha = 1.f; }
    else { mn = fmaxf(m_reg, pmax); alpha = __builtin_amdgcn_exp2f((m_reg - mn) * SM_C); m_reg = mn; }
    const float mnC = off ? -__builtin_inff() : -mn * SM_C;
#pragma unroll
    for (int r = 0; r < 16; ++r) { p0[r] = __builtin_amdgcn_exp2f(fmaf(p0[r], SM_C, mnC)); p1[r] = __builtin_amdgcn_exp2f(fmaf(p1[r], SM_C, mnC)); }
    float ps = 0.f;
#pragma unroll
    for (int r = 0; r < 16; ++r) ps += p0[r] + p1[r];
    ps = xhalf_sum(ps);
    l_reg = l_reg * alpha + ps;
    if (__any(alpha < 1.f)) { if (hi == 0) wsf[r32] = alpha; asm volatile("s_waitcnt lgkmcnt(0)" ::: "memory");
#pragma unroll
        for (int r = 0; r < 16; ++r) { const float a = (wsf + 4 * hi)[crow0(r)];
#pragma unroll
            for (int d = 0; d < 4; ++d) o[d][r] *= a; } }
    bf16x8 pa0, pa1, pa2, pa3; pack_p(p0, p1, pa0, pa1, pa2, pa3);
    pv_d0(o, vb, pa0, pa1, pa2, pa3);
}

__device__ __forceinline__ void nsa_mfma_unit(Frame& F, int unit) {
    const int qt = unit & 31, g = (unit >> 5) & 3, b = unit >> 7;
    const int tid = F.tid, wid = F.wave, lane = F.lane, r32 = lane & 31, hi = lane >> 5;
    const int hg = wid & 3, qh = wid >> 2, head = g * 4 + hg, qrel = qh * 32 + r32, tq = qt * 64 + qrel;
    LAS char* L = (LAS char*)F.lds;
    LAS float* wsf = (LAS float*)(L + AT_WSF) + wid * 64;
    LAS float* impw = (LAS float*)(L + AT_IMPW);
    LAS float* imps = (LAS float*)(L + AT_IMPS);
    LAS unsigned* selm = (LAS unsigned*)(L + AT_SEL);
    LAS unsigned* misc = (LAS unsigned*)(L + AT_MISC);
    const int vb0 = (int)(unsigned)(uintptr_t)(L + AT_V) + v_rd_base(lane);
    const int sr = tid >> 4, sc = (tid & 15) * 8;
    const bf16* pbase = F.proj + (size_t)b * SEQ * NSA_INP;
    bf16x8 qr[8];
    { const bf16* qp = pbase + (size_t)tq * NSA_INP + N_Q + head * 128 + hi * 8;
#pragma unroll
      for (int d0 = 0; d0 < 8; ++d0) qr[d0] = *(const bf16x8*)(qp + d0 * 16); }
#define NSA_GATE(br) sigmoidf_(bf1(pbase[(size_t)tq * NSA_INP + N_G + head * 3 + (br)]))
    float* orow = F.y + (size_t)(b * SEQ + qt * 64 + qh * 32 + 4 * hi) * DM + head * 128 + r32;
    f32x16 o[4];
    const unsigned ldsK0 = (unsigned)(uintptr_t)(L + AT_K), ldsV0 = (unsigned)(uintptr_t)(L + AT_V);
    { const bf16* kc = F.kcmpb + (size_t)(b * 4 + g) * 128 * 128; const bf16* vc = F.vcmpb + (size_t)(b * 4 + g) * 128 * 128;
      DmaOff dc; dma_offsets(dc, wid, lane, 128 * 2);
      dma_tile(dc, kc, vc, ldsK0, ldsV0, wid); dma_tile(dc, kc + 64 * 128, vc + 64 * 128, ldsK0 + 16384u, ldsV0 + 16384u, wid); DMA_WAIT(); }
    if (tid == 0) misc[0] = 0u;
    __syncthreads();
#ifndef NSA_SKIP_CMP
    {
        const int nv = (tq >= 31) ? ((tq - 31) >> 4) + 1 : 0;
        float m_c = -1.0e30f, l_c = 0.f;
#pragma unroll
        for (int d = 0; d < 4; ++d) o[d] = f32x16{};
        { f32x16 p0, p1; qkt(p0, p1, L + AT_K, qr, r32, hi); sm_tile(p0, p1, -1, nv - 1, m_c, l_c, o, wsf, vb0, r32, hi); }
        { f32x16 p0, p1; qkt(p0, p1, L + AT_K + 16384, qr, r32, hi); sm_tile(p0, p1, -1, nv - 65, m_c, l_c, o, wsf, vb0 + 16384, r32, hi); }
        const float inv = (nv > 0) ? 1.f / l_c : 0.f;
        if (hi == 0) wsf[r32] = NSA_GATE(0) * inv;
        asm volatile("s_waitcnt lgkmcnt(0)" ::: "memory");
        { float* ob_ = launder(orow);
#pragma unroll
          for (int r = 0; r < 16; ++r) { const float s = (wsf + 4 * hi)[crow0(r)]; float* op = ob_ + (size_t)crow0(r) * DM;
#pragma unroll
            for (int d = 0; d < 4; ++d) op[32 * d] = o[d][r] * s; } }
        {
            LAS float* iw = impw + (wid * 32 + r32) * 32;
            float prevL = 0.f; const float mnC = -m_c * SM_C;
#define IMP_STEP(C, TS) _Pragma("unroll") for (int rg = 0; rg < 4; ++rg) { const float Gs = (C[4 * rg] + C[4 * rg + 1]) + (C[4 * rg + 2] + C[4 * rg + 3]); \
                const float Lc = xhalf_other(C[4 * rg + 3], hi); iw[8 * TS + 2 * rg + hi] = (Gs + (hi ? Lc : prevL)) * inv; prevL = Lc; }
#define IMP_TILE(KOFF, NB) { f32x16 p0, p1; qkt(p0, p1, L + AT_K + KOFF, qr, r32, hi); const int lim = nv - NB - 4 * hi; \
            _Pragma("unroll") for (int r = 0; r < 16; ++r) { p0[r] = (crow0(r) < lim) ? __builtin_amdgcn_exp2f(fmaf(p0[r], SM_C, mnC)) : 0.f; p1[r] = (32 + crow0(r) < lim) ? __builtin_amdgcn_exp2f(fmaf(p1[r], SM_C, mnC)) : 0.f; } \
            IMP_STEP(p0, (NB / 32)) IMP_STEP(p1, (NB / 32 + 1)) }
            IMP_TILE(0, 0) IMP_TILE(16384, 64)
#undef IMP_TILE
#undef IMP_STEP
        }
    }
#endif
    __syncthreads();
    { const int q = tid >> 3, m4 = (tid & 7) * 4;
      const int w0 = (q >> 5) * 4, rr = q & 31;
#pragma unroll
      for (int i = 0; i < 4; ++i) { const int m = m4 + i;
          imps[q * 32 + m] = (impw[((w0 + 0) * 32 + rr) * 32 + m] + impw[((w0 + 1) * 32 + rr) * 32 + m]) + (impw[((w0 + 2) * 32 + rr) * 32 + m] + impw[((w0 + 3) * 32 + rr) * 32 + m]); } }
    __syncthreads();
    if (tid < 64) { const unsigned mk = nsa_select(imps + tid * 32, qt * 64 + tid); selm[tid] = mk; __hip_atomic_fetch_or(&misc[0], mk, __ATOMIC_RELAXED, __HIP_MEMORY_SCOPE_WORKGROUP); }
    __syncthreads();
    if (tid == 0) { unsigned un = misc[0]; int n = 0;
        for (int j = 0; j <= qt; ++j) if ((un >> j) & 1u) misc[2 + n++] = 0x100u | (unsigned)j;
        for (int j = (qt >= 8 ? qt - 8 : 0); j <= qt; ++j) misc[2 + n++] = 0x200u | (unsigned)j;
        misc[1] = (unsigned)n; }
    DmaOff dof; dma_offsets(dof, wid, lane, NSA_INP * 2);
    dma_tile(dof, pbase + N_KS + g * 128, pbase + N_VS + g * 128, ldsK0, ldsV0, wid);
    __syncthreads();
    const int nt = (int)misc[1];
#define NSA_TILE_SRC(IDX) (pbase + (size_t)(64 * (int)(misc[2 + (IDX)] & 255u)) * NSA_INP + ((misc[2 + (IDX)] >> 8) == 1u ? N_KS : N_KW) + g * 128)
    if (nt > 1) { const bf16* kb1 = NSA_TILE_SRC(1); dma_tile(dof, kb1, kb1 + 512, ldsK0 + 16384u, ldsV0 + 16384u, wid); asm volatile("s_waitcnt vmcnt(4)" ::: "memory"); }
    else DMA_WAIT();
    __syncthreads();
    float m_reg = -1.0e30f, l_reg = 0.f;
#pragma unroll
    for (int d = 0; d < 4; ++d) o[d] = f32x16{};
    int prevkind = 1;
#ifndef NSA_SKIP_LOOP
    for (int i = 0; i < nt; ++i) {
        const unsigned ent = misc[2 + i]; const int kind = (int)(ent >> 8), j = (int)(ent & 255u);
        if (i + 2 < nt) { const bf16* kb = NSA_TILE_SRC(i + 2); const unsigned nb = (unsigned)(((i + 2) % 3) * 16384);
            dma_tile(dof, kb, kb + 512, ldsK0 + nb, ldsV0 + nb, wid); }
#ifndef NSA_SKIP_TRANS
        if (kind != prevkind) {
            if (hi == 0) wsf[r32] = NSA_GATE(1) / l_reg;
            asm volatile("s_waitcnt lgkmcnt(0)" ::: "memory");
            float* ob_ = launder(orow);
#pragma unroll
            for (int r = 0; r < 16; ++r) { const float s = (wsf + 4 * hi)[crow0(r)]; float* op = ob_ + (size_t)crow0(r) * DM;
#pragma unroll
                for (int d = 0; d < 4; ++d) { op[32 * d] += o[d][r] * s; } }
            asm volatile("s_waitcnt vmcnt(0)" ::: "memory");
#pragma unroll
            for (int d = 0; d < 4; ++d) o[d] = f32x16{};
            m_reg = -1.0e30f; l_reg = 0.f; prevkind = kind;
        }
#endif
        int lo = -1, hi2 = 63;
        if (kind == 1) { if (!((selm[qrel] >> j) & 1u)) hi2 = -1; else if (j == qt) hi2 = qrel; }
        else { if (j == qt) hi2 = qrel; else if (j == qt - 8) lo = qrel; }
        const int bo = (i % 3) * 16384;
        f32x16 p0, p1;
        qkt(p0, p1, L + AT_K + bo, qr, r32, hi);
        sm_tile(p0, p1, lo, hi2, m_reg, l_reg, o, wsf, vb0 + bo, r32, hi);
        if (i + 2 < nt) asm volatile("s_waitcnt vmcnt(4)" ::: "memory"); else DMA_WAIT();
        __syncthreads();
    }
#endif
#undef NSA_TILE_SRC
    if (hi == 0) wsf[r32] = NSA_GATE(2) / l_reg;
    asm volatile("s_waitcnt lgkmcnt(0)" ::: "memory");
    const float* ob_ = launder(orow);
#if FP8_P13
    unsigned char* mrow = launder((unsigned char*)F.mix + (size_t)(b * SEQ + qt * 64 + qh * 32 + 4 * hi) * DM + head * 128 + r32);
#pragma unroll
    for (int r = 0; r < 16; ++r) { const float s = (wsf + 4 * hi)[crow0(r)]; const float* op = ob_ + (size_t)crow0(r) * DM; unsigned char* mp = mrow + (size_t)crow0(r) * DM;
#pragma unroll
        for (int d = 0; d < 4; ++d) mp[32 * d] = (unsigned char)(__builtin_amdgcn_cvt_pk_fp8_f32(pg8::clamp448(op[32 * d] + o[d][r] * s), 0.f, 0, false) & 255); }
#else
    bf16* mrow = launder(F.mix + (size_t)(b * SEQ + qt * 64 + qh * 32 + 4 * hi) * DM + head * 128 + r32);
#pragma unroll
    for (int r = 0; r < 16; ++r) { const float s = (wsf + 4 * hi)[crow0(r)]; const float* op = ob_ + (size_t)crow0(r) * DM; bf16* mp = mrow + (size_t)crow0(r) * DM;
#pragma unroll
        for (int d = 0; d < 4; ++d) mp[32 * d] = (bf16)f2bf(op[32 * d] + o[d][r] * s); }
#endif
    __syncthreads();
}

__device__ __forceinline__ void sb_mfma_unit(Frame& F, int unit) {
    const int qb = unit & 7, hh = (unit >> 3) & 7, b = unit >> 6;
    const int tid = F.tid, wid = F.wave, lane = F.lane, r32 = lane & 31, hi = lane >> 5;
    const int tq0 = qb * 256 + wid * 32, tq = tq0 + r32;
    LAS char* L = (LAS char*)F.lds;
    LAS unsigned* actf = (LAS unsigned*)(L + AT_MISC);
    const int vb0 = (int)(unsigned)(uintptr_t)(L + AT_V) + v_rd_base(lane);
    const int sr = tid >> 4, sc = (tid & 15) * 8;
    const bf16* pbase = F.proj + (size_t)b * SEQ * EVEN_IN + hh * 128;
    bf16x8 qr[8];
    { const bf16* qp = pbase + (size_t)tq * EVEN_IN + E_Q + hi * 8;
#pragma unroll
      for (int d0 = 0; d0 < 8; ++d0) qr[d0] = *(const bf16x8*)(qp + d0 * 16); }
    f32x16 o[4];
#pragma unroll
    for (int d = 0; d < 4; ++d) o[d] = f32x16{};
    float R = 0.f;
    KVStage st;
    int jt = qb * 4 + 3;
    DmaOff dof; dma_offsets(dof, wid, lane, EVEN_IN * 2);
    const unsigned ldsK0 = (unsigned)(uintptr_t)(L + AT_K), ldsV0 = (unsigned)(uintptr_t)(L + AT_V);
    dma_tile(dof, pbase + (size_t)(64 * jt) * EVEN_IN + E_K, pbase + (size_t)(64 * jt) * EVEN_IN + E_V, ldsK0, ldsV0, wid);
    DMA_WAIT();
    __syncthreads();
    for (int it = 0;; ++it, --jt) {
        const int bo = (it & 1) * 16384;
        if (jt > 0) dma_tile(dof, pbase + (size_t)(64 * (jt - 1)) * EVEN_IN + E_K, pbase + (size_t)(64 * (jt - 1)) * EVEN_IN + E_V, ldsK0 + (16384u - (unsigned)bo), ldsV0 + (16384u - (unsigned)bo), wid);
        const bool act = (64 * jt < tq0 + 32) && __any(R > -120.f);
        if (act) {
            f32x16 p0, p1;
            qkt(p0, p1, L + AT_K + bo, qr, r32, hi);
            const int kbase = 64 * jt;
            f32x16 k0, k1;
            const int thr = tq - kbase - 4 * hi;
#pragma unroll
            for (int r = 0; r < 16; ++r) {
                const float z0 = p0[r] * QSCALE, z1 = p1[r] * QSCALE;
                const float lb0 = logsigf_(z0), lb1 = logsigf_(z1);
                k0[r] = (crow0(r) < thr) ? lb0 - z0 : 0.f; k1[r] = (32 + crow0(r) < thr) ? lb1 - z1 : 0.f;
                p0[r] = (crow0(r) < thr) ? lb0 : -__builtin_inff(); p1[r] = (32 + crow0(r) < thr) ? lb1 : -__builtin_inff(); }
            float run = R;
#pragma unroll
            for (int ti = 1; ti >= 0; --ti)
#pragma unroll
                for (int rg = 3; rg >= 0; --rg) {
                    const float a0 = ti ? k1[4 * rg] : k0[4 * rg], a1 = ti ? k1[4 * rg + 1] : k0[4 * rg + 1], a2 = ti ? k1[4 * rg + 2] : k0[4 * rg + 2], a3 = ti ? k1[4 * rg + 3] : k0[4 * rg + 3];
                    const float gs_ = (a0 + a1) + (a2 + a3), go_ = xhalf_other(gs_, hi);
                    const float godd = hi ? gs_ : go_, gev = hi ? go_ : gs_;
                    const float sx = hi ? run : run + godd;
                    run += godd + gev;
                    const float e3 = sx, e2 = sx + a3, e1 = e2 + a2, e0 = e1 + a1;
                    if (ti) { p1[4 * rg] = __expf(p1[4 * rg] + e0); p1[4 * rg + 1] = __expf(p1[4 * rg + 1] + e1); p1[4 * rg + 2] = __expf(p1[4 * rg + 2] + e2); p1[4 * rg + 3] = __expf(p1[4 * rg + 3] + e3); }
                    else    { p0[4 * rg] = __expf(p0[4 * rg] + e0); p0[4 * rg + 1] = __expf(p0[4 * rg + 1] + e1); p0[4 * rg + 2] = __expf(p0[4 * rg + 2] + e2); p0[4 * rg + 3] = __expf(p0[4 * rg + 3] + e3); }
                }
            R = run;
            bf16x8 pa0, pa1, pa2, pa3; pack_p(p0, p1, pa0, pa1, pa2, pa3);
            pv_d0(o, vb0 + bo, pa0, pa1, pa2, pa3);
        }
        const bool actn = (jt > 0) && (64 * (jt - 1) < tq0 + 32) && __any(R > -120.f);
        if (lane == 0) actf[(it & 1) * 8 + wid] = actn ? 1u : 0u;
        DMA_WAIT();
        __syncthreads();
        unsigned any = 0u;
#pragma unroll
        for (int w = 0; w < 8; ++w) any |= actf[(it & 1) * 8 + w];
        if (!any) break;
    }
    bf16* mrow = launder(F.mix + (size_t)(b * SEQ + tq0 + 4 * hi) * DM + hh * 128 + r32);
#pragma unroll
    for (int r = 0; r < 16; ++r) { bf16* mp = mrow + (size_t)crow0(r) * DM;
#pragma unroll
        for (int d = 0; d < 4; ++d) mp[32 * d] = (bf16)f2bf(o[d][r]); }
    __syncthreads();
}

__device__ __forceinline__ void cmp_posbias(Frame& F, int idx) {
    const int which = idx >> 5, part = idx & 31;
    const float* w1 = which ? F.cmp_v_w1 : F.cmp_k_w1; const float* pos = which ? F.cmp_pos_v : F.cmp_pos_k;
    LAS float* red = (LAS float*)(F.lds);
    const int dout = F.tid & 127, ks = F.tid >> 7; float acc = 0.f;
    const int kb = part * 128 + ks * 32;
#pragma unroll 16
    for (int k = 0; k < 32; ++k) acc += pos[kb + k] * w1[(size_t)(kb + k) * 128 + dout];
    __syncthreads();
    red[F.tid] = acc;
    __syncthreads();
    if (F.tid < 128) F.cmp_pb[(which * 32 + part) * 128 + F.tid] = (red[F.tid] + red[128 + F.tid]) + (red[256 + F.tid] + red[384 + F.tid]);
    __syncthreads();
}
__device__ __forceinline__ void cmp_mfma_unit(Frame& F, int unit) {
    const int mt = unit % 5, bg = (unit / 5) & 15, which = unit / 80;
    const int b = bg >> 2, g = bg & 3, m0 = 31 * mt;
    const int tid = F.tid, wid = F.wave, lane = F.lane, r32 = lane & 31, hi = lane >> 5, kq = wid & 3, nh = wid >> 2;
    const bf16* W1t = which ? F.Wc1v : F.Wc1k; const bf16* W2t = which ? F.Wc2v : F.Wc2k;
    bf16* outb = which ? F.vcmpb : F.kcmpb;
    const int coff = (which ? N_VC : N_KC) + g * 128;
    LAS float* part = (LAS float*)(F.lds);
    LAS char* hidb = (LAS char*)(F.lds) + 131072;
    LAS float* pb = (LAS float*)(F.lds + 131072 + 32 * 272);
    if (tid < 128) { float s = 0.f; for (int p = 0; p < 32; ++p) s += F.cmp_pb[(which * 32 + p) * 128 + tid]; pb[tid] = s; }
    const int m = m0 + r32; const bool mv = m < 128;
    const bf16* arow = F.proj + ((size_t)b * SEQ + 16 * (mv ? m : 0)) * NSA_INP + coff + 8 * hi;
    const bf16* brow = W1t + (size_t)(nh * 128 + r32) * 2048 + 8 * hi;
    f32x16 acc[4];
#pragma unroll
    for (int i = 0; i < 4; ++i) acc[i] = f32x16{};
#pragma unroll 4
    for (int s = 0; s < 32; ++s) { const int ksg = kq * 32 + s;
        bf16x8 a = *(const bf16x8*)(arow + (size_t)(ksg >> 3) * NSA_INP + (ksg & 7) * 16);
        if (!mv) a = bf16x8{};
#pragma unroll
        for (int nt = 0; nt < 4; ++nt) { const bf16x8 bb = *(const bf16x8*)(brow + (size_t)(nt * 32) * 2048 + ksg * 16);
            acc[nt] = __builtin_amdgcn_mfma_f32_32x32x16_bf16(a, bb, acc[nt], 0, 0, 0); } }
    { LAS float* pp = part + (kq * 32 + 4 * hi) * 256 + nh * 128 + r32;
#pragma unroll
      for (int r = 0; r < 16; ++r)
#pragma unroll
        for (int nt = 0; nt < 4; ++nt) pp[crow0(r) * 256 + nt * 32] = acc[nt][r]; }
    __syncthreads();
    { const int nl = tid >> 4, d8 = (tid & 15) * 8;
      unsigned pk[4];
#pragma unroll
      for (int i = 0; i < 4; ++i) { float hv[2];
#pragma unroll
          for (int q = 0; q < 2; ++q) { const int dd = d8 + 2 * i + q; float u = 0.f;
              if (nl < 31) { u = pb[dd];
#pragma unroll
                  for (int k4 = 0; k4 < 4; ++k4) u += part[(k4 * 32 + nl) * 256 + dd] + part[(k4 * 32 + nl + 1) * 256 + 128 + dd];
                  u = gelu_tanh(u); }
              hv[q] = u; }
          pk[i] = pk2(hv[0], hv[1]); }
      *(LAS v4u*)(hidb + nl * 272 + d8 * 2) = (v4u){pk[0], pk[1], pk[2], pk[3]}; }
    __syncthreads();
    if (wid < 4) {
        f32x16 a2 = f32x16{};
#pragma unroll
        for (int ks = 0; ks < 8; ++ks) { const bf16x8 a = *(const LAS bf16x8*)(hidb + r32 * 272 + (ks * 16 + 8 * hi) * 2);
            const bf16x8 bb = *(const bf16x8*)(W2t + (size_t)(wid * 32 + r32) * 128 + ks * 16 + 8 * hi);
            a2 = __builtin_amdgcn_mfma_f32_32x32x16_bf16(a, bb, a2, 0, 0, 0); }
#pragma unroll
        for (int r = 0; r < 16; ++r) { const int nl = crow0(r) + 4 * hi, n = m0 + nl;
            if (nl < 31 && n < 128) outb[((size_t)bg * 128 + n) * 128 + wid * 32 + r32] = (n < NCMP) ? (bf16)f2bf(a2[r]) : (bf16)0; }
    }
    __syncthreads();
}

__device__ __forceinline__ int lane_now() { int l; asm volatile("v_mbcnt_lo_u32_b32 %0, -1, 0\n\tv_mbcnt_hi_u32_b32 %0, -1, %0" : "=v"(l)); return l; }
struct Args { const float* in[33]; float* out; unsigned char* ws; int ph_lo, ph_hi; };
#define CAS __attribute__((address_space(4)))
__device__ __forceinline__ void load_frame(Frame& F) {
    const CAS Args* ap = (const CAS Args*)__builtin_amdgcn_kernarg_segment_ptr();
    asm volatile("" : "+s"(ap));
    unsigned char* ws = ap->ws;
    F.ctl = (gu32*)(ws + WS_CTL);
    F.x = ap->in[0]; F.c = ap->in[1]; F.ada_mix_w = ap->in[2]; F.ada_mix_b = ap->in[3]; F.norm_mix_g = ap->in[4]; F.ada_ffn_w = ap->in[5]; F.ada_ffn_b = ap->in[6]; F.norm_ffn_g = ap->in[7];
    F.even_in_w = ap->in[8]; F.rg_conv_w = ap->in[9]; F.rg_conv_b = ap->in[10]; F.rg_wa = ap->in[11]; F.rg_ba = ap->in[12]; F.rg_wx = ap->in[13]; F.rg_bx = ap->in[14]; F.rg_lambda = ap->in[15];
    F.even_out_w = ap->in[16]; F.dense_w_gate = ap->in[17]; F.dense_w_up = ap->in[18]; F.dense_w_down = ap->in[19]; F.nsa_in_w = ap->in[20]; F.cmp_pos_k = ap->in[21]; F.cmp_pos_v = ap->in[22];
    F.cmp_k_w1 = ap->in[23]; F.cmp_k_w2 = ap->in[24]; F.cmp_v_w1 = ap->in[25]; F.cmp_v_w2 = ap->in[26]; F.nsa_out_w = ap->in[27]; F.router_w = ap->in[28];
    F.moe_w_gate = ap->in[29]; F.moe_w_up = ap->in[30]; F.moe_w_down = ap->in[31]; F.final_norm_g = ap->in[32]; F.out = ap->out;
    F.Win0 = (bf16*)(ws + WS_WIN0); F.Wout0 = (bf16*)(ws + WS_WOUT0); F.Wgu0 = (bf16*)(ws + WS_WGU0); F.Wdn0 = (bf16*)(ws + WS_WDN0); F.Win1 = (bf16*)(ws + WS_WIN1); F.Wout1 = (bf16*)(ws + WS_WOUT1);
    F.Wmgu = (bf16*)(ws + WS_WMGU); F.Wmdn = (bf16*)(ws + WS_WMDN);
    F.mod = (float*)(ws + WS_MOD); F.xa = (float*)(ws + WS_XA); F.xb = (float*)(ws + WS_XB); F.kcmp = (float*)(ws + WS_KCMP); F.vcmp = (float*)(ws + WS_VCMP);
    F.sumP = (float*)(ws + WS_SUMP); F.sumH = (float*)(ws + WS_SUMH); F.hl = (float*)(ws + WS_HL); F.pc = (float*)(ws + WS_PC); F.y = (float*)(ws + WS_Y); F.rowp = (float*)(ws + WS_ROWP);
    F.route = (int*)(ws + WS_ROUTE);
    F.h = (bf16*)(ws + WS_H); F.proj = (bf16*)(ws + WS_PROJ); F.mix = (bf16*)(ws + WS_MIX); F.act = (bf16*)(ws + WS_ACT); F.hperm = (bf16*)(ws + WS_HPERM); F.kcmpb = (bf16*)(ws + WS_KCMPB); F.vcmpb = (bf16*)(ws + WS_VCMPB); F.Wc1k = (bf16*)(ws + WS_WC1K); F.Wc1v = (bf16*)(ws + WS_WC1V); F.Wc2k = (bf16*)(ws + WS_WC2K); F.Wc2v = (bf16*)(ws + WS_WC2V); F.cmp_pb = (float*)(ws + WS_CMPPB); F.rowsa = (float*)(ws + WS_ROWSA); F.part = (float*)(ws + WS_PART);
}
__global__ void __launch_bounds__(NTHR, 2) mk_fwd(Args args) {
    extern __shared__ __attribute__((aligned(16))) unsigned char lds[];
    Frame F;
    F.lds = (LAS unsigned char*)lds;
    F.MISC = (volatile LAS unsigned*)(F.lds + MISC_OFF);
    const int wave0 = __builtin_amdgcn_readfirstlane((int)threadIdx.x >> 6);
    F.lane = lane_now(); F.wave = wave0; F.tid = wave0 * 64 + F.lane;
    F.G = gridDim.x; { const int bx = blockIdx.x; F.vcu = (F.G % 8 == 0) ? (bx % 8) * (F.G / 8) + bx / 8 : bx; }
    load_frame(F);
    for (int u = F.tid; u < (LDS_BYTES - LDSCTL_OFF) / 4; u += NTHR) ((LAS unsigned*)(F.lds + LDSCTL_OFF))[u] = 0u;
    __syncthreads();
    XcdBarrier bar; bar.bar = (unsigned*)(F.ctl + CW_BAR); bar.x = 0; bar.st = nullptr;
    if (N_LAUNCHES == 1) bar = xcd_barrier_post((unsigned*)(F.ctl + CW_BAR), F.MISC + 8, F.tid);
    const int lo = args.ph_lo, hi = args.ph_hi;
#define IN(k) (lo <= (k) && (k) < hi)
#define SEAM(k) do { if (IN(k) && IN((k) + 1)) xcd_barrier(bar, wave0 * 64 + lane_now()); } while (0)
#ifndef PROBE_DUP
#define PROBE_DUP -1
#endif
#define REP(k) for (int rep_ = (load_frame(F), F.lane = lane_now(), F.wave = wave0, F.tid = wave0 * 64 + F.lane, 0); rep_ < ((PROBE_DUP) == (k) ? 2 : 1); ++rep_)
#define mod0 (F.mod)
#define mod1 (F.mod + 4 * 6144)
#define mod2 (F.mod + 8 * 6144)
#define mod3 (F.mod + 12 * 6144)

    if (IN(0)) REP(0) { p0_adaln(F); p0_zero_pad(F);
        { CvtSeg sg; const int aLo = I8_P2 ? 2560 : 0;
          const int gLo = 3584, gN = I8_DUP ? 7168 : 0;
          const int nLo = 14336, nN = I8_P10 ? 2592 : 0;
          sg.n0 = gLo - aLo; sg.b0 = aLo; sg.n1 = nLo - (gLo + gN); sg.b1 = gLo + gN; sg.b2 = nLo + nN; sg.nv = sg.n0 + sg.n1 + (CVT_TOTAL - sg.b2) - (F.G == 256 ? LATE_ALL : 0);
          p0_convert(F, sg, 0.f); }
        if (I8_DUP) p0_absmax(F, F.dense_w_gate, F.dense_w_up, DM * DFF / 4, CW_WMAX);
#ifdef ABSMAX_PROBE
        for (int rr = 0; rr < 8; ++rr) { asm volatile("" ::: "memory"); p0_absmax(F, F.dense_w_gate, F.dense_w_up, DM * DFF / 4, CW_WMAX); }
#endif
        if (I8_P2) p0_absmax(F, F.even_in_w, F.even_in_w, DM * EVEN_IN / 4, CW_WMAX + 1);
        if (I8_P10) p0_absmax(F, F.nsa_in_w, F.nsa_in_w, DM * NSA_IN / 4, CW_WMAX + 2);
    } SEAM(0);
    if (IN(1)) REP(1) {
        if (I8_DUP) { const float wm = __builtin_bit_cast(float, __hip_atomic_load(F.ctl + CW_WMAX, RLX_AGENT)); CvtSeg sg{7168, 3584, 0, 0, 0, 7168}; p0_convert(F, sg, wm > 0.f ? 127.f / wm : 0.f); }
        if (I8_P2) { const float w1 = __builtin_bit_cast(float, __hip_atomic_load(F.ctl + CW_WMAX + 1, RLX_AGENT)); CvtSeg s1{2560, 0, 0, 0, 0, 2560}; p0_convert(F, s1, w1 > 0.f ? 127.f / w1 : 0.f); }
        if (I8_P10) { const float w2 = __builtin_bit_cast(float, __hip_atomic_load(F.ctl + CW_WMAX + 2, RLX_AGENT)); CvtSeg s2{2592, 14336, 0, 0, 0, 2592}; p0_convert(F, s2, w2 > 0.f ? 127.f / w2 : 0.f); }
        __syncthreads();
        normmod_phase<(I8_P2 ? 2 : 0)>(F, F.x, F.norm_mix_g, mod0); for (int i = F.vcu; i < 64; i += F.G) cmp_posbias(F, i); } SEAM(1);
    if (IN(2)) REP(2) { pg8::StaticOrder S; S.init(MTOK, EVEN_IN, F.G, (int)blockIdx.x);
#if I8_P2
        const float wm = __builtin_bit_cast(float, __hip_atomic_load(F.ctl + CW_WMAX + 1, RLX_AGENT));
        pg8::Gemm g{(const pg8::bf16_t*)F.h, (const pg8::bf16_t*)F.Win0, MTOK, EVEN_IN, DM / 2};
        pg8::EpiBf16Pi8 E{F.proj, EVEN_IN, F.rowsa, wm * (1.f / 127.f)};
        pg8::gemm_phase<pg8::EpiBf16Pi8, pg8::StaticOrder, true, true, 2>(F.lds + RING_OFF, g, S, E, F.tid);
#else
        pg8::Gemm g{F.h, F.Win0, MTOK, EVEN_IN, DM};
        pg8::EpiBf16P E{F.proj, EVEN_IN};
        pg8::gemm_phase<pg8::EpiBf16P, pg8::StaticOrder, true, true>(F.lds + RING_OFF, g, S, E, F.tid);
#endif
        if (LATE_P2 && F.G == 256 && blockIdx.x >= 128) { CvtSeg sl{LATE_P2, CVT_TOTAL - LATE_ALL, 0, 0, 0, LATE_P2}; p0_convert(F, sl, 0.f, ((int)blockIdx.x - 128) * NWAVES + F.wave, 128 * NWAVES); }
    } SEAM(2);
    if (IN(3)) REP(3) { for (int u = F.vcu; u < 256; u += F.G) sb_mfma_unit(F, u);
#ifdef PROBE_SB
        for (int u = F.vcu; u < 256; u += F.G) sb_mfma_unit(F, u);
#endif
        for (int u = F.vcu; u < 2048; u += F.G) rglru_local_unit(F, u);
#ifdef PROBE_RG
        for (int u = F.vcu; u < 2048; u += F.G) rglru_local_unit(F, u);
#endif
    } SEAM(3);
    if (IN(4)) REP(4) { for (int u = F.vcu; u < 512; u += F.G) rglru_fix_unit(F, u); } SEAM(4);
    if (IN(5)) REP(5) { pg8::Gemm g{F.mix, F.Wout0, MTOK, DM, DM}; pg8::StaticOrder S; S.init(MTOK, DM, F.G, (int)blockIdx.x);
#if RES_BF16
        pg8::EpiResidB<true> E{F.x, (pg8::bf16_t*)F.xa, DM, mod0 + 4096, 6144, SEQ, 1.f};
        pg8::gemm_phase<pg8::EpiResidB<true>, pg8::StaticOrder, false, true>(F.lds + RING_OFF, g, S, E, F.tid);
#else
        pg8::EpiResid E{F.x, F.xa, DM, mod0 + 4096, 6144, SEQ, 1.f};
        pg8::gemm_phase<pg8::EpiResid, pg8::StaticOrder, false, true>(F.lds + RING_OFF, g, S, E, F.tid);
#endif
    } SEAM(5);
    if (IN(6)) REP(6) { normmod_phase<(I8_DUP ? 2 : (FP8_DUP ? 1 : 0)), RES_BF16 != 0>(F, F.xa, F.norm_ffn_g, mod1); } SEAM(6);
    if (IN(7)) REP(7) { pg8::StaticOrder S; S.init(MTOK, 2 * DFF, F.G, (int)blockIdx.x);
#if I8_DUP
        const float wm = __builtin_bit_cast(float, __hip_atomic_load(F.ctl + CW_WMAX, RLX_AGENT));
        pg8::Gemm g{(const pg8::bf16_t*)F.h, (const pg8::bf16_t*)F.Wgu0, MTOK, 2 * DFF, DM / 2};
        pg8::EpiSwiGLUi8<FP8_DDN != 0> E{F.act, DFF, F.rowsa, wm * (1.f / 127.f)};
        pg8::gemm_phase<pg8::EpiSwiGLUi8<FP8_DDN != 0>, pg8::StaticOrder, true, true, 2>(F.lds + RING_OFF, g, S, E, F.tid);
#elif FP8_DUP && FP8_DDN
        pg8::Gemm g{(const pg8::bf16_t*)F.h, (const pg8::bf16_t*)F.Wgu0, MTOK, 2 * DFF, DM / 2};
        pg8::EpiSwiGLU8 E{(unsigned char*)F.act, DFF, W8_INV};
        pg8::gemm_phase<pg8::EpiSwiGLU8, pg8::StaticOrder, true, true, 1>(F.lds + RING_OFF, g, S, E, F.tid);
#elif FP8_DUP
        pg8::Gemm g{(const pg8::bf16_t*)F.h, (const pg8::bf16_t*)F.Wgu0, MTOK, 2 * DFF, DM / 2};
        pg8::EpiSwiGLU E{F.act, DFF, W8_INV};
        pg8::gemm_phase<pg8::EpiSwiGLU, pg8::StaticOrder, true, true, 1>(F.lds + RING_OFF, g, S, E, F.tid);
#else
        pg8::Gemm g{F.h, F.Wgu0, MTOK, 2 * DFF, DM};
        pg8::EpiSwiGLU E{F.act, DFF, 1.f};
        pg8::gemm_phase<pg8::EpiSwiGLU, pg8::StaticOrder, true, true>(F.lds + RING_OFF, g, S, E, F.tid);
#endif
    } SEAM(7);
    if (IN(8)) REP(8) { pg8::StaticOrder S; S.init(MTOK, DM, F.G, (int)blockIdx.x);
#if FP8_DDN
        pg8::Gemm g{(const pg8::bf16_t*)F.act, (const pg8::bf16_t*)F.Wdn0, MTOK, DM, DFF / 2};
#if RES_BF16
        pg8::EpiResidB<false> E{F.xa, (pg8::bf16_t*)F.xb, DM, mod1 + 4096, 6144, SEQ, W8_INV};
        pg8::gemm_phase<pg8::EpiResidB<false>, pg8::StaticOrder, false, true, 1>(F.lds + RING_OFF, g, S, E, F.tid);
#else
        pg8::EpiResid E{F.xa, F.xb, DM, mod1 + 4096, 6144, SEQ, W8_INV};
        pg8::gemm_phase<pg8::EpiResid, pg8::StaticOrder, false, true, 1>(F.lds + RING_OFF, g, S, E, F.tid);
#endif
#else
        pg8::Gemm g{F.act, F.Wdn0, MTOK, DM, DFF};
        pg8::EpiResid E{F.xa, F.xb, DM, mod1 + 4096, 6144, SEQ, 1.f};
        pg8::gemm_phase<pg8::EpiResid, pg8::StaticOrder, false, true>(F.lds + RING_OFF, g, S, E, F.tid);
#endif
    } SEAM(8);
    if (IN(9)) REP(9) { normmod_phase<(I8_P10 ? 2 : 0), RES_BF16 != 0>(F, F.xb, F.norm_mix_g + DM, mod2); } SEAM(9);
    if (IN(10)) REP(10) { pg8::StaticOrder S; S.init(MTOK, NSA_INP, F.G, (int)blockIdx.x);
#if I8_P10
        const float wm = __builtin_bit_cast(float, __hip_atomic_load(F.ctl + CW_WMAX + 2, RLX_AGENT));
        pg8::Gemm g{(const pg8::bf16_t*)F.h, (const pg8::bf16_t*)F.Win1, MTOK, NSA_INP, DM / 2};
        pg8::EpiBf16Pi8 E{F.proj, NSA_INP, F.rowsa, wm * (1.f / 127.f)};
        pg8::gemm_phase<pg8::EpiBf16Pi8, pg8::StaticOrder, true, true, 2>(F.lds + RING_OFF, g, S, E, F.tid);
#else
        pg8::Gemm g{F.h, F.Win1, MTOK, NSA_INP, DM};
        pg8::EpiBf16P E{F.proj, NSA_INP};
        pg8::gemm_phase<pg8::EpiBf16P, pg8::StaticOrder, true, true>(F.lds + RING_OFF, g, S, E, F.tid);
#endif
        if (LATE_P10 && F.G == 256 && blockIdx.x >= 160) { CvtSeg sl{LATE_P10, CVT_TOTAL - LATE_ALL + LATE_P2, 0, 0, 0, LATE_P10}; p0_convert(F, sl, 0.f, ((int)blockIdx.x - 160) * NWAVES + F.wave, 96 * NWAVES); }
    } SEAM(10);
    if (IN(11)) REP(11) { for (int u = F.vcu; u < 160; u += F.G) cmp_mfma_unit(F, u);
        if (LATE_P11 && F.G == 256 && F.vcu >= 160) { CvtSeg sl{LATE_P11, CVT_TOTAL - LATE_ALL + LATE_P2 + LATE_P10, 0, 0, 0, LATE_P11}; p0_convert(F, sl, 0.f, (F.vcu - 160) * NWAVES + F.wave, 96 * NWAVES); }
    } SEAM(11);
    if (IN(12)) REP(12) { for (int idx = F.vcu; idx < 256; idx += F.G) { const int bg = idx >> 4, q16 = idx & 15; nsa_mfma_unit(F, (bg << 5) | q16); nsa_mfma_unit(F, (bg << 5) | (31 - q16)); } } SEAM(12);
    if (IN(13)) REP(13) { pg8::StaticOrder S; S.init(MTOK, DM, F.G, (int)blockIdx.x);
#if FP8_P13
        pg8::Gemm g{(const pg8::bf16_t*)F.mix, (const pg8::bf16_t*)F.Wout1, MTOK, DM, DM / 2};
        pg8::EpiResid E{F.xb, F.xa, DM, mod2 + 4096, 6144, SEQ, W8_INV};
        pg8::gemm_phase<pg8::EpiResid, pg8::StaticOrder, false, true, 1>(F.lds + RING_OFF, g, S, E, F.tid);
#else
        pg8::Gemm g{F.mix, F.Wout1, MTOK, DM, DM};
#if RES_BF16
        pg8::EpiResidB<false> E{F.xb, (pg8::bf16_t*)F.xa, DM, mod2 + 4096, 6144, SEQ, 1.f};
        pg8::gemm_phase<pg8::EpiResidB<false>, pg8::StaticOrder, false, true>(F.lds + RING_OFF, g, S, E, F.tid);
#else
        pg8::EpiResid E{F.xb, F.xa, DM, mod2 + 4096, 6144, SEQ, 1.f};
        pg8::gemm_phase<pg8::EpiResid, pg8::StaticOrder, false, true>(F.lds + RING_OFF, g, S, E, F.tid);
#endif
#endif
    } SEAM(13);
    if (IN(14)) REP(14) { for (int tb = F.vcu; tb < 256; tb += F.G) router_block(F, tb, F.xa, F.norm_ffn_g + DM, mod3); } SEAM(14);
    if (IN(15)) REP(15) { for (int tb = F.vcu; tb < 256; tb += F.G) moe_scatter_block(F, tb); } SEAM(15);
    if (IN(16)) REP(16) { pg8::MoeOrder S;
#pragma unroll
        for (int e = 0; e < 9; ++e) S.tc[e] = __builtin_amdgcn_readfirstlane((int)__hip_atomic_load(F.ctl + CW_TILE + e, RLX_AGENT));
        S.nN = 2 * DFF / 256; S.G = F.G; S.c = (int)blockIdx.x; S.plan(0, 0);
#if FP8_MOE
        S.estride = 2u * DFF * DM;
        pg8::Gemm g{(const pg8::bf16_t*)F.hperm, (const pg8::bf16_t*)F.Wmgu, MOE_ROWS, 2 * DFF, DM / 2};
        pg8::EpiSwiGLU8 E{(unsigned char*)F.act, DFF, W8_INV};
        pg8::gemm_phase<pg8::EpiSwiGLU8, pg8::MoeOrder, true, true, 1>(F.lds + RING_OFF, g, S, E, F.tid);
#else
        S.estride = 2u * DFF * DM * 2u;
        pg8::Gemm g{F.hperm, F.Wmgu, MOE_ROWS, 2 * DFF, DM};
        pg8::EpiSwiGLU E{F.act, DFF, 1.f};
        pg8::gemm_phase<pg8::EpiSwiGLU, pg8::MoeOrder, true, true>(F.lds + RING_OFF, g, S, E, F.tid);
#endif
    } SEAM(16);
    if (IN(17)) REP(17) {
#if FP8_MOE
        pg8::MoeOrderT<MOE_SPLIT != 0> S;
#pragma unroll
        for (int e = 0; e < 9; ++e) S.tc[e] = __builtin_amdgcn_readfirstlane((int)__hip_atomic_load(F.ctl + CW_TILE + e, RLX_AGENT));
        S.nN = DM / 256; S.G = F.G; S.c = (int)blockIdx.x; S.estride = (unsigned)DFF * DM; S.plan(DFF / 128, DFF);
        typedef pg8::EpiMoeDown<WS_Y, WS_ROWP, WS_PART, DM> EpiMD; EpiMD E{(unsigned char*)F.mod - WS_MOD};
        pg8::Gemm g{(const pg8::bf16_t*)F.act, (const pg8::bf16_t*)F.Wmdn, MOE_ROWS, DM, DFF / 2};
        pg8::gemm_phase<EpiMD, pg8::MoeOrderT<MOE_SPLIT != 0>, true, true, 1>(F.lds + RING_OFF, g, S, E, F.tid);
#else
        pg8::MoeOrder S;
#pragma unroll
        for (int e = 0; e < 9; ++e) S.tc[e] = __builtin_amdgcn_readfirstlane((int)__hip_atomic_load(F.ctl + CW_TILE + e, RLX_AGENT));
        S.nN = DM / 256; S.G = F.G; S.c = (int)blockIdx.x; S.estride = (unsigned)DFF * DM * 2u; S.plan(DFF / 64, DFF * 2);
        typedef pg8::EpiMoeDown<WS_Y, WS_ROWP, WS_PART, DM> EpiMD; EpiMD E{(unsigned char*)F.mod - WS_MOD};
        pg8::Gemm g{F.act, F.Wmdn, MOE_ROWS, DM, DFF};
        pg8::gemm_phase<EpiMD, pg8::MoeOrder, true, true>(F.lds + RING_OFF, g, S, E, F.tid);
#endif
    } SEAM(17);
    if (IN(18)) REP(18) { final_phase(F, F.xa, mod3 + 4096); }
#undef IN
#undef SEAM
#undef mod0
#undef mod1
#undef mod2
#undef mod3
}

extern "C" void kernel_launch(void* const* d_in, const int* in_sizes, int n_in, void* d_out, int out_size, void* d_ws, size_t ws_size, hipStream_t stream) {
    static int grid = 0;
    if (grid == 0) {
        if (n_in != 33 || in_sizes[0] != MTOK * DM || out_size != MTOK * DM || ws_size < WS_END) {
            fprintf(stderr, "kernel_launch: built for 33 inputs, x/out of %d floats, >= %zu bytes of workspace; got n_in %d, in0 %d, out %d, ws %zu; nothing launched\n", MTOK * DM, (size_t)WS_END, n_in, n_in > 0 ? in_sizes[0] : -1, out_size, ws_size); grid = -1; return; }
        int dev = 0, cus = 0, per_cu = 0;
        if (hipGetDevice(&dev) != hipSuccess || hipDeviceGetAttribute(&cus, hipDeviceAttributeMultiprocessorCount, dev) != hipSuccess) { fprintf(stderr, "kernel_launch: device query failed\n"); grid = -1; return; }
        if (hipFuncSetAttribute((const void*)mk_fwd, hipFuncAttributeMaxDynamicSharedMemorySize, LDS_BYTES) != hipSuccess) { fprintf(stderr, "kernel_launch: hipFuncSetAttribute failed\n"); grid = -1; return; }
        if (hipOccupancyMaxActiveBlocksPerMultiprocessor(&per_cu, (const void*)mk_fwd, NTHR, LDS_BYTES) != hipSuccess || per_cu < 1)
            fprintf(stderr, "kernel_launch: note: occupancy query reports %d workgroups per CU\n", per_cu);
        (void)hipGetLastError();
        grid = cus;
    }
    if (grid < 0) return;
    if (hipMemsetAsync((char*)d_ws + WS_CTL, 0, CTL_ZERO_BYTES, stream) != hipSuccess) { fprintf(stderr, "kernel_launch: memset failed\n"); return; }
    Args a{};
    for (int i = 0; i < 33; ++i) a.in[i] = (const float*)d_in[i];
    a.out = (float*)d_out; a.ws = (unsigned char*)d_ws;
    for (int li = 0; li < N_LAUNCHES; ++li) {
        a.ph_lo = (N_LAUNCHES == 1) ? 0 : li; a.ph_hi = (N_LAUNCHES == 1) ? NPH : li + 1;
        hipLaunchKernelGGL(mk_fwd, dim3(grid), dim3(NTHR), LDS_BYTES, stream, a);
        const hipError_t le = hipPeekAtLastError();
        if (le != hipSuccess) { fprintf(stderr, "kernel_launch: launch %d failed: %s\n", li, hipGetErrorName(le)); break; }
    }
}
```

```cpp
#include <hip/hip_runtime.h>
#include <cstdio>
#include <cstdint>
namespace pg8 {
#define PG8_LAS __attribute__((address_space(3)))
typedef unsigned short bf16_t;
typedef short bf16x8 __attribute__((ext_vector_type(8)));
typedef float f32x4 __attribute__((ext_vector_type(4)));
typedef unsigned u32x4 __attribute__((ext_vector_type(4)));
typedef int v4i_t __attribute__((ext_vector_type(4)));
constexpr int BM = 256, BK = 64, HALF = 128, HTB = HALF * BK * 2  , STAGE_BYTES = 8 * HTB, NXCD = 8, WGM = 8;

__host__ __device__ __forceinline__ int lds_byte(int r, int c) { const int st = (r >> 4) * 2 + (c >> 5), rr = r & 15, cc = c & 31, ob = rr * 64 + cc * 2; return st * 1024 + (ob ^ (((ob >> 9) & 1) << 5)); }
__host__ __device__ __forceinline__ void stage_rc(int b, int& R, int& C) { const int st = b / 1024, sb = b % 1024, swz = sb ^ (((sb >> 9) & 1) << 5); R = (st >> 1) * 16 + swz / 64; C = (st & 1) * 32 + (swz % 64) / 2; }
__host__ __device__ __forceinline__ int perm32(int rho) { const int n = rho >> 4, i = rho & 15; return 8 * (i >> 2) + 4 * n + (i & 3); }

struct Unit { int pm, pn; size_t boff; unsigned aoff; int nt, part; };
struct Gemm { const bf16_t* A; const bf16_t* Bt; int M, N, K; };

struct StaticOrder {
    static constexpr bool VARK = false;
    int nM, nN, nwg, G, c;
    __host__ __device__ void init(int M, int N, int G_, int c_) { nM = M / BM; nN = N / BM; nwg = nM * nN; G = G_; c = c_; }
    __host__ __device__ bool next(int i, Unit& u) const {
        const long L = (long)i * G + c; if (L >= nwg) return false;
        int wgid = (int)L; { const int q = nwg / NXCD, r = nwg % NXCD, xcd = wgid % NXCD, off = wgid / NXCD; wgid = (xcd < r ? xcd * (q + 1) : r * (q + 1) + (xcd - r) * q) + off; }
        const int nig = WGM * nN, gid = wgid / nig, fm = gid * WGM, gsz = (nM - fm) < WGM ? (nM - fm) : WGM;
        u.pm = fm + ((wgid % nig) % gsz); u.pn = (wgid % nig) / gsz; u.boff = 0; u.aoff = 0; u.nt = 0; u.part = -1; return true;
    }
    __device__ __forceinline__ void a_ready(const Unit&) const {}
    __device__ __forceinline__ void done(const Unit&) const {}
};

__device__ __forceinline__ unsigned cvt_pk_bf16(float lo, float hi) { unsigned r; asm volatile("v_cvt_pk_bf16_f32 %0, %1, %2" : "=v"(r) : "v"(lo), "v"(hi)); return r; }

struct EpiBf16P {
    static constexpr bool PERM = true, AFTER_DRAIN = false;
    bf16_t* O; int ldc;
    __device__ __forceinline__ void operator()(const f32x4 (&acc)[2][2][4][2], const Unit& u, int wr, int wc, int fr, int fq) const {
        const int row0 = u.pm * BM + wr * 64 + fr, col0 = u.pn * BM + wc * 32 + 8 * fq;
#pragma unroll
        for (int ai = 0; ai < 2; ++ai)
#pragma unroll
            for (int m = 0; m < 4; ++m) { bf16_t* rowp = O + (size_t)(row0 + ai * HALF + m * 16) * ldc + col0;
#pragma unroll
                for (int bj = 0; bj < 2; ++bj) { const f32x4 v0 = acc[ai][bj][m][0], v1 = acc[ai][bj][m][1];
                    u32x4 w; w.x = cvt_pk_bf16(v0[0], v0[1]); w.y = cvt_pk_bf16(v0[2], v0[3]); w.z = cvt_pk_bf16(v1[0], v1[1]); w.w = cvt_pk_bf16(v1[2], v1[3]);
                    *(u32x4*)(rowp + bj * HALF) = w; } }
    }
};

struct EpiBf16Pi8 {
    static constexpr bool PERM = true, AFTER_DRAIN = false;
    bf16_t* O; int ldc; const float* rowscale; float wscale;
    __device__ __forceinline__ static float cf(float bits, float s) { return (float)__builtin_bit_cast(int, bits) * s; }
    __device__ __forceinline__ void operator()(const f32x4 (&acc)[2][2][4][2], const Unit& u, int wr, int wc, int fr, int fq) const {
        const int row0 = u.pm * BM + wr * 64 + fr, col0 = u.pn * BM + wc * 32 + 8 * fq;
#pragma unroll
        for (int ai = 0; ai < 2; ++ai)
#pragma unroll
            for (int m = 0; m < 4; ++m) { const int r = row0 + ai * HALF + m * 16; const float s = rowscale[r] * wscale; bf16_t* rowp = O + (size_t)r * ldc + col0;
#pragma unroll
                for (int bj = 0; bj < 2; ++bj) { const f32x4 v0 = acc[ai][bj][m][0], v1 = acc[ai][bj][m][1];
                    u32x4 w; w.x = cvt_pk_bf16(cf(v0[0], s), cf(v0[1], s)); w.y = cvt_pk_bf16(cf(v0[2], s), cf(v0[3], s)); w.z = cvt_pk_bf16(cf(v1[0], s), cf(v1[1], s)); w.w = cvt_pk_bf16(cf(v1[2], s), cf(v1[3], s));
                    *(u32x4*)(rowp + bj * HALF) = w; } }
    }
};

struct EpiResid {
    static constexpr bool PERM = false, AFTER_DRAIN = false;
    const float* xin; float* xout; int ldc; const float* gate; int gpitch; int rows_per_batch; float sc;
    __device__ __forceinline__ void operator()(const f32x4 (&acc)[2][2][4][2], const Unit& u, int wr, int wc, int fr, int fq) const {
        const int row0 = u.pm * BM + wr * 64 + fr, col0 = u.pn * BM + wc * 32 + 4 * fq;
        const float* gp = gate + (size_t)((u.pm * BM) / rows_per_batch) * gpitch + col0;
        f32x4 gv[2][2];
#pragma unroll
        for (int bj = 0; bj < 2; ++bj)
#pragma unroll
            for (int n = 0; n < 2; ++n) gv[bj][n] = *(const f32x4*)(gp + bj * HALF + n * 16) * sc;
#pragma unroll
        for (int ai = 0; ai < 2; ++ai)
#pragma unroll
            for (int m = 0; m < 4; ++m) { const size_t off = (size_t)(row0 + ai * HALF + m * 16) * ldc + col0;
#pragma unroll
                for (int bj = 0; bj < 2; ++bj)
#pragma unroll
                    for (int n = 0; n < 2; ++n) { const f32x4 xi = *(const f32x4*)(xin + off + bj * HALF + n * 16);
                        *(f32x4*)(xout + off + bj * HALF + n * 16) = xi + gv[bj][n] * acc[ai][bj][m][n]; } }
    }
};

template <bool XIN_F32> struct EpiResidB {
    static constexpr bool PERM = true, AFTER_DRAIN = false;
    const void* xin; bf16_t* xout; int ldc; const float* gate; int gpitch; int rows_per_batch; float sc;
    __device__ __forceinline__ static float lo(unsigned u) { return __builtin_bit_cast(float, u << 16); }
    __device__ __forceinline__ static float hi(unsigned u) { return __builtin_bit_cast(float, u & 0xffff0000u); }
    __device__ __forceinline__ void operator()(const f32x4 (&acc)[2][2][4][2], const Unit& u, int wr, int wc, int fr, int fq) const {
        const int row0 = u.pm * BM + wr * 64 + fr, col0 = u.pn * BM + wc * 32 + 8 * fq;
        const float* gp = gate + (size_t)((u.pm * BM) / rows_per_batch) * gpitch + col0;
        f32x4 gv[2][2];
#pragma unroll
        for (int bj = 0; bj < 2; ++bj)
#pragma unroll
            for (int n = 0; n < 2; ++n) gv[bj][n] = *(const f32x4*)(gp + bj * HALF + n * 4) * sc;
#pragma unroll
        for (int ai = 0; ai < 2; ++ai)
#pragma unroll
            for (int m = 0; m < 4; ++m) { const size_t off = (size_t)(row0 + ai * HALF + m * 16) * ldc + col0;
#pragma unroll
                for (int bj = 0; bj < 2; ++bj) { f32x4 x0, x1;
                    if constexpr (XIN_F32) { x0 = *(const f32x4*)((const float*)xin + off + bj * HALF); x1 = *(const f32x4*)((const float*)xin + off + bj * HALF + 4); }
                    else { const u32x4 q = *(const u32x4*)((const bf16_t*)xin + off + bj * HALF); x0 = (f32x4){lo(q.x), hi(q.x), lo(q.y), hi(q.y)}; x1 = (f32x4){lo(q.z), hi(q.z), lo(q.w), hi(q.w)}; }
                    const f32x4 v0 = x0 + gv[bj][0] * acc[ai][bj][m][0], v1 = x1 + gv[bj][1] * acc[ai][bj][m][1];
                    u32x4 w; w.x = cvt_pk_bf16(v0[0], v0[1]); w.y = cvt_pk_bf16(v0[2], v0[3]); w.z = cvt_pk_bf16(v1[0], v1[1]); w.w = cvt_pk_bf16(v1[2], v1[3]);
                    *(u32x4*)(xout + off + bj * HALF) = w; } }
    }
};

struct EpiSwiGLU {
    static constexpr bool PERM = true, AFTER_DRAIN = false;
    bf16_t* O; int ldc; float sc;
    __device__ __forceinline__ float silu_mul(float g, float u) const { g *= sc; u *= sc; return g * u * __builtin_amdgcn_rcpf(1.f + __builtin_amdgcn_exp2f(-1.44269504089f * g)); }
    __device__ __forceinline__ void operator()(const f32x4 (&acc)[2][2][4][2], const Unit& u, int wr, int wc, int fr, int fq) const {
        const int row0 = u.pm * BM + wr * 64 + fr, col0 = u.pn * HALF + wc * 32 + 8 * fq;
#pragma unroll
        for (int ai = 0; ai < 2; ++ai)
#pragma unroll
            for (int m = 0; m < 4; ++m) { bf16_t* rowp = O + (size_t)(row0 + ai * HALF + m * 16) * ldc + col0;
                const f32x4 g0 = acc[ai][0][m][0], g1 = acc[ai][0][m][1], u0 = acc[ai][1][m][0], u1 = acc[ai][1][m][1];
                u32x4 w; w.x = cvt_pk_bf16(silu_mul(g0[0], u0[0]), silu_mul(g0[1], u0[1])); w.y = cvt_pk_bf16(silu_mul(g0[2], u0[2]), silu_mul(g0[3], u0[3]));
                w.z = cvt_pk_bf16(silu_mul(g1[0], u1[0]), silu_mul(g1[1], u1[1])); w.w = cvt_pk_bf16(silu_mul(g1[2], u1[2]), silu_mul(g1[3], u1[3]));
                *(u32x4*)rowp = w; }
    }
};

__device__ __forceinline__ float clamp448(float v) { return __builtin_fminf(__builtin_fmaxf(v, -448.f), 448.f); }
__device__ __forceinline__ unsigned pk4_fp8(float a, float b, float c, float d) { int p = __builtin_amdgcn_cvt_pk_fp8_f32(clamp448(a), clamp448(b), 0, false); p = __builtin_amdgcn_cvt_pk_fp8_f32(clamp448(c), clamp448(d), p, true); return (unsigned)p; }
template <bool OUT8> struct EpiSwiGLUi8 {
    static constexpr bool PERM = true, AFTER_DRAIN = false;
    bf16_t* O; int ldc; const float* rowscale; float wscale;
    __device__ __forceinline__ static float sm(float g, float u) { return g * u * __builtin_amdgcn_rcpf(1.f + __builtin_amdgcn_exp2f(-1.44269504089f * g)); }
    __device__ __forceinline__ static float cf(float bits, float s) { return (float)__builtin_bit_cast(int, bits) * s; }
    __device__ __forceinline__ void operator()(const f32x4 (&acc)[2][2][4][2], const Unit& u, int wr, int wc, int fr, int fq) const {
        const int row0 = u.pm * BM + wr * 64 + fr, col0 = u.pn * HALF + wc * 32 + 8 * fq;
#pragma unroll
        for (int ai = 0; ai < 2; ++ai)
#pragma unroll
            for (int m = 0; m < 4; ++m) { const int r = row0 + ai * HALF + m * 16; const float s = rowscale[r] * wscale;
                const f32x4 g0 = acc[ai][0][m][0], g1 = acc[ai][0][m][1], u0 = acc[ai][1][m][0], u1 = acc[ai][1][m][1];
                const float v0 = sm(cf(g0[0], s), cf(u0[0], s)), v1 = sm(cf(g0[1], s), cf(u0[1], s)), v2 = sm(cf(g0[2], s), cf(u0[2], s)), v3 = sm(cf(g0[3], s), cf(u0[3], s));
                const float v4 = sm(cf(g1[0], s), cf(u1[0], s)), v5 = sm(cf(g1[1], s), cf(u1[1], s)), v6 = sm(cf(g1[2], s), cf(u1[2], s)), v7 = sm(cf(g1[3], s), cf(u1[3], s));
                if constexpr (OUT8) { uint2 w; w.x = pk4_fp8(v0, v1, v2, v3); w.y = pk4_fp8(v4, v5, v6, v7); *(uint2*)((unsigned char*)O + (size_t)r * ldc + col0) = w; }
                else { u32x4 w; w.x = cvt_pk_bf16(v0, v1); w.y = cvt_pk_bf16(v2, v3); w.z = cvt_pk_bf16(v4, v5); w.w = cvt_pk_bf16(v6, v7); *(u32x4*)(O + (size_t)r * ldc + col0) = w; } }
    }
};

struct EpiSwiGLU8 {
    static constexpr bool PERM = true, AFTER_DRAIN = false;
    unsigned char* O; int ldc; float sc;
    __device__ __forceinline__ float sm(float g, float u) const { g *= sc; u *= sc; return g * u * __builtin_amdgcn_rcpf(1.f + __builtin_amdgcn_exp2f(-1.44269504089f * g)); }
    __device__ __forceinline__ void operator()(const f32x4 (&acc)[2][2][4][2], const Unit& u, int wr, int wc, int fr, int fq) const {
        const int row0 = u.pm * BM + wr * 64 + fr, col0 = u.pn * HALF + wc * 32 + 8 * fq;
#pragma unroll
        for (int ai = 0; ai < 2; ++ai)
#pragma unroll
            for (int m = 0; m < 4; ++m) { unsigned char* rowp = O + (size_t)(row0 + ai * HALF + m * 16) * ldc + col0;
                const f32x4 g0 = acc[ai][0][m][0], g1 = acc[ai][0][m][1], u0 = acc[ai][1][m][0], u1 = acc[ai][1][m][1];
                uint2 w; w.x = pk4_fp8(sm(g0[0], u0[0]), sm(g0[1], u0[1]), sm(g0[2], u0[2]), sm(g0[3], u0[3]));
                w.y = pk4_fp8(sm(g1[0], u1[0]), sm(g1[1], u1[1]), sm(g1[2], u1[2]), sm(g1[3], u1[3]));
                *(uint2*)rowp = w; }
    }
};

struct EpiScaleRow {
    static constexpr bool PERM = false, AFTER_DRAIN = false;
    float* C; int ldc; const float* rowscale;
    __device__ __forceinline__ void operator()(const f32x4 (&acc)[2][2][4][2], const Unit& u, int wr, int wc, int fr, int fq) const {
        const int row0 = u.pm * BM + wr * 64 + fr, col0 = u.pn * BM + wc * 32 + 4 * fq;
#pragma unroll
        for (int ai = 0; ai < 2; ++ai)
#pragma unroll
            for (int m = 0; m < 4; ++m) { const int r = row0 + ai * HALF + m * 16; const float s = rowscale[r]; float* rowp = C + (size_t)r * ldc + col0;
#pragma unroll
                for (int bj = 0; bj < 2; ++bj)
#pragma unroll
                    for (int n = 0; n < 2; ++n) *(f32x4*)(rowp + bj * HALF + n * 16) = acc[ai][bj][m][n] * s; }
    }
};

struct EpiScaleRowBf16 {
    static constexpr bool PERM = true, AFTER_DRAIN = false;
    bf16_t* O; int ldc; const float* rowscale;
    __device__ __forceinline__ void operator()(const f32x4 (&acc)[2][2][4][2], const Unit& u, int wr, int wc, int fr, int fq) const {
        const int row0 = u.pm * BM + wr * 64 + fr, col0 = u.pn * BM + wc * 32 + 8 * fq;
#pragma unroll
        for (int ai = 0; ai < 2; ++ai)
#pragma unroll
            for (int m = 0; m < 4; ++m) { const int r = row0 + ai * HALF + m * 16; const float s = rowscale[r]; bf16_t* rowp = O + (size_t)r * ldc + col0;
#pragma unroll
                for (int bj = 0; bj < 2; ++bj) { const f32x4 v0 = acc[ai][bj][m][0] * s, v1 = acc[ai][bj][m][1] * s;
                    u32x4 w; w.x = cvt_pk_bf16(v0[0], v0[1]); w.y = cvt_pk_bf16(v0[2], v0[3]); w.z = cvt_pk_bf16(v1[0], v1[1]); w.w = cvt_pk_bf16(v1[2], v1[3]);
                    *(u32x4*)(rowp + bj * HALF) = w; } }
    }
};

template <size_t OFF_Y, size_t OFF_ROWP, size_t OFF_PART, int LDC> struct EpiMoeDown {
    static constexpr bool PERM = true, AFTER_DRAIN = false;
    unsigned char* ws;
    __device__ __forceinline__ void operator()(const f32x4 (&acc)[2][2][4][2], const Unit& u, int wr, int wc, int fr, int fq) const {
        const int rl0 = wr * 64 + fr, cl0 = wc * 32 + 8 * fq; constexpr int ldc = LDC;
        bf16_t* O = (bf16_t*)(ws + OFF_Y); const float* rowscale = (const float*)(ws + OFF_ROWP); float* part = (float*)(ws + OFF_PART);
        if (u.part < 0) {
#pragma unroll
            for (int ai = 0; ai < 2; ++ai)
#pragma unroll
                for (int m = 0; m < 4; ++m) { const int r = u.pm * BM + rl0 + ai * HALF + m * 16; const float s = rowscale[r]; bf16_t* rowp = O + (size_t)r * ldc + u.pn * BM + cl0;
#pragma unroll
                    for (int bj = 0; bj < 2; ++bj) { const f32x4 v0 = acc[ai][bj][m][0] * s, v1 = acc[ai][bj][m][1] * s;
                        u32x4 w; w.x = cvt_pk_bf16(v0[0], v0[1]); w.y = cvt_pk_bf16(v0[2], v0[3]); w.z = cvt_pk_bf16(v1[0], v1[1]); w.w = cvt_pk_bf16(v1[2], v1[3]);
                        *(u32x4*)(rowp + bj * HALF) = w; } }
        } else {
            float* pb = part + (size_t)u.part * 65536;
#pragma unroll
            for (int ai = 0; ai < 2; ++ai)
#pragma unroll
                for (int m = 0; m < 4; ++m) { const int rl = rl0 + ai * HALF + m * 16; const float s = rowscale[u.pm * BM + rl]; float* rowp = pb + rl * 256 + cl0;
#pragma unroll
                    for (int bj = 0; bj < 2; ++bj) { *(f32x4*)(rowp + bj * HALF) = acc[ai][bj][m][0] * s; *(f32x4*)(rowp + bj * HALF + 4) = acc[ai][bj][m][1] * s; } }
        }
    }
};

__device__ __forceinline__ int moe_unremap(int wgid, int nwg) {
    const int q = nwg / NXCD, r = nwg % NXCD; int xcd, off;
    if (wgid < r * (q + 1)) { xcd = wgid / (q + 1); off = wgid - xcd * (q + 1); } else { const int w = wgid - r * (q + 1); xcd = r + w / q; off = w - (xcd - r) * q; }
    return off * NXCD + xcd;
}
__device__ __forceinline__ void moe_split_plan(int nwg, int G, int ktiles, int& nfull, int& nleft, int& S) {
    nfull = nwg; nleft = 0; S = 1;
    if (G == 256) { const int rounds = nwg / G, rem = nwg - rounds * G;
        if (rounds >= 1 && rem > 0 && rem <= 64) { const int s = (rem <= 36) ? 7 : 4; if (ktiles % (2 * s) == 0) { S = s; nfull = rounds * G; nleft = rem; } } }
}
template <bool SPLIT> struct MoeOrderT {
    static constexpr bool VARK = SPLIT;
    int tc[9]; int nN, G, c; unsigned estride;
    int ntfull, nfull, nleft, S, kslice;
    __device__ __forceinline__ void plan(int ktiles, int kbytes) { ntfull = ktiles; nfull = tc[8] * nN; nleft = 0; S = 1; kslice = 0;
        if (SPLIT) { moe_split_plan(tc[8] * nN, G, ktiles, nfull, nleft, S); kslice = kbytes / S; } }
    __device__ __forceinline__ bool next(int i, Unit& u) const {
        const int nwg = tc[8] * nN; int L = i * G + c; int s = 0, slot = -1;
        if (SPLIT && L >= nfull) { const int t = L - nfull; if (t >= nleft * S) return false; s = t % S; slot = t; L = nfull + t / S; }
        if (L >= nwg) return false;
        int wgid = L; { const int q = nwg / NXCD, r = nwg % NXCD, xcd = wgid % NXCD, off = wgid / NXCD; wgid = (xcd < r ? xcd * (q + 1) : r * (q + 1) + (xcd - r) * q) + off; }
        int e = 0, start = 0, nt = tc[1];
#pragma unroll
        for (int k = 1; k < 8; ++k) { if (wgid >= tc[k] * nN) { e = k; start = tc[k]; nt = tc[k + 1] - tc[k]; } }
        const int r2 = wgid - start * nN;
        u.pn = r2 / nt; u.pm = start + r2 % nt; u.aoff = (unsigned)(s * kslice); u.boff = (size_t)((unsigned)e * estride + (unsigned)(s * kslice)); u.nt = (slot >= 0) ? ntfull / S : ntfull; u.part = slot; return true;
    }
    __device__ __forceinline__ void a_ready(const Unit&) const {}
    __device__ __forceinline__ void done(const Unit&) const {}
};
typedef MoeOrderT<false> MoeOrder;

template <class Epi, class Sched, bool ALIGN_EPI = false, bool SP2 = false, int MODE = 0>
__device__ __forceinline__ void gemm_phase(PG8_LAS unsigned char* lds, const Gemm g, const Sched& S, const Epi& E, const int tid_in) {
    constexpr bool F8 = (MODE == 1);
    const int tid = tid_in, wid = __builtin_amdgcn_readfirstlane(tid >> 6), lane = tid & 63, wr = wid >> 2, wc = wid & 3, fr = lane & 15, fq = lane >> 4;
    const int K = g.K, nt = K / BK;
    unsigned voffA[2], voffB[2];
#pragma unroll
    for (int i = 0; i < 2; ++i) { int R, C; stage_rc(tid * 16 + i * 8192, R, C); const int Rb = Epi::PERM ? ((R & ~31) + perm32(R & 31)) : R;
        voffA[i] = (unsigned)(R * K + C) * 2u; voffB[i] = (unsigned)(Rb * K + C) * 2u; }
    const size_t kstep = (size_t)(BK * 2);
    const size_t hstep = (size_t)HALF * K * 2;
    const size_t tstep = 2 * hstep;
    const unsigned ldsbase = (unsigned)__builtin_amdgcn_readfirstlane((int)((unsigned)(uintptr_t)lds + (unsigned)wid * 1024u));
    const unsigned ldsw = (unsigned)wid * 1024u;
    const int aoff = lds_byte(wr * 64 + fr, fq * 8), boff = lds_byte(wc * 32 + fr, fq * 8);
#define PG8_SA(b, h) (((b) * 2 + (h)) * HTB)
#define PG8_SB(b, h) ((4 + (b) * 2 + (h)) * HTB)
#define PG8_STAGE(bufoff, gbase, voff) do { _Pragma("unroll") for (int _i = 0; _i < 2; ++_i) { \
        if constexpr (F8) { unsigned keep_; asm volatile("s_mov_b32 %0, m0\n\ts_mov_b32 m0, %3\n\ts_nop 0\n\tglobal_load_lds_dwordx4 %1, %2\n\ts_mov_b32 m0, %0" : "=&s"(keep_) : "v"((voff)[_i]), "s"((const char*)(gbase)), "s"(ldsbase + (unsigned)((bufoff) + _i * 8192)) : "memory"); } \
        else __builtin_amdgcn_global_load_lds((const unsigned*)((const char*)(gbase) + (voff)[_i]), (PG8_LAS unsigned*)(lds + (bufoff) + ldsw + _i * 8192), 16, 0, 0); } } while (0)
#define PG8_LDA(dst, b, h) do { _Pragma("unroll") for (int m = 0; m < 4; ++m) _Pragma("unroll") for (int k = 0; k < 2; ++k) dst[m][k] = *(const PG8_LAS bf16x8*)(lds + PG8_SA(b, h) + aoff + m * 2048 + k * 1024); } while (0)
#define PG8_LDB(dst, b, h) do { _Pragma("unroll") for (int n = 0; n < 2; ++n) _Pragma("unroll") for (int k = 0; k < 2; ++k) dst[n][k] = *(const PG8_LAS bf16x8*)(lds + PG8_SB(b, h) + boff + n * 2048 + k * 1024); } while (0)
#define PG8_CAT8(x) __builtin_shufflevector(__builtin_bit_cast(v4i_t, (x)[0]), __builtin_bit_cast(v4i_t, (x)[1]), 0, 1, 2, 3, 4, 5, 6, 7)
#define PG8_MMA(ai, bj, At, Bt) do { __builtin_amdgcn_s_setprio(1); _Pragma("unroll") for (int m = 0; m < 4; ++m) _Pragma("unroll") for (int n = 0; n < 2; ++n) { \
        if constexpr (F8) { acc[ai][bj][m][n] = __builtin_amdgcn_mfma_scale_f32_16x16x128_f8f6f4(PG8_CAT8(Bt[n]), PG8_CAT8(At[m]), acc[ai][bj][m][n], 0, 0, 0, 0x7F7F7F7F, 0, 0x7F7F7F7F); } \
        else if constexpr (MODE == 2) { _Pragma("unroll") for (int k = 0; k < 2; ++k) acc[ai][bj][m][n] = __builtin_bit_cast(f32x4, __builtin_amdgcn_mfma_i32_16x16x64_i8(__builtin_bit_cast(v4i_t, Bt[n][k]), __builtin_bit_cast(v4i_t, At[m][k]), __builtin_bit_cast(v4i_t, acc[ai][bj][m][n]), 0, 0, 0)); } \
        else { _Pragma("unroll") for (int k = 0; k < 2; ++k) acc[ai][bj][m][n] = __builtin_amdgcn_mfma_f32_16x16x32_bf16(Bt[n][k], At[m][k], acc[ai][bj][m][n], 0, 0, 0); } } __builtin_amdgcn_s_setprio(0); } while (0)
#define PG8_WAIT_V(n) asm volatile("s_waitcnt vmcnt(" #n ")" ::: "memory")
#define PG8_WAIT_L(n) asm volatile("s_waitcnt lgkmcnt(" #n ")" ::: "memory")
#define PG8_BAR __builtin_amdgcn_s_barrier()
#define PG8_SCHED __builtin_amdgcn_sched_barrier(0)
    Unit cur, nxt; int ui = 0;
    if (!S.next(0, cur)) return;
    f32x4 acc[2][2][4][2];
#pragma unroll
    for (int a = 0; a < 2; ++a)
#pragma unroll
        for (int b = 0; b < 2; ++b)
#pragma unroll
            for (int m = 0; m < 4; ++m)
#pragma unroll
                for (int n = 0; n < 2; ++n) acc[a][b][m][n] = (f32x4){0.f, 0.f, 0.f, 0.f};
    bf16x8 At[4][2], B0[2][2], B1[2][2];
    int ntc = nt; if constexpr (Sched::VARK) ntc = cur.nt;
    const char* cA = (const char*)g.A + (size_t)cur.pm * tstep + (Sched::VARK ? cur.aoff : 0u); const char* cB = (const char*)g.Bt + (size_t)cur.pn * tstep + cur.boff;
    S.a_ready(cur);
    if constexpr (SP2) {
        PG8_STAGE(PG8_SB(0, 0), cB, voffB); PG8_STAGE(PG8_SB(0, 1), cB + hstep, voffB); PG8_STAGE(PG8_SA(0, 0), cA, voffA); PG8_STAGE(PG8_SA(0, 1), cA + hstep, voffA);
        if (wr == 1) PG8_BAR;
        PG8_WAIT_V(2); PG8_BAR;
        PG8_STAGE(PG8_SB(1, 0), cB + kstep, voffB); PG8_STAGE(PG8_SA(1, 0), cA + kstep, voffA); PG8_STAGE(PG8_SB(1, 1), cB + hstep + kstep, voffB);
        PG8_WAIT_V(6); PG8_BAR;
    } else {
        PG8_STAGE(PG8_SB(0, 0), cB, voffB); PG8_STAGE(PG8_SA(0, 0), cA, voffA); PG8_STAGE(PG8_SB(0, 1), cB + hstep, voffB); PG8_STAGE(PG8_SA(0, 1), cA + hstep, voffA);
        if (wr == 1) PG8_BAR;
        PG8_WAIT_V(4); PG8_BAR;
        PG8_STAGE(PG8_SB(1, 0), cB + kstep, voffB); PG8_STAGE(PG8_SA(1, 0), cA + kstep, voffA); PG8_STAGE(PG8_SB(1, 1), cB + hstep + kstep, voffB);
        PG8_WAIT_V(6); PG8_BAR;
    }
    for (;;) {
        const bool has_next = S.next(ui + 1, nxt);
        const char* nA = has_next ? (const char*)g.A + (size_t)nxt.pm * tstep + (Sched::VARK ? nxt.aoff : 0u) : cA; const char* nB = has_next ? (const char*)g.Bt + (size_t)nxt.pn * tstep + nxt.boff : cB;
        for (int t = 0; t < ntc; t += 2) {
            const bool last = (t == ntc - 2);
            const char* a1 = cA + (size_t)(t + 1) * kstep;
            const char* a2 = last ? nA : cA + (size_t)(t + 2) * kstep; const char* b2 = last ? nB : cB + (size_t)(t + 2) * kstep;
            const char* a3 = a2 + kstep; const char* b3 = b2 + kstep;
            if (last && has_next) S.a_ready(nxt);
            if constexpr (SP2) {
            PG8_LDB(B0, 0, 0); PG8_LDB(B1, 0, 1); PG8_SCHED; PG8_LDA(At, 0, 0); PG8_STAGE(PG8_SA(1, 1), a1 + hstep, voffA);
            PG8_WAIT_V(8); PG8_WAIT_L(0); PG8_BAR; PG8_MMA(0, 0, At, B0); PG8_MMA(0, 1, At, B1); PG8_BAR; PG8_SCHED;
            PG8_LDA(At, 0, 1); PG8_STAGE(PG8_SB(0, 0), b2, voffB); PG8_STAGE(PG8_SB(0, 1), b2 + hstep, voffB); PG8_STAGE(PG8_SA(0, 0), a2, voffA);
            PG8_WAIT_V(8); PG8_WAIT_L(0); PG8_BAR; PG8_MMA(1, 0, At, B0); PG8_MMA(1, 1, At, B1); PG8_BAR; PG8_SCHED;
            PG8_LDB(B0, 1, 0); PG8_LDB(B1, 1, 1); PG8_SCHED; PG8_LDA(At, 1, 0); PG8_STAGE(PG8_SA(0, 1), a2 + hstep, voffA);
            PG8_WAIT_V(8); PG8_WAIT_L(0); PG8_BAR; PG8_MMA(0, 0, At, B0); PG8_MMA(0, 1, At, B1); PG8_BAR; PG8_SCHED;
            PG8_LDA(At, 1, 1); PG8_STAGE(PG8_SB(1, 0), b3, voffB); PG8_STAGE(PG8_SB(1, 1), b3 + hstep, voffB); PG8_STAGE(PG8_SA(1, 0), a3, voffA);
            PG8_WAIT_V(8); PG8_WAIT_L(0); PG8_BAR; PG8_MMA(1, 0, At, B0); PG8_MMA(1, 1, At, B1); PG8_BAR; PG8_SCHED;
            } else {
            PG8_LDB(B0, 0, 0); PG8_SCHED; PG8_LDA(At, 0, 0); PG8_STAGE(PG8_SA(1, 1), a1 + hstep, voffA);
            PG8_WAIT_L(8); PG8_BAR; PG8_WAIT_L(0); PG8_MMA(0, 0, At, B0); PG8_BAR; PG8_SCHED;
            PG8_LDB(B1, 0, 1); PG8_STAGE(PG8_SB(0, 0), b2, voffB);
            PG8_BAR; PG8_WAIT_L(0); PG8_MMA(0, 1, At, B1); PG8_BAR;
            PG8_LDA(At, 0, 1); PG8_STAGE(PG8_SA(0, 0), a2, voffA);
            PG8_BAR; PG8_WAIT_L(0); PG8_MMA(1, 0, At, B0); PG8_BAR; PG8_SCHED;
            PG8_STAGE(PG8_SB(0, 1), b2 + hstep, voffB);
            PG8_WAIT_V(6); PG8_BAR; PG8_MMA(1, 1, At, B1); PG8_BAR;
            PG8_LDB(B0, 1, 0); PG8_SCHED; PG8_LDA(At, 1, 0); PG8_STAGE(PG8_SA(0, 1), a2 + hstep, voffA);
            PG8_WAIT_L(8); PG8_BAR; PG8_WAIT_L(0); PG8_MMA(0, 0, At, B0); PG8_BAR; PG8_SCHED;
            PG8_LDB(B1, 1, 1); PG8_STAGE(PG8_SB(1, 0), b3, voffB);
            PG8_BAR; PG8_WAIT_L(0); PG8_MMA(0, 1, At, B1); PG8_BAR;
            PG8_LDA(At, 1, 1); PG8_STAGE(PG8_SA(1, 0), a3, voffA);
            PG8_BAR; PG8_WAIT_L(0); PG8_MMA(1, 0, At, B0); PG8_BAR; PG8_SCHED;
            PG8_STAGE(PG8_SB(1, 1), b3 + hstep, voffB);
            PG8_WAIT_V(6); PG8_BAR; PG8_MMA(1, 1, At, B1); PG8_BAR;
            }
        }
        if constexpr (ALIGN_EPI) { if (wr == 0) PG8_BAR; }
        if constexpr (!Epi::AFTER_DRAIN) { int t2_ = tid; asm volatile("" : "+v"(t2_)); const int l2_ = t2_ & 63;
            E(acc, cur, wr, wc, l2_ & 15, l2_ >> 4); S.done(cur); }
        if (!has_next) break;
#pragma unroll
        for (int a = 0; a < 2; ++a)
#pragma unroll
            for (int b = 0; b < 2; ++b)
#pragma unroll
                for (int m = 0; m < 4; ++m)
#pragma unroll
                    for (int n = 0; n < 2; ++n) acc[a][b][m][n] = (f32x4){0.f, 0.f, 0.f, 0.f};
        cur = nxt; cA = nA; cB = nB; ++ui; if constexpr (Sched::VARK) ntc = cur.nt;
        if constexpr (ALIGN_EPI) { if (wr == 1) PG8_BAR; }
    }
    PG8_WAIT_V(0);
    if constexpr (!ALIGN_EPI) { if (wr == 0) PG8_BAR; }
    PG8_BAR;
    if constexpr (Epi::AFTER_DRAIN) { E.fused(acc, cur, wr, wc, fr, fq, lds, wid, lane); S.done(cur); }
#undef PG8_SA
#undef PG8_SB
#undef PG8_STAGE
#undef PG8_LDA
#undef PG8_LDB
#undef PG8_MMA
#undef PG8_CAT8
#undef PG8_WAIT_V
#undef PG8_WAIT_L
#undef PG8_BAR
#undef PG8_SCHED
}
}
#define GAS __attribute__((address_space(1)))
#define LAS __attribute__((address_space(3)))
typedef unsigned short bf16;
typedef unsigned v4u __attribute__((ext_vector_type(4)));
typedef float f32x4 __attribute__((ext_vector_type(4)));
typedef short bf16x8 __attribute__((ext_vector_type(8)));
typedef GAS unsigned gu32;
typedef GAS unsigned long long gu64;
#define RLX_AGENT __ATOMIC_RELAXED, __HIP_MEMORY_SCOPE_AGENT
#define LDS_WAIT() asm volatile("s_waitcnt lgkmcnt(0)" ::: "memory")
#define VM_WAIT() asm volatile("s_waitcnt vmcnt(0)" ::: "memory")
__device__ __forceinline__ unsigned long long rt() { return __builtin_amdgcn_s_memrealtime(); }
__device__ __forceinline__ unsigned f2bf(float f) { unsigned u = __builtin_bit_cast(unsigned, f); return (u + 0x7fffu + ((u >> 16) & 1u)) >> 16; }
__device__ __forceinline__ unsigned pk2(float lo, float hi) { return f2bf(lo) | (f2bf(hi) << 16); }

#define XB_TMO      128
#define XB_XCNT(j)  (256  + 64 * (j))
#define XB_XSUB(j)  (1280 + 64 * (j))
#define XB_XGEN(j)  (2304 + 64 * (j))
#define XB_TOP      3328
#define XB_TOPGEN   3392
#define XCD_BAR_WORDS 3456
#define XB_SPIN_CAP (1u << 18)

__device__ __forceinline__ unsigned xb_ld(unsigned* p)              { return __hip_atomic_load(p, __ATOMIC_RELAXED, __HIP_MEMORY_SCOPE_AGENT); }
__device__ __forceinline__ unsigned xb_add(unsigned* p, unsigned v) { return __hip_atomic_fetch_add(p, v, __ATOMIC_RELAXED, __HIP_MEMORY_SCOPE_AGENT); }
__device__ __forceinline__ unsigned xb_xcc_id() { return (unsigned)__builtin_amdgcn_s_getreg((3 << 11) | 20) & 0xFu; }
#define XB_SPIN(cond, bar) do { unsigned _sp = 0; while (cond) { __builtin_amdgcn_s_sleep(1); \
    if ((++_sp & 255u) == 0u) { if (xb_ld(&(bar)[XB_TMO])) break; if (_sp > XB_SPIN_CAP) { atomicAdd(&(bar)[XB_TMO], 1u); break; } } } } while (0)

struct XcdBarrier {
    unsigned* bar; unsigned x;
    volatile LAS unsigned* st;
};

__device__ __forceinline__ XcdBarrier xcd_barrier_post(unsigned* bar, volatile LAS unsigned* st, const int xb_tid) {
    XcdBarrier b; b.bar = bar; b.x = xb_xcc_id(); b.st = st;
    if (xb_tid == 0) (void)xb_add(&bar[XB_XCNT(b.x)], 1u);
    return b;
}
__device__ __forceinline__ void xcd_barrier_complete(unsigned* bar, unsigned x, unsigned& nloc, unsigned& nx) {
    const unsigned G = gridDim.x * gridDim.y * gridDim.z;
    unsigned sum, cnt, mine, sp = 0u;
    for (;;) {
        sum = 0u; cnt = 0u; mine = 0u;
#pragma unroll
        for (unsigned j = 0; j < 16; ++j) { const unsigned c = xb_ld(&bar[XB_XCNT(j)]); sum += c; cnt += (c > 0u) ? 1u : 0u; mine = (j == x) ? c : mine; }
        if (sum == G) break;
        __builtin_amdgcn_s_sleep(1);
        if ((++sp & 255u) == 0u) { if (xb_ld(&bar[XB_TMO])) break; if (sp > XB_SPIN_CAP) { atomicAdd(&bar[XB_TMO], 1u); break; } }
    }
    nloc = mine > 0u ? mine : 1u; nx = cnt > 0u ? cnt : 1u;
}

__device__ __forceinline__ void xcd_barrier(const XcdBarrier& b, const int xb_tid) {
    asm volatile("s_waitcnt vmcnt(0)" ::: "memory");
    __syncthreads();
    if (xb_tid == 0) {
        unsigned* bar = b.bar;
        __builtin_amdgcn_s_waitcnt(0);
        unsigned nloc = b.st[0], nx = b.st[1];
        if (nloc == 0u) { xcd_barrier_complete(bar, b.x, nloc, nx); b.st[0] = nloc; b.st[1] = nx; }
        const unsigned old = xb_add(&bar[XB_XSUB(b.x)], 1u);
        const unsigned gen = old / nloc;
        if (old + 1u == (gen + 1u) * nloc) {
            __builtin_amdgcn_fence(__ATOMIC_RELEASE, "agent");
            asm volatile("s_waitcnt vmcnt(0)" ::: "memory");
            const unsigned og = xb_add(&bar[XB_TOP], 1u);
            const unsigned tg = og / nx;
            if (og + 1u == (tg + 1u) * nx) xb_add(&bar[XB_TOPGEN], 1u);
            else XB_SPIN(xb_ld(&bar[XB_TOPGEN]) == tg, bar);
            __builtin_amdgcn_fence(__ATOMIC_ACQUIRE, "agent");
            xb_add(&bar[XB_XGEN(b.x)], 1u);
            asm volatile("s_waitcnt vmcnt(0)" ::: "memory");
        } else {
            XB_SPIN(xb_ld(&bar[XB_XGEN(b.x)]) == gen, bar);
            __builtin_amdgcn_fence(__ATOMIC_ACQUIRE, "agent");
            asm volatile("s_waitcnt vmcnt(0)" ::: "memory");
        }
    }
    __syncthreads();
}


constexpr int NWAVES = 8, NTHR = 512;
constexpr int BATCH = 4, SEQ = 2048, DM = 2048, MTOK = BATCH * SEQ;
constexpr int EVEN_IN = 5120, NSA_IN = 5168, NSA_INP = 5376, DFF = 7168, NEXP = 8, MOE_ROWS = 18432;
constexpr int NCMP = 127;
constexpr float EPS = 1e-6f, QSCALE = 0.08838834764831845f;
constexpr int E_Q = 0, E_K = 1024, E_V = 2048, E_XR = 3072, E_GR = 4096;
constexpr int N_Q = 0, N_KC = 2048, N_VC = 2560, N_KS = 3072, N_VS = 3584, N_KW = 4096, N_VW = 4608, N_G = 5120;
#ifndef MK_N_LAUNCHES
#define MK_N_LAUNCHES 1
#endif
constexpr int NPH = 19;
constexpr int N_LAUNCHES = MK_N_LAUNCHES;

constexpr size_t MiB = 1u << 20;
constexpr size_t WS_CTL = 0, CTL_ZERO_BYTES = 1 * MiB;
constexpr size_t WS_MOD = 1 * MiB;
constexpr size_t WS_ROUTE = 2 * MiB;
constexpr size_t WS_ROWP = 2 * MiB + 512 * 1024;
constexpr size_t WS_KCMP = 3 * MiB, WS_VCMP = 4 * MiB;
constexpr size_t WS_KCMPB = 6 * MiB, WS_VCMPB = 6 * MiB + 512 * 1024;
constexpr size_t WS_WC1K = 149 * MiB, WS_WC1V = 7 * MiB, WS_WC2K = 2 * MiB + 768 * 1024, WS_WC2V = WS_WC2K + 32768, WS_CMPPB = WS_WC2V + 32768;
constexpr size_t WS_ROWSA = 2 * MiB + 896 * 1024;
constexpr size_t WS_SUMP = 5 * MiB, WS_SUMH = 5 * MiB + 512 * 1024;
constexpr size_t WS_WIN0 = 8 * MiB, WS_WOUT0 = 28 * MiB, WS_WGU0 = 36 * MiB, WS_WDN0 = 92 * MiB, WS_WIN1 = 120 * MiB, WS_WOUT1 = 141 * MiB;
constexpr size_t WS_WMGU = 150 * MiB, WS_WMDN = 598 * MiB;
constexpr size_t WS_XA = 822 * MiB, WS_XB = 886 * MiB, WS_H = 950 * MiB, WS_PROJ = 982 * MiB, WS_MIX = 1066 * MiB;
constexpr size_t WS_ACT = 1098 * MiB, WS_HPERM = 1350 * MiB, WS_Y = 1422 * MiB, WS_PART = 1566 * MiB  , WS_END = 1632 * MiB;
constexpr size_t WS_HL = WS_ACT, WS_PC = WS_ACT + 32 * MiB;
constexpr int CW_TMO = 0, CW_CODE = 1, CW_BAR = 4096, CW_CNT = 8192  , CW_TILE = 12288  , CW_WMAX = 12352  ;

constexpr int RING_OFF = 0, RING_BYTES = 131072;
constexpr int LDSCTL_OFF = 147456 - 448, MISC_OFF = LDSCTL_OFF + 320;
constexpr int LDS_BYTES = 147456;

struct Frame {
    LAS unsigned char* lds;
    volatile LAS unsigned* MISC;
    gu32* ctl;
    int tid, lane, wave;
    int vcu, G;
    const float *x, *c, *ada_mix_w, *ada_mix_b, *norm_mix_g, *ada_ffn_w, *ada_ffn_b, *norm_ffn_g;
    const float *even_in_w, *rg_conv_w, *rg_conv_b, *rg_wa, *rg_ba, *rg_wx, *rg_bx, *rg_lambda, *even_out_w;
    const float *dense_w_gate, *dense_w_up, *dense_w_down, *nsa_in_w, *cmp_pos_k, *cmp_pos_v, *cmp_k_w1, *cmp_k_w2, *cmp_v_w1, *cmp_v_w2;
    const float *nsa_out_w, *router_w, *moe_w_gate, *moe_w_up, *moe_w_down, *final_norm_g;
    float* out;
    bf16 *Win0, *Wout0, *Wgu0, *Wdn0, *Win1, *Wout1, *Wmgu, *Wmdn;
    float *mod, *xa, *xb, *kcmp, *vcmp, *sumP, *sumH, *hl, *pc, *y, *rowp;
    int* route;
    bf16 *h, *proj, *mix, *act, *hperm, *kcmpb, *vcmpb, *Wc1k, *Wc1v, *Wc2k, *Wc2v;
    float* cmp_pb; float* rowsa; float* part;
};

__device__ __forceinline__ float wave_sum(float v) {
#pragma unroll
    for (int o = 1; o < 64; o <<= 1) v += __shfl_xor(v, o);
    return v;
}
__device__ __forceinline__ float grp8_sum(float v) { v += __shfl_xor(v, 1); v += __shfl_xor(v, 2); v += __shfl_xor(v, 4); return v; }
__device__ __forceinline__ float bflo(unsigned u) { return __builtin_bit_cast(float, u << 16); }
__device__ __forceinline__ float bfhi(unsigned u) { return __builtin_bit_cast(float, u & 0xffff0000u); }
__device__ __forceinline__ float bf1(bf16 u) { return __builtin_bit_cast(float, ((unsigned)u) << 16); }
__device__ __forceinline__ void ld16bf(const bf16* p, float (&o)[16]) {
    const v4u a = *(const v4u*)p, b = *(const v4u*)(p + 8);
    o[0] = bflo(a.x); o[1] = bfhi(a.x); o[2] = bflo(a.y); o[3] = bfhi(a.y); o[4] = bflo(a.z); o[5] = bfhi(a.z); o[6] = bflo(a.w); o[7] = bfhi(a.w);
    o[8] = bflo(b.x); o[9] = bfhi(b.x); o[10] = bflo(b.y); o[11] = bfhi(b.y); o[12] = bflo(b.z); o[13] = bfhi(b.z); o[14] = bflo(b.w); o[15] = bfhi(b.w);
}
__device__ __forceinline__ void st16bf(bf16* p, const float (&o)[16]) {
    v4u a, b; a.x = pk2(o[0], o[1]); a.y = pk2(o[2], o[3]); a.z = pk2(o[4], o[5]); a.w = pk2(o[6], o[7]);
    b.x = pk2(o[8], o[9]); b.y = pk2(o[10], o[11]); b.z = pk2(o[12], o[13]); b.w = pk2(o[14], o[15]);
    *(v4u*)p = a; *(v4u*)(p + 8) = b;
}
__device__ __forceinline__ float sigmoidf_(float v) { return 1.f / (1.f + __expf(-v)); }
__device__ __forceinline__ float logsigf_(float z) { return fminf(z, 0.f) - __logf(1.f + __expf(-fabsf(z))); }
__device__ __forceinline__ float gelu_tanh(float v) { const float u = 0.7978845608028654f * (v + 0.044715f * v * v * v); const float t = 1.f - 2.f / (1.f + __expf(2.f * u)); return 0.5f * v * (1.f + t); }

__device__ __forceinline__ void p0_adaln(Frame& F) {
    LAS float* sc = (LAS float*)(F.lds);
    LAS float* red = (LAS float*)(F.lds + 32768);
    __syncthreads();
    for (int i = F.tid; i < BATCH * DM; i += NTHR) { const float v = F.c[i]; sc[i] = v / (1.f + __expf(-v)); }
    __syncthreads();
    for (int u = F.vcu; u < 384; u += F.G) {
        const int j = u / 96, cb = u % 96;
        const float* W = ((j & 1) ? F.ada_ffn_w : F.ada_mix_w) + (size_t)(j >> 1) * DM * 6144;
        const float* Bv = ((j & 1) ? F.ada_ffn_b : F.ada_mix_b) + (size_t)(j >> 1) * 6144;
        const int r = F.lane >> 4, cx = (F.lane & 15) * 4;
        float acc[4][4];
#pragma unroll
        for (int b = 0; b < 4; ++b)
#pragma unroll
            for (int q = 0; q < 4; ++q) acc[b][q] = 0.f;
        const int kbase = F.wave * 256;
#pragma unroll 8
        for (int i = 0; i < 64; ++i) {
            const int k = kbase + 4 * i + r;
            const f32x4 w = *(const f32x4*)(W + (size_t)k * 6144 + cb * 64 + cx);
#pragma unroll
            for (int b = 0; b < 4; ++b) { const float s = sc[b * DM + k]; acc[b][0] += s * w.x; acc[b][1] += s * w.y; acc[b][2] += s * w.z; acc[b][3] += s * w.w; }
        }
#pragma unroll
        for (int b = 0; b < 4; ++b)
#pragma unroll
            for (int q = 0; q < 4; ++q) { float v = acc[b][q]; v += __shfl_xor(v, 16); v += __shfl_xor(v, 32); acc[b][q] = v; }
        if (F.lane < 16) {
#pragma unroll
            for (int b = 0; b < 4; ++b)
#pragma unroll
                for (int q = 0; q < 4; ++q) red[(F.wave * 4 + b) * 64 + cx + q] = acc[b][q];
        }
        __syncthreads();
        if (F.tid < 256) { const int b = F.tid >> 6, col = F.tid & 63; float s = 0.f;
#pragma unroll
            for (int w = 0; w < 8; ++w) s += red[(w * 4 + b) * 64 + col];
            F.mod[(size_t)(j * 4 + b) * 6144 + cb * 64 + col] = s + Bv[cb * 64 + col]; }
        __syncthreads();
    }
}

struct CvtDesc { const float* src; unsigned char* dst; int N, K, n0, mode, f8; float qs; };
#ifndef FP8_DUP
#define FP8_DUP 0
#endif
#ifndef FP8_P13
#define FP8_P13 0
#endif
#ifndef I8_P2
#define I8_P2 0
#endif
#ifndef I8_P10
#define I8_P10 1
#endif
#ifndef I8_DUP
#define I8_DUP 1
#endif
#ifndef FP8_DDN
#define FP8_DDN 1
#endif
#ifndef FP8_MOE
#define FP8_MOE 1
#endif
constexpr float W8_PRESCALE = 64.f, W8_INV = 1.f / 64.f;
constexpr int CVT_NMAT = 10;
__device__ __forceinline__ bool cvt_decode(const Frame& F, int it, CvtDesc& d) {
    constexpr int C0 = 2560, C1 = C0 + 1024, C2 = C1 + 3584, C3 = C2 + 3584, C4 = C3 + 3584, C5 = C4 + 2592, C6 = C5 + 1024, C7 = C6 + 128, C8 = C7 + 128, C9 = C8 + 4, C10 = C9 + 4, C11 = C10 + 28672, C12 = C11 + 28672, C13 = C12 + 28672;
    if (it >= C13) return false;
    const float* src; bf16* dst; int K, N, mode = 0, r, f8 = 0; size_t dstb = 0;
    if (it < C0) { src = F.even_in_w; dst = F.Win0; K = DM; N = EVEN_IN; r = it; f8 = I8_P2 ? 2 : 0; }
    else if (it < C1) { src = F.even_out_w; dst = F.Wout0; K = DM; N = DM; r = it - C0; }
    else if (it < C2) { src = F.dense_w_gate; dst = F.Wgu0; f8 = I8_DUP ? 2 : FP8_DUP; K = DM; N = DFF; mode = 1; r = it - C1; }
    else if (it < C3) { src = F.dense_w_up; dst = F.Wgu0; f8 = I8_DUP ? 2 : FP8_DUP; K = DM; N = DFF; mode = 2; r = it - C2; }
    else if (it < C4) { src = F.dense_w_down; dst = F.Wdn0; f8 = FP8_DDN; K = DFF; N = DM; r = it - C3; }
    else if (it < C5) { src = F.nsa_in_w; dst = F.Win1; K = DM; N = NSA_IN; r = it - C4; f8 = I8_P10 ? 2 : 0; }
    else if (it < C6) { src = F.nsa_out_w; dst = F.Wout1; K = DM; N = DM; r = it - C5; f8 = FP8_P13; }
    else if (it < C7) { src = F.cmp_k_w1; dst = F.Wc1k; K = 2048; N = 128; r = it - C6; dstb = (size_t)128 * 2048; }
    else if (it < C8) { src = F.cmp_v_w1; dst = F.Wc1v; K = 2048; N = 128; r = it - C7; dstb = (size_t)128 * 2048; }
    else if (it < C9) { src = F.cmp_k_w2; dst = F.Wc2k; K = 128; N = 128; r = it - C8; }
    else if (it < C10) { src = F.cmp_v_w2; dst = F.Wc2v; K = 128; N = 128; r = it - C9; }
    else if (it < C11) { src = F.moe_w_gate; dst = F.Wmgu; f8 = FP8_MOE; K = DM; N = DFF; mode = 1; r = it - C10; dstb = (size_t)2 * DFF * DM; }
    else if (it < C12) { src = F.moe_w_up; dst = F.Wmgu; f8 = FP8_MOE; K = DM; N = DFF; mode = 2; r = it - C11; dstb = (size_t)2 * DFF * DM; }
    else { src = F.moe_w_down; dst = F.Wmdn; f8 = FP8_MOE; K = DFF; N = DM; r = it - C12; dstb = (size_t)DFF * DM; }
    const int nblk = (N + 63) >> 6, ipb = (K >> 6) * nblk;
    const int nkb = K >> 6; const int e = r / ipb, r2 = r - e * ipb, nb = r2 / nkb, kb = r2 - nb * nkb;
    d.N = N; d.K = K; d.n0 = nb * 64; d.mode = mode; d.f8 = f8; d.qs = 0.f;
    d.src = src + (size_t)e * K * N + (size_t)(kb * 64) * N + nb * 64;
    d.dst = (unsigned char*)dst + ((size_t)e * dstb + kb * 64) * (f8 ? 1 : 2);
    return true;
}
__device__ __forceinline__ void cvt_load(const CvtDesc& d, int lane, f32x4 (&v)[16]) {
    const int r = lane >> 4, cx = (lane & 15) * 4; const bool ok = (d.n0 + cx) < d.N;
#pragma unroll
    for (int i = 0; i < 16; ++i) v[i] = ok ? __builtin_nontemporal_load((const f32x4*)(d.src + (size_t)(4 * i + r) * d.N + cx)) : (f32x4){0.f, 0.f, 0.f, 0.f};
#ifdef CVT_PROBE_LD
    asm volatile("" ::: "memory");
#pragma unroll
    for (int i = 0; i < 16; ++i) { const f32x4 w = ok ? __builtin_nontemporal_load((const f32x4*)(d.src + (size_t)(4 * i + r) * d.N + cx)) : (f32x4){0.f, 0.f, 0.f, 0.f}; v[i] = (v[i] + w) * 0.5f; }
#endif
}
__device__ __forceinline__ void cvt_store(const CvtDesc& d, int lane, const f32x4 (&v)[16], LAS float* scr) {
    const int r = lane >> 4, cx = (lane & 15) * 4;
#pragma unroll
    for (int i = 0; i < 16; ++i) { LAS float* p = scr + (4 * i + r) * 65 + cx; p[0] = v[i].x; p[1] = v[i].y; p[2] = v[i].z; p[3] = v[i].w; }
    LDS_WAIT(); asm volatile("" ::: "memory");
#ifdef CVT_PROBE_LDS
    for (int rep = 0; rep < 2; ++rep) {
#pragma unroll
    for (int i = 0; i < 16; ++i) { LAS float* p = scr + (4 * i + r) * 65 + cx; p[0] = v[i].x; p[1] = v[i].y; p[2] = v[i].z; p[3] = v[i].w; }
    LDS_WAIT(); asm volatile("" ::: "memory"); }
#endif
    if (d.f8 == 2) {
        const int c = lane & 3; const float qs = d.qs;
#define Q8(v) (__builtin_amdgcn_fmed3f(__builtin_rintf((v) * qs), -127.f, 127.f))
#define PK8(a, b, c2, d2) (((unsigned)(int)Q8(a) & 255u) | (((unsigned)(int)Q8(b) & 255u) << 8) | (((unsigned)(int)Q8(c2) & 255u) << 16) | (((unsigned)(int)Q8(d2)) << 24))
#pragma unroll
        for (int j = 0; j < 4; ++j) { const int nl = (lane >> 2) + 16 * j, n = d.n0 + nl; const LAS float* s = scr + (16 * c) * 65 + nl;
            v4u o; o.x = PK8(s[0 * 65], s[1 * 65], s[2 * 65], s[3 * 65]); o.y = PK8(s[4 * 65], s[5 * 65], s[6 * 65], s[7 * 65]);
            o.z = PK8(s[8 * 65], s[9 * 65], s[10 * 65], s[11 * 65]); o.w = PK8(s[12 * 65], s[13 * 65], s[14 * 65], s[15 * 65]);
            const int row = d.mode == 0 ? n : ((n >> 7) * 256 + (n & 127) + (d.mode == 2 ? 128 : 0));
            if (n < d.N) *(v4u*)(d.dst + (size_t)row * d.K + 16 * c) = o; }
#undef PK8
#undef Q8
    } else if (d.f8) {
        const int c = lane & 3;
#pragma unroll
        for (int j = 0; j < 4; ++j) { const int nl = (lane >> 2) + 16 * j, n = d.n0 + nl; const LAS float* s = scr + (16 * c) * 65 + nl;
            v4u o; o.x = pg8::pk4_fp8(W8_PRESCALE * s[0 * 65], W8_PRESCALE * s[1 * 65], W8_PRESCALE * s[2 * 65], W8_PRESCALE * s[3 * 65]);
            o.y = pg8::pk4_fp8(W8_PRESCALE * s[4 * 65], W8_PRESCALE * s[5 * 65], W8_PRESCALE * s[6 * 65], W8_PRESCALE * s[7 * 65]);
            o.z = pg8::pk4_fp8(W8_PRESCALE * s[8 * 65], W8_PRESCALE * s[9 * 65], W8_PRESCALE * s[10 * 65], W8_PRESCALE * s[11 * 65]);
            o.w = pg8::pk4_fp8(W8_PRESCALE * s[12 * 65], W8_PRESCALE * s[13 * 65], W8_PRESCALE * s[14 * 65], W8_PRESCALE * s[15 * 65]);
            const int row = d.mode == 0 ? n : ((n >> 7) * 256 + (n & 127) + (d.mode == 2 ? 128 : 0));
            if (n < d.N) *(v4u*)(d.dst + (size_t)row * d.K + 16 * c) = o; }
    } else {
    const int c = lane & 7;
#pragma unroll
    for (int j = 0; j < 8; ++j) { const int nl = (lane >> 3) + 8 * j, n = d.n0 + nl; const LAS float* s = scr + (8 * c) * 65 + nl;
        v4u o; o.x = pg8::cvt_pk_bf16(s[0 * 65], s[1 * 65]); o.y = pg8::cvt_pk_bf16(s[2 * 65], s[3 * 65]); o.z = pg8::cvt_pk_bf16(s[4 * 65], s[5 * 65]); o.w = pg8::cvt_pk_bf16(s[6 * 65], s[7 * 65]);
        const int row = d.mode == 0 ? n : ((n >> 7) * 256 + (n & 127) + (d.mode == 2 ? 128 : 0));
        if (n < d.N) *(v4u*)(d.dst + ((size_t)row * d.K + 8 * c) * 2) = o; }
    }
    LDS_WAIT(); asm volatile("" ::: "memory");
}
constexpr int CVT_TOTAL = 103968 + 264;
#ifndef RES_BF16
#define RES_BF16 1
#endif
#ifndef MOE_SPLIT
#define MOE_SPLIT 0
#endif
#ifndef CVT_LATE
#define CVT_LATE 1
#endif
constexpr int LATE_P2 = CVT_LATE ? 10 * 128 * 8 : 0, LATE_P10 = CVT_LATE ? 4 * 96 * 8 : 0, LATE_P11 = CVT_LATE ? 8 * 96 * 8 : 0, LATE_ALL = LATE_P2 + LATE_P10 + LATE_P11;
struct CvtSeg { int n0, b0, n1, b1, b2, nv; };
__device__ __forceinline__ int cvt_real(const CvtSeg& s, int v) { return v < s.n0 ? s.b0 + v : (v < s.n0 + s.n1 ? s.b1 + (v - s.n0) : s.b2 + (v - s.n0 - s.n1)); }
__device__ __forceinline__ void p0_convert(Frame& F, const CvtSeg sg, const float qs, const int gw_in = -1, const int ngw_in = 0) {
    LAS float* scr = (LAS float*)(F.lds + F.wave * 16640);
    const int gw = gw_in >= 0 ? gw_in : (int)blockIdx.x * NWAVES + F.wave, NGW = gw_in >= 0 ? ngw_in : F.G * NWAVES;
    CvtDesc dA, dB; f32x4 vA[16], vB[16];
#define CVT_DEC(V, D) (((V) < sg.nv) && cvt_decode(F, cvt_real(sg, (V)), D) && ((D).qs = qs, true))
    int it = gw; bool okA = CVT_DEC(it, dA);
    if (okA) cvt_load(dA, F.lane, vA);
    while (okA) {
        const bool okB = CVT_DEC(it + NGW, dB);
        if (okB) cvt_load(dB, F.lane, vB);
        cvt_store(dA, F.lane, vA, scr);
        if (!okB) break;
        okA = CVT_DEC(it + 2 * NGW, dA);
        if (okA) cvt_load(dA, F.lane, vA);
        cvt_store(dB, F.lane, vB, scr);
        it += 2 * NGW;
    }
#undef CVT_DEC
}
__device__ __forceinline__ void p0_zero_pad(Frame& F) {
    const int gt = F.vcu * NTHR + F.tid; constexpr int ESZ = I8_P10 ? 1 : 2;
    v4u* z = (v4u*)((unsigned char*)F.Win1 + (size_t)NSA_IN * DM * ESZ); const int nz = (NSA_INP - NSA_IN) * DM * ESZ / 16;
    for (int i = gt; i < nz; i += F.G * NTHR) z[i] = (v4u){0u, 0u, 0u, 0u};
}
__device__ __forceinline__ void p0_absmax(Frame& F, const float* pa, const float* pb, const int n4, const int word) {
    const int gt = (int)blockIdx.x * NTHR + F.tid, NT = F.G * NTHR;
    const f32x4* a = (const f32x4*)pa; const f32x4* b = (const f32x4*)pb; float m = 0.f;
#pragma unroll 4
    for (int i = gt; i < n4; i += NT) { const f32x4 x = a[i], y = b[i];
        m = fmaxf(m, fmaxf(fmaxf(fabsf(x.x), fabsf(x.y)), fmaxf(fabsf(x.z), fabsf(x.w)))); m = fmaxf(m, fmaxf(fmaxf(fabsf(y.x), fabsf(y.y)), fmaxf(fabsf(y.z), fabsf(y.w)))); }
#pragma unroll
    for (int o = 1; o < 64; o <<= 1) m = fmaxf(m, __shfl_xor(m, o));
    if (F.lane == 0) __hip_atomic_fetch_max(F.ctl + word, __builtin_bit_cast(unsigned, m), __ATOMIC_RELAXED, __HIP_MEMORY_SCOPE_AGENT);
}

template <int OM, bool XB = false> __device__ __forceinline__ void normmod_row(const float* xrow, const float* g, const float* modb, bf16* orow, int lane, f32x4 (&y)[8], float* rowsa = nullptr) {
    const f32x4* xr = (const f32x4*)xrow + lane; const uint2* xb2 = (const uint2*)xrow + lane; float ss = 0.f;
#pragma unroll
    for (int j = 0; j < 8; ++j) { if constexpr (XB) { const uint2 q = xb2[64 * j]; y[j] = (f32x4){bflo(q.x), bfhi(q.x), bflo(q.y), bfhi(q.y)}; } else y[j] = xr[64 * j]; ss += (y[j].x * y[j].x + y[j].y * y[j].y) + (y[j].z * y[j].z + y[j].w * y[j].w); }
    const float rs = 1.f / sqrtf(wave_sum(ss) * (1.f / DM) + EPS);
    const f32x4* gp = (const f32x4*)g + lane; const f32x4* sh = (const f32x4*)modb + lane; const f32x4* scl = (const f32x4*)(modb + DM) + lane;
    unsigned long long* o8 = (unsigned long long*)orow + lane;
#pragma unroll
    for (int j = 0; j < 8; ++j) { const f32x4 gg = gp[64 * j], s = sh[64 * j], c = scl[64 * j];
        y[j] = (y[j] * rs) * gg * (c + 1.f) + s;
        if constexpr (OM == 1) ((unsigned*)orow + lane)[64 * j] = pg8::pk4_fp8(y[j].x, y[j].y, y[j].z, y[j].w);
        else if constexpr (OM == 0) o8[64 * j] = (unsigned long long)pk2(y[j].x, y[j].y) | ((unsigned long long)pk2(y[j].z, y[j].w) << 32); }
    if constexpr (OM == 2) {
        float am = 0.f;
#pragma unroll
        for (int j = 0; j < 8; ++j) am = fmaxf(am, fmaxf(fmaxf(fabsf(y[j].x), fabsf(y[j].y)), fmaxf(fabsf(y[j].z), fabsf(y[j].w))));
#pragma unroll
        for (int o = 1; o < 64; o <<= 1) am = fmaxf(am, __shfl_xor(am, o));
        const float q = (am > 0.f) ? 127.f / am : 0.f;
        if (lane == 0) *rowsa = (am > 0.f) ? am * (1.f / 127.f) : 1.f;
#pragma unroll
        for (int j = 0; j < 8; ++j) { const int a = (int)__builtin_rintf(y[j].x * q), b = (int)__builtin_rintf(y[j].y * q), c = (int)__builtin_rintf(y[j].z * q), d = (int)__builtin_rintf(y[j].w * q);
            ((unsigned*)orow + lane)[64 * j] = ((unsigned)a & 255u) | (((unsigned)b & 255u) << 8) | (((unsigned)c & 255u) << 16) | ((unsigned)d << 24); }
    }
}
template <int OM, bool XB = false> __device__ __forceinline__ void normmod_phase(Frame& F, const float* xin, const float* g, const float* modj) {
    const int gw = (int)blockIdx.x * NWAVES + F.wave, NGW = F.G * NWAVES;
    for (int m = gw; m < MTOK; m += NGW) { f32x4 y[8]; normmod_row<OM, XB>((const float*)((const unsigned char*)xin + (size_t)m * DM * (XB ? 2 : 4)), g, modj + (size_t)(m / SEQ) * 6144, (bf16*)((unsigned char*)F.h + (size_t)m * DM * (OM ? 1 : 2)), F.lane, y, F.rowsa + m); }
}

__device__ __forceinline__ void rglru_local_unit(Frame& F, int unit) {
    const int nb = unit & 15, ck = (unit >> 4) & 31, b = unit >> 9;
    LAS float* xin = (LAS float*)(F.lds);
    LAS float* xc = xin + 67 * 64;
    LAS float* wa = xc + 64 * 64;
    LAS float* wx = wa + 64 * 64;
    LAS float* segP = wx + 64 * 64;
    LAS float* segH = segP + 8 * 64;
    const int t0 = ck * 64, ch0 = nb * 64;
    for (int i = F.tid; i < 67 * 8; i += NTHR) { const int r = i >> 3, c8 = (i & 7) * 8, t = t0 - 3 + r;
        v4u v = (v4u){0u, 0u, 0u, 0u}; if (t >= 0) v = *(const v4u*)(F.proj + (size_t)(b * SEQ + t) * EVEN_IN + E_XR + ch0 + c8);
        LAS float* xp = xin + r * 64 + c8; xp[0] = bflo(v.x); xp[1] = bfhi(v.x); xp[2] = bflo(v.y); xp[3] = bfhi(v.y); xp[4] = bflo(v.z); xp[5] = bfhi(v.z); xp[6] = bflo(v.w); xp[7] = bfhi(v.w); }
    for (int i = F.tid; i < 1024; i += NTHR) { *(LAS f32x4*)(wa + 4 * i) = *(const f32x4*)(F.rg_wa + (size_t)nb * 4096 + 4 * i); *(LAS f32x4*)(wx + 4 * i) = *(const f32x4*)(F.rg_wx + (size_t)nb * 4096 + 4 * i); }
    { const int cc = F.tid & 63, chc = ch0 + cc;
      const float cw0 = F.rg_conv_w[0 * 1024 + chc], cw1 = F.rg_conv_w[1 * 1024 + chc], cw2 = F.rg_conv_w[2 * 1024 + chc], cw3 = F.rg_conv_w[3 * 1024 + chc], cbb = F.rg_conv_b[chc];
      __syncthreads();
      for (int i = F.tid; i < 64 * 64; i += NTHR) { const int tt = i >> 6;
          xc[i] = cw0 * xin[(tt + 0) * 64 + cc] + cw1 * xin[(tt + 1) * 64 + cc] + cw2 * xin[(tt + 2) * 64 + cc] + cw3 * xin[(tt + 3) * 64 + cc] + cbb; } }
    __syncthreads();
    const int d = F.tid & 63, tq = F.tid >> 6, ch = ch0 + d;
    float aa[8], ax[8];
#pragma unroll
    for (int i = 0; i < 8; ++i) { aa[i] = 0.f; ax[i] = 0.f; }
    for (int cc = 0; cc < 64; ++cc) { const float wac = wa[cc * 64 + d], wxc = wx[cc * 64 + d];
#pragma unroll
        for (int i = 0; i < 8; ++i) { const float xv = xc[(tq * 8 + i) * 64 + cc]; aa[i] += xv * wac; ax[i] += xv * wxc; } }
    const float ba = F.rg_ba[ch], bx = F.rg_bx[ch], lsl = logsigf_(F.rg_lambda[ch]);
    float hloc[8], pl[8]; float hprev = 0.f, pprev = 1.f;
#pragma unroll
    for (int i = 0; i < 8; ++i) {
        const float r = sigmoidf_(aa[i] + ba), ig = sigmoidf_(ax[i] + bx);
        const float la = 8.f * r * lsl, a = __expf(la);
        const float u = sqrtf(fmaxf(1.f - a * a, 0.f)) * (ig * xc[(tq * 8 + i) * 64 + d]);
        hprev = a * hprev + u; pprev = pprev * a; hloc[i] = hprev; pl[i] = pprev;
    }
    segP[tq * 64 + d] = pprev; segH[tq * 64 + d] = hprev;
    __syncthreads();
    float carry = 0.f, pp = 1.f;
    for (int s = 0; s < tq; ++s) { const float sp = segP[s * 64 + d]; carry = sp * carry + segH[s * 64 + d]; pp *= sp; }
#pragma unroll
    for (int i = 0; i < 8; ++i) { const size_t m = (size_t)(b * SEQ + t0 + tq * 8 + i);
        const float hv = hloc[i] + pl[i] * carry, pv = pl[i] * pp;
        ((bf16*)F.hl)[m * 1024 + ch] = (bf16)f2bf(hv); ((bf16*)F.pc)[m * 1024 + ch] = (bf16)f2bf(pv);
        if (tq == 7 && i == 7) { F.sumP[(size_t)(b * 32 + ck) * 1024 + ch] = pv; F.sumH[(size_t)(b * 32 + ck) * 1024 + ch] = hv; } }
    __syncthreads();
}

__device__ __forceinline__ void rglru_fix_unit(Frame& F, int unit) {
    const int cg = unit & 3, ck = (unit >> 2) & 31, b = unit >> 7;
    const int ch = cg * 256 + (F.tid & 255), th = F.tid >> 8;
    float carry = 0.f;
#pragma unroll 8
    for (int s = 0; s < ck; ++s) carry = F.sumP[(size_t)(b * 32 + s) * 1024 + ch] * carry + F.sumH[(size_t)(b * 32 + s) * 1024 + ch];
#pragma unroll 8
    for (int i = 0; i < 32; ++i) { const size_t m = (size_t)(b * SEQ + ck * 64 + th * 32 + i);
        const float hv = bf1(((const bf16*)F.hl)[m * 1024 + ch]) + bf1(((const bf16*)F.pc)[m * 1024 + ch]) * carry;
        const float gr = bf1(F.proj[m * EVEN_IN + E_GR + ch]);
        F.mix[m * DM + 1024 + ch] = (bf16)f2bf(hv * gelu_tanh(gr)); }
}

__device__ __forceinline__ unsigned nsa_select(const LAS float* imp, int t) {
    const int cur = t >> 6;
    unsigned mask = 1u | (1u << cur); if (cur >= 1) mask |= 1u << (cur - 1);
    int need = 8 - __builtin_popcount(mask);
    const unsigned valid = (cur >= 31) ? 0xffffffffu : ((2u << cur) - 1u);
    float v[32];
#pragma unroll
    for (int j = 0; j < 32; j += 4) { const f32x4 q = *(const LAS f32x4*)(imp + j); v[j] = q.x; v[j + 1] = q.y; v[j + 2] = q.z; v[j + 3] = q.w; }
    for (; need > 0; --need) {
        const unsigned cand = valid & ~mask; if (!cand) break;
        float best = -1.f; int bi = 0;
#pragma unroll
        for (int j = 0; j < 32; ++j) { const bool better = ((cand >> j) & 1u) && (v[j] > best); best = better ? v[j] : best; bi = better ? j : bi; }
        mask |= 1u << bi;
    }
    return mask;
}
__device__ __forceinline__ void router_block(Frame& F, int tb, const float* xin, const float* g, const float* modj) {
    LAS int* cntl = (LAS int*)(F.lds);
    if (F.tid < 8) cntl[F.tid] = 0;
    __syncthreads();
    for (int i = 0; i < 4; ++i) {
        const int m = tb * 32 + F.wave * 4 + i; f32x4 y[8];
        normmod_row<(FP8_MOE ? 1 : 0), RES_BF16 != 0>((const float*)((const unsigned char*)xin + (size_t)m * DM * (RES_BF16 ? 2 : 4)), g, modj + (size_t)(m / SEQ) * 6144, (bf16*)((unsigned char*)F.h + (size_t)m * DM * (FP8_MOE ? 1 : 2)), F.lane, y);
        float lg[8];
#pragma unroll
        for (int e = 0; e < 8; ++e) lg[e] = 0.f;
#pragma unroll
        for (int j = 0; j < 8; ++j) {
#pragma unroll
            for (int q = 0; q < 4; ++q) { const int dcol = 4 * F.lane + 256 * j + q; const f32x4 w0 = *(const f32x4*)(F.router_w + (size_t)dcol * 8), w1 = *(const f32x4*)(F.router_w + (size_t)dcol * 8 + 4);
                const float yv = y[j][q];
                lg[0] += yv * w0.x; lg[1] += yv * w0.y; lg[2] += yv * w0.z; lg[3] += yv * w0.w; lg[4] += yv * w1.x; lg[5] += yv * w1.y; lg[6] += yv * w1.z; lg[7] += yv * w1.w; } }
#pragma unroll
        for (int e = 0; e < 8; ++e) lg[e] = wave_sum(lg[e]);
        if (F.lane == 0) {
            int e0 = 0; float v0 = lg[0];
#pragma unroll
            for (int e = 1; e < 8; ++e) if (lg[e] > v0) { v0 = lg[e]; e0 = e; }
            int e1 = -1; float v1 = -3.0e38f;
#pragma unroll
            for (int e = 0; e < 8; ++e) if (e != e0 && lg[e] > v1) { v1 = lg[e]; e1 = e; }
            const float p1 = 1.f / (1.f + __expf(v0 - v1)), p0 = 1.f - p1;
            int* r = F.route + (size_t)m * 8; r[0] = e0; r[1] = e1; ((float*)r)[2] = p0; ((float*)r)[3] = p1;
            __hip_atomic_fetch_add(&cntl[e0], 1, __ATOMIC_RELAXED, __HIP_MEMORY_SCOPE_WORKGROUP); __hip_atomic_fetch_add(&cntl[e1], 1, __ATOMIC_RELAXED, __HIP_MEMORY_SCOPE_WORKGROUP);
        }
    }
    __syncthreads();
    if (F.tid < 8) __hip_atomic_store(F.ctl + CW_CNT + tb * 8 + F.tid, (unsigned)cntl[F.tid], RLX_AGENT);
    __syncthreads();
}

__device__ __forceinline__ void moe_scatter_block(Frame& F, int tb) {
    LAS int* tot = (LAS int*)(F.lds);
    LAS int* bas = tot + 8;
    LAS int* seg = bas + 8;
    LAS int* re = seg + 16;
    LAS int* dst = re + 64;
    if (F.tid < 16) tot[F.tid] = 0;
    __syncthreads();
    { const int tb2 = F.tid >> 1, e4 = (F.tid & 1) * 4;
#pragma unroll
      for (int q = 0; q < 4; ++q) { const int v = (int)__hip_atomic_load(F.ctl + CW_CNT + tb2 * 8 + e4 + q, RLX_AGENT); __hip_atomic_fetch_add(&tot[e4 + q], v, __ATOMIC_RELAXED, __HIP_MEMORY_SCOPE_WORKGROUP); if (tb2 < tb) __hip_atomic_fetch_add(&bas[e4 + q], v, __ATOMIC_RELAXED, __HIP_MEMORY_SCOPE_WORKGROUP); } }
    if (F.tid < 64) { const int i = F.tid >> 1, k = F.tid & 1; re[F.tid] = F.route[(size_t)(tb * 32 + i) * 8 + k]; }
    __syncthreads();
    if (F.tid == 0) { int s = 0, tcum = 0; for (int e = 0; e < 8; ++e) { seg[e] = s; const int nt = (tot[e] + 255) >> 8; s += nt * 256;
            if (tb == 0) { __hip_atomic_store(F.ctl + CW_TILE + e, (unsigned)tcum, RLX_AGENT); } tcum += nt; }
        seg[8] = s; if (tb == 0) __hip_atomic_store(F.ctl + CW_TILE + 8, (unsigned)tcum, RLX_AGENT); }
    __syncthreads();
    if (F.tid < 64) { const int i = F.tid >> 1, k = F.tid & 1, e = re[F.tid]; int rank = 0;
        for (int q = 0; q < 2 * i; ++q) rank += (re[q] == e) ? 1 : 0;
        const int d = seg[e] + bas[e] + rank; dst[F.tid] = d;
        const size_t m = (size_t)(tb * 32 + i); F.route[m * 8 + 4 + k] = d; F.rowp[d] = ((const float*)F.route)[m * 8 + 2 + k] * (FP8_MOE ? W8_INV : 1.f); }
    __syncthreads();
    constexpr int RB = DM * (FP8_MOE ? 1 : 2);
    for (int r = F.wave; r < 64; r += NWAVES) { const size_t m = (size_t)(tb * 32 + (r >> 1)); const v4u* s = (const v4u*)((const unsigned char*)F.h + m * RB) + F.lane; v4u* o = (v4u*)((unsigned char*)F.hperm + (size_t)dst[r] * RB) + F.lane;
#pragma unroll
        for (int j = 0; j < RB / 1024; ++j) o[64 * j] = s[64 * j]; }
    __syncthreads();
}

__device__ __forceinline__ f32x4 moe_y4(const Frame& F, int p, int e, int j, int lane, int nwg, int nfull, int S) {
    if (nfull < nwg) {
        const int tce = (int)__hip_atomic_load(F.ctl + CW_TILE + e, RLX_AGENT), tce1 = (int)__hip_atomic_load(F.ctl + CW_TILE + e + 1, RLX_AGENT);
        const int wgid = tce * 8 + j * (tce1 - tce) + ((p >> 8) - tce), L = pg8::moe_unremap(wgid, nwg);
        if (L >= nfull) { const float* pp = F.part + (size_t)((L - nfull) * S) * 65536 + (p & 255) * 256 + 4 * lane; f32x4 a = *(const f32x4*)pp;
            for (int s = 1; s < S; ++s) a += *(const f32x4*)(pp + (size_t)s * 65536);
            return a; }
    }
    const uint2 a = ((const uint2*)((const bf16*)F.y + (size_t)p * DM) + lane)[64 * j];
    return (f32x4){bflo(a.x), bfhi(a.x), bflo(a.y), bfhi(a.y)};
}
__device__ __forceinline__ void final_phase(Frame& F, const float* xin, const float* gate) {
    const int gw = (int)blockIdx.x * NWAVES + F.wave, NGW = F.G * NWAVES;
    const int nwg = (int)__hip_atomic_load(F.ctl + CW_TILE + 8, RLX_AGENT) * 8; int nfull = nwg, nleft = 0, S = 1;
    if (MOE_SPLIT) pg8::moe_split_plan(nwg, F.G, DFF / 128, nfull, nleft, S);
    for (int m = gw; m < MTOK; m += NGW) {
        const int e0 = F.route[(size_t)m * 8 + 0], e1 = F.route[(size_t)m * 8 + 1], p0 = F.route[(size_t)m * 8 + 4], p1 = F.route[(size_t)m * 8 + 5];
        const f32x4* xr = (const f32x4*)(xin + (size_t)m * DM) + F.lane; const uint2* xb2 = (const uint2*)((const bf16*)xin + (size_t)m * DM) + F.lane;
        const f32x4* gp = (const f32x4*)(gate + (size_t)(m / SEQ) * 6144) + F.lane; const f32x4* fg = (const f32x4*)F.final_norm_g + F.lane;
        f32x4 v[8]; float ss = 0.f;
#pragma unroll
        for (int j = 0; j < 8; ++j) { const f32x4 ys = moe_y4(F, p0, e0, j, F.lane, nwg, nfull, S) + moe_y4(F, p1, e1, j, F.lane, nwg, nfull, S);
            f32x4 xv; if (RES_BF16) { const uint2 q = xb2[64 * j]; xv = (f32x4){bflo(q.x), bfhi(q.x), bflo(q.y), bfhi(q.y)}; } else xv = xr[64 * j];
            v[j] = xv + gp[64 * j] * ys; ss += (v[j].x * v[j].x + v[j].y * v[j].y) + (v[j].z * v[j].z + v[j].w * v[j].w); }
        const float rs = 1.f / sqrtf(wave_sum(ss) * (1.f / DM) + EPS);
        f32x4* o = (f32x4*)(F.out + (size_t)m * DM) + F.lane;
#pragma unroll
        for (int j = 0; j < 8; ++j) o[64 * j] = (v[j] * rs) * fg[64 * j];
    }
}

typedef short s16x4 __attribute__((ext_vector_type(4)));
typedef float f32x16 __attribute__((ext_vector_type(16)));
#define KSWZ(row, colB) ((row) * 256 + ((colB) ^ (((row) & 7) << 4)))
#define SBAR() __builtin_amdgcn_sched_barrier(0)
__device__ __forceinline__ int crow(int r, int hi) { return (r & 3) + 8 * (r >> 2) + 4 * hi; }
__device__ __forceinline__ constexpr int crow0(int r) { return (r & 3) + 8 * (r >> 2); }
__device__ __forceinline__ unsigned cvtpk(float lo, float hi) { unsigned r; asm volatile("v_cvt_pk_bf16_f32 %0, %1, %2" : "=v"(r) : "v"(lo), "v"(hi)); return r; }
__device__ __forceinline__ float xhalf_max(float v) { auto rr = __builtin_amdgcn_permlane32_swap(__float_as_uint(v), __float_as_uint(v), false, false); return fmaxf(__uint_as_float(rr[0]), __uint_as_float(rr[1])); }
__device__ __forceinline__ float xhalf_sum(float v) { auto rr = __builtin_amdgcn_permlane32_swap(__float_as_uint(v), __float_as_uint(v), false, false); return __uint_as_float(rr[0]) + __uint_as_float(rr[1]); }
__device__ __forceinline__ float xhalf_other(float v, int hi) { auto rr = __builtin_amdgcn_permlane32_swap(__float_as_uint(v), __float_as_uint(v), false, false); return hi ? __uint_as_float(rr[0]) : __uint_as_float(rr[1]); }
template <class T> __device__ __forceinline__ T* launder(T* p) { asm volatile("" : "+v"(p)); return p; }
template <int OFF> __device__ __forceinline__ void kread4(bf16x8 (&b)[4], unsigned a0, unsigned a1) {
    asm volatile("ds_read_b128 %0, %4 offset:%6\n\tds_read_b128 %1, %4 offset:%7\n\tds_read_b128 %2, %5 offset:%6\n\tds_read_b128 %3, %5 offset:%7\n\ts_waitcnt lgkmcnt(0)"
                 : "=&v"(b[0]), "=&v"(b[1]), "=&v"(b[2]), "=&v"(b[3]) : "v"(a0), "v"(a1), "i"(OFF), "i"(OFF + 8192) : "memory");
}
__device__ __forceinline__ void qkt(f32x16& p0, f32x16& p1, const LAS char* Ks, const bf16x8 (&qr)[8], int r32, int hi) {
    p0 = f32x16{}; p1 = f32x16{};
    const int x = (r32 & 7) << 4; const unsigned rb = (unsigned)(uintptr_t)Ks + r32 * 256 + ((hi * 16) ^ (x & 16));
    const unsigned a0 = rb + ((0 * 32) ^ (x & 96)), a1 = rb + ((1 * 32) ^ (x & 96)), a2 = rb + ((2 * 32) ^ (x & 96)), a3 = rb + ((3 * 32) ^ (x & 96));
    bf16x8 b[4];
#define QK_STEP(RD, QA, QB) RD; p0 = __builtin_amdgcn_mfma_f32_32x32x16_bf16(b[0], qr[QA], p0, 0, 0, 0); p1 = __builtin_amdgcn_mfma_f32_32x32x16_bf16(b[1], qr[QA], p1, 0, 0, 0); \
    p0 = __builtin_amdgcn_mfma_f32_32x32x16_bf16(b[2], qr[QB], p0, 0, 0, 0); p1 = __builtin_amdgcn_mfma_f32_32x32x16_bf16(b[3], qr[QB], p1, 0, 0, 0);
    QK_STEP(kread4<0>(b, a0, a1), 0, 1) QK_STEP(kread4<0>(b, a2, a3), 2, 3) QK_STEP(kread4<128>(b, a0, a1), 4, 5) QK_STEP(kread4<128>(b, a2, a3), 6, 7)
#undef QK_STEP
}
__device__ __forceinline__ int v_st(int k, int c) { const int kk = (k & ~0xC) | ((k & 4) << 1) | ((k & 8) >> 1); return ((kk >> 3) * 4 + (c >> 5)) * 512 + ((kk & 7) * 32 + (c & 31)) * 2; }
__device__ __forceinline__ int v_rd_base(int lane) { return ((lane & 3) << 3) | (((lane >> 2) & 3) << 6) | (((lane >> 4) & 1) << 5) | (((lane >> 5) & 1) << 8); }
constexpr int v_rd_off(int d0, int ks, int half) { return d0 * 512 + ks * 4096 + half * 2048; }
template <int OFF> __device__ __forceinline__ s16x4 tr_read(int vb) { s16x4 r; asm volatile("ds_read_b64_tr_b16 %0, %1 offset:%2" : "=&v"(r) : "v"(vb), "i"(OFF) : "memory"); return r; }
template <int D0> __device__ __forceinline__ void pv_one(f32x16& od, int vb, bf16x8 pa0, bf16x8 pa1, bf16x8 pa2, bf16x8 pa3) {
    const s16x4 l0 = tr_read<v_rd_off(D0, 0, 0)>(vb), h0 = tr_read<v_rd_off(D0, 0, 1)>(vb), l1 = tr_read<v_rd_off(D0, 1, 0)>(vb), h1 = tr_read<v_rd_off(D0, 1, 1)>(vb);
    const s16x4 l2 = tr_read<v_rd_off(D0, 2, 0)>(vb), h2 = tr_read<v_rd_off(D0, 2, 1)>(vb), l3 = tr_read<v_rd_off(D0, 3, 0)>(vb), h3 = tr_read<v_rd_off(D0, 3, 1)>(vb);
    asm volatile("s_waitcnt lgkmcnt(0)" ::: "memory"); SBAR();
#define PKV(L, H) (bf16x8){L[0], L[1], L[2], L[3], H[0], H[1], H[2], H[3]}
    od = __builtin_amdgcn_mfma_f32_32x32x16_bf16(pa0, PKV(l0, h0), od, 0, 0, 0);
    od = __builtin_amdgcn_mfma_f32_32x32x16_bf16(pa1, PKV(l1, h1), od, 0, 0, 0);
    od = __builtin_amdgcn_mfma_f32_32x32x16_bf16(pa2, PKV(l2, h2), od, 0, 0, 0);
    od = __builtin_amdgcn_mfma_f32_32x32x16_bf16(pa3, PKV(l3, h3), od, 0, 0, 0);
#undef PKV
}
__device__ __forceinline__ void pv_d0(f32x16 (&o)[4], int vb, bf16x8 pa0, bf16x8 pa1, bf16x8 pa2, bf16x8 pa3) {
    pv_one<0>(o[0], vb, pa0, pa1, pa2, pa3); pv_one<1>(o[1], vb, pa0, pa1, pa2, pa3); pv_one<2>(o[2], vb, pa0, pa1, pa2, pa3); pv_one<3>(o[3], vb, pa0, pa1, pa2, pa3);
}
__device__ __forceinline__ void pack_p(const f32x16& p0, const f32x16& p1, bf16x8& pa0, bf16x8& pa1, bf16x8& pa2, bf16x8& pa3) {
#define PK4(P, BASE, OUT) do { unsigned a0 = cvtpk(P[BASE + 0], P[BASE + 1]), a1 = cvtpk(P[BASE + 2], P[BASE + 3]);   \
    unsigned b0 = cvtpk(P[BASE + 4], P[BASE + 5]), b1 = cvtpk(P[BASE + 6], P[BASE + 7]);                              \
    auto r0 = __builtin_amdgcn_permlane32_swap(a0, b0, false, false); auto r1 = __builtin_amdgcn_permlane32_swap(a1, b1, false, false); \
    v4u w = {r0[0], r1[0], r0[1], r1[1]}; OUT = __builtin_bit_cast(bf16x8, w); } while (0)
    PK4(p0, 0, pa0); PK4(p0, 8, pa1); PK4(p1, 0, pa2); PK4(p1, 8, pa3);
#undef PK4
}
struct KVStage { bf16x8 k0, k1, v0, v1; };
__device__ __forceinline__ void kv_load(KVStage& s, const bf16* kb, const bf16* vb, size_t pitch, int sr, int sc) {
    s.k0 = *(const bf16x8*)(kb + (size_t)sr * pitch + sc); s.k1 = *(const bf16x8*)(kb + (size_t)(32 + sr) * pitch + sc);
    s.v0 = *(const bf16x8*)(vb + (size_t)sr * pitch + sc); s.v1 = *(const bf16x8*)(vb + (size_t)(32 + sr) * pitch + sc);
}
__device__ __forceinline__ void kv_write(const KVStage& s, LAS char* Kb, LAS char* Vb, int sr, int sc) {
    *(LAS bf16x8*)(Vb + v_st(sr, sc)) = s.v0; *(LAS bf16x8*)(Vb + v_st(32 + sr, sc)) = s.v1;
    *(LAS bf16x8*)(Kb + KSWZ(sr, sc * 2)) = s.k0; *(LAS bf16x8*)(Kb + KSWZ(32 + sr, sc * 2)) = s.k1;
}
struct DmaOff { unsigned k0, k1, v0, v1; };
__device__ __forceinline__ void dma_offsets(DmaOff& d, int wid, int lane, unsigned pitch_bytes) {
    { const int r0 = 8 * wid + (lane >> 4), r1 = r0 + 4; d.k0 = r0 * pitch_bytes + (((lane & 15) ^ (r0 & 7)) << 4); d.k1 = r1 * pitch_bytes + (((lane & 15) ^ (r1 & 7)) << 4); }
    { const int T0 = 4 * wid + (lane >> 5), T1 = T0 + 2, klo = (lane & 31) >> 2, cl = 8 * (lane & 3);
      const int kk0 = 8 * (T0 >> 2) + klo, kk1 = 8 * (T1 >> 2) + klo;
      const int k0 = (kk0 & ~0xC) | ((kk0 & 4) << 1) | ((kk0 & 8) >> 1), k1 = (kk1 & ~0xC) | ((kk1 & 4) << 1) | ((kk1 & 8) >> 1);
      d.v0 = k0 * pitch_bytes + (32 * (T0 & 3) + cl) * 2; d.v1 = k1 * pitch_bytes + (32 * (T1 & 3) + cl) * 2; }
}
__device__ __forceinline__ void glds_s(unsigned voff, const void* sbase, unsigned lds_dst) {
    const unsigned lo = (unsigned)__builtin_amdgcn_readfirstlane((int)(unsigned)(uintptr_t)sbase), hi = (unsigned)__builtin_amdgcn_readfirstlane((int)(unsigned)((uintptr_t)sbase >> 32));
    const unsigned long long sb = ((unsigned long long)hi << 32) | lo; const unsigned ld = (unsigned)__builtin_amdgcn_readfirstlane((int)lds_dst); unsigned keep;
    asm volatile("s_mov_b32 %0, m0\n\ts_mov_b32 m0, %3\n\ts_nop 0\n\tglobal_load_lds_dwordx4 %1, %2\n\ts_mov_b32 m0, %0" : "=&s"(keep) : "v"(voff), "s"(sb), "s"(ld) : "memory");
}
__device__ __forceinline__ void dma_tile(const DmaOff& d, const bf16* kb, const bf16* vb, unsigned ldsK, unsigned ldsV, int wid) {
    glds_s(d.k0, kb, ldsK + 2048 * wid); glds_s(d.k1, kb, ldsK + 2048 * wid + 1024);
    glds_s(d.v0, vb, ldsV + 2048 * wid); glds_s(d.v1, vb, ldsV + 2048 * wid + 1024);
}
#define DMA_WAIT() asm volatile("s_waitcnt vmcnt(0)" ::: "memory")
constexpr int AT_V = 0, AT_K = 49152, AT_WSF = 98304, AT_IMPW = 100352, AT_IMPS = AT_IMPW + 32768, AT_SEL = AT_IMPS + 8192, AT_MISC = AT_SEL + 256;
constexpr float SM_C = QSCALE * 1.4426950408889634f, SM_THR = 8.f / QSCALE;

__device__ __forceinline__ void sm_tile(f32x16& p0, f32x16& p1, int lo, int hi2, float& m_reg, float& l_reg, f32x16 (&o)[4], LAS float* wsf, int vb, int r32, int hi) {
    const bool partial = (lo >= 0) || (hi2 >= 0 && hi2 < 63);
    if (__any(partial)) {
        const int lo4 = lo - 4 * hi, hi4 = hi2 - 4 * hi;
#pragma unroll
        for (int r = 0; r < 16; ++r) { p0[r] = (crow0(r) > lo4 && crow0(r) <= hi4) ? p0[r] : -__builtin_inff(); p1[r] = (32 + crow0(r) > lo4 && 32 + crow0(r) <= hi4) ? p1[r] : -__builtin_inff(); }
    }
    const bool off = (hi2 < 0);
    float pmax = p0[0];
#pragma unroll
    for (int r = 1; r < 16; ++r) pmax = fmaxf(pmax, p0[r]);
#pragma unroll
    for (int r = 0; r < 16; ++r) pmax = fmaxf(pmax, p1[r]);
    pmax = xhalf_max(pmax);
    pmax = off ? -__builtin_inff() : pmax;
    float mn, alpha;
    if (__all(pmax - m_reg <= SM_THR)) { mn = m_reg; alpha = 1.f; }
    else { mn = fmaxf(m_reg, pmax); alpha = __builtin_amdgcn_exp2f((m_reg - mn) * SM_C); m_reg = mn; }
    const float mnC = off ? -__builtin_inff() : -mn * SM_C;
#pragma unroll
    for (int r = 0; r < 16; ++r) { p0[r] = __builtin_amdgcn_exp2f(fmaf(p0[r], SM_C, mnC)); p1[r] = __builtin_amdgcn_exp2f(fmaf(p1[r], SM_C, mnC)); }
    float ps = 0.f;
#pragma unroll
    for (int r = 0; r < 16; ++r) ps += p0[r] + p1[r];
    ps = xhalf_sum(ps);
    l_reg = l_reg * alpha + ps;
    if (__any(alpha < 1.f)) { if (hi == 0) wsf[r32] = alpha; asm volatile("s_waitcnt lgkmcnt(0)" ::: "memory");
#pragma unroll
        for (int r = 0; r < 16; ++r) { const float a = (wsf + 4 * hi)[crow0(r)];
#pragma unroll
            for (int d = 0; d < 4; ++d) o[d][r] *= a; } }
    bf16x8 pa0, pa1, pa2, pa3; pack_p(p0, p1, pa0, pa1, pa2, pa3);
    pv_d0(o, vb, pa0, pa1, pa2, pa3);
}

__device__ __forceinline__ void nsa_mfma_unit(Frame& F, int unit) {
    const int qt = unit & 31, g = (unit >> 5) & 3, b = unit >> 7;
    const int tid = F.tid, wid = F.wave, lane = F.lane, r32 = lane & 31, hi = lane >> 5;
    const int hg = wid & 3, qh = wid >> 2, head = g * 4 + hg, qrel = qh * 32 + r32, tq = qt * 64 + qrel;
    LAS char* L = (LAS char*)F.lds;
    LAS float* wsf = (LAS float*)(L + AT_WSF) + wid * 64;
    LAS float* impw = (LAS float*)(L + AT_IMPW);
    LAS float* imps = (LAS float*)(L + AT_IMPS);
    LAS unsigned* selm = (LAS unsigned*)(L + AT_SEL);
    LAS unsigned* misc = (LAS unsigned*)(L + AT_MISC);
    const int vb0 = (int)(unsigned)(uintptr_t)(L + AT_V) + v_rd_base(lane);
    const int sr = tid >> 4, sc = (tid & 15) * 8;
    const bf16* pbase = F.proj + (size_t)b * SEQ * NSA_INP;
    bf16x8 qr[8];
    { const bf16* qp = pbase + (size_t)tq * NSA_INP + N_Q + head * 128 + hi * 8;
#pragma unroll
      for (int d0 = 0; d0 < 8; ++d0) qr[d0] = *(const bf16x8*)(qp + d0 * 16); }
#define NSA_GATE(br) sigmoidf_(bf1(pbase[(size_t)tq * NSA_INP + N_G + head * 3 + (br)]))
    float* orow = F.y + (size_t)(b * SEQ + qt * 64 + qh * 32 + 4 * hi) * DM + head * 128 + r32;
    f32x16 o[4];
    const unsigned ldsK0 = (unsigned)(uintptr_t)(L + AT_K), ldsV0 = (unsigned)(uintptr_t)(L + AT_V);
    { const bf16* kc = F.kcmpb + (size_t)(b * 4 + g) * 128 * 128; const bf16* vc = F.vcmpb + (size_t)(b * 4 + g) * 128 * 128;
      DmaOff dc; dma_offsets(dc, wid, lane, 128 * 2);
      dma_tile(dc, kc, vc, ldsK0, ldsV0, wid); dma_tile(dc, kc + 64 * 128, vc + 64 * 128, ldsK0 + 16384u, ldsV0 + 16384u, wid); DMA_WAIT(); }
    if (tid == 0) misc[0] = 0u;
    __syncthreads();
#ifndef NSA_SKIP_CMP
    {
        const int nv = (tq >= 31) ? ((tq - 31) >> 4) + 1 : 0;
        float m_c = -1.0e30f, l_c = 0.f;
#pragma unroll
        for (int d = 0; d < 4; ++d) o[d] = f32x16{};
        { f32x16 p0, p1; qkt(p0, p1, L + AT_K, qr, r32, hi); sm_tile(p0, p1, -1, nv - 1, m_c, l_c, o, wsf, vb0, r32, hi); }
        { f32x16 p0, p1; qkt(p0, p1, L + AT_K + 16384, qr, r32, hi); sm_tile(p0, p1, -1, nv - 65, m_c, l_c, o, wsf, vb0 + 16384, r32, hi); }
        const float inv = (nv > 0) ? 1.f / l_c : 0.f;
        if (hi == 0) wsf[r32] = NSA_GATE(0) * inv;
        asm volatile("s_waitcnt lgkmcnt(0)" ::: "memory");
        { float* ob_ = launder(orow);
#pragma unroll
          for (int r = 0; r < 16; ++r) { const float s = (wsf + 4 * hi)[crow0(r)]; float* op = ob_ + (size_t)crow0(r) * DM;
#pragma unroll
            for (int d = 0; d < 4; ++d) op[32 * d] = o[d][r] * s; } }
        {
            LAS float* iw = impw + (wid * 32 + r32) * 32;
            float prevL = 0.f; const float mnC = -m_c * SM_C;
#define IMP_STEP(C, TS) _Pragma("unroll") for (int rg = 0; rg < 4; ++rg) { const float Gs = (C[4 * rg] + C[4 * rg + 1]) + (C[4 * rg + 2] + C[4 * rg + 3]); \
                const float Lc = xhalf_other(C[4 * rg + 3], hi); iw[8 * TS + 2 * rg + hi] = (Gs + (hi ? Lc : prevL)) * inv; prevL = Lc; }
#define IMP_TILE(KOFF, NB) { f32x16 p0, p1; qkt(p0, p1, L + AT_K + KOFF, qr, r32, hi); const int lim = nv - NB - 4 * hi; \
            _Pragma("unroll") for (int r = 0; r < 16; ++r) { p0[r] = (crow0(r) < lim) ? __builtin_amdgcn_exp2f(fmaf(p0[r], SM_C, mnC)) : 0.f; p1[r] = (32 + crow0(r) < lim) ? __builtin_amdgcn_exp2f(fmaf(p1[r], SM_C, mnC)) : 0.f; } \
            IMP_STEP(p0, (NB / 32)) IMP_STEP(p1, (NB / 32 + 1)) }
            IMP_TILE(0, 0) IMP_TILE(16384, 64)
#undef IMP_TILE
#undef IMP_STEP
        }
    }
#endif
    __syncthreads();
    { const int q = tid >> 3, m4 = (tid & 7) * 4;
      const int w0 = (q >> 5) * 4, rr = q & 31;
#pragma unroll
      for (int i = 0; i < 4; ++i) { const int m = m4 + i;
          imps[q * 32 + m] = (impw[((w0 + 0) * 32 + rr) * 32 + m] + impw[((w0 + 1) * 32 + rr) * 32 + m]) + (impw[((w0 + 2) * 32 + rr) * 32 + m] + impw[((w0 + 3) * 32 + rr) * 32 + m]); } }
    __syncthreads();
    if (tid < 64) { const unsigned mk = nsa_select(imps + tid * 32, qt * 64 + tid); selm[tid] = mk; __hip_atomic_fetch_or(&misc[0], mk, __ATOMIC_RELAXED, __HIP_MEMORY_SCOPE_WORKGROUP); }
    __syncthreads();
    if (tid == 0) { unsigned un = misc[0]; int n = 0;
        for (int j = 0; j <= qt; ++j) if ((un >> j) & 1u) misc[2 + n++] = 0x100u | (unsigned)j;
        for (int j = (qt >= 8 ? qt - 8 : 0); j <= qt; ++j) misc[2 + n++] = 0x200u | (unsigned)j;
        misc[1] = (unsigned)n; }
    DmaOff dof; dma_offsets(dof, wid, lane, NSA_INP * 2);
    dma_tile(dof, pbase + N_KS + g * 128, pbase + N_VS + g * 128, ldsK0, ldsV0, wid);
    __syncthreads();
    const int nt = (int)misc[1];
#define NSA_TILE_SRC(IDX) (pbase + (size_t)(64 * (int)(misc[2 + (IDX)] & 255u)) * NSA_INP + ((misc[2 + (IDX)] >> 8) == 1u ? N_KS : N_KW) + g * 128)
    if (nt > 1) { const bf16* kb1 = NSA_TILE_SRC(1); dma_tile(dof, kb1, kb1 + 512, ldsK0 + 16384u, ldsV0 + 16384u, wid); asm volatile("s_waitcnt vmcnt(4)" ::: "memory"); }
    else DMA_WAIT();
    __syncthreads();
    float m_reg = -1.0e30f, l_reg = 0.f;
#pragma unroll
    for (int d = 0; d < 4; ++d) o[d] = f32x16{};
    int prevkind = 1;
#ifndef NSA_SKIP_LOOP
    for (int i = 0; i < nt; ++i) {
        const unsigned ent = misc[2 + i]; const int kind = (int)(ent >> 8), j = (int)(ent & 255u);
        if (i + 2 < nt) { const bf16* kb = NSA_TILE_SRC(i + 2); const unsigned nb = (unsigned)(((i + 2) % 3) * 16384);
            dma_tile(dof, kb, kb + 512, ldsK0 + nb, ldsV0 + nb, wid); }
#ifndef NSA_SKIP_TRANS
        if (kind != prevkind) {
            if (hi == 0) wsf[r32] = NSA_GATE(1) / l_reg;
            asm volatile("s_waitcnt lgkmcnt(0)" ::: "memory");
            float* ob_ = launder(orow);
#pragma unroll
            for (int r = 0; r < 16; ++r) { const float s = (wsf + 4 * hi)[crow0(r)]; float* op = ob_ + (size_t)crow0(r) * DM;
#pragma unroll
                for (int d = 0; d < 4; ++d) { op[32 * d] += o[d][r] * s; } }
            asm volatile("s_waitcnt vmcnt(0)" ::: "memory");
#pragma unroll
            for (int d = 0; d < 4; ++d) o[d] = f32x16{};
            m_reg = -1.0e30f; l_reg = 0.f; prevkind = kind;
        }
#endif
        int lo = -1, hi2 = 63;
        if (kind == 1) { if (!((selm[qrel] >> j) & 1u)) hi2 = -1; else if (j == qt) hi2 = qrel; }
        else { if (j == qt) hi2 = qrel; else if (j == qt - 8) lo = qrel; }
        const int bo = (i % 3) * 16384;
        f32x16 p0, p1;
        qkt(p0, p1, L + AT_K + bo, qr, r32, hi);
        sm_tile(p0, p1, lo, hi2, m_reg, l_reg, o, wsf, vb0 + bo, r32, hi);
        if (i + 2 < nt) asm volatile("s_waitcnt vmcnt(4)" ::: "memory"); else DMA_WAIT();
        __syncthreads();
    }
#endif
#undef NSA_TILE_SRC
    if (hi == 0) wsf[r32] = NSA_GATE(2) / l_reg;
    asm volatile("s_waitcnt lgkmcnt(0)" ::: "memory");
    const float* ob_ = launder(orow);
#if FP8_P13
    unsigned char* mrow = launder((unsigned char*)F.mix + (size_t)(b * SEQ + qt * 64 + qh * 32 + 4 * hi) * DM + head * 128 + r32);
#pragma unroll
    for (int r = 0; r < 16; ++r) { const float s = (wsf + 4 * hi)[crow0(r)]; const float* op = ob_ + (size_t)crow0(r) * DM; unsigned char* mp = mrow + (size_t)crow0(r) * DM;
#pragma unroll
        for (int d = 0; d < 4; ++d) mp[32 * d] = (unsigned char)(__builtin_amdgcn_cvt_pk_fp8_f32(pg8::clamp448(op[32 * d] + o[d][r] * s), 0.f, 0, false) & 255); }
#else
    bf16* mrow = launder(F.mix + (size_t)(b * SEQ + qt * 64 + qh * 32 + 4 * hi) * DM + head * 128 + r32);
#pragma unroll
    for (int r = 0; r < 16; ++r) { const float s = (wsf + 4 * hi)[crow0(r)]; const float* op = ob_ + (size_t)crow0(r) * DM; bf16* mp = mrow + (size_t)crow0(r) * DM;
#pragma unroll
        for (int d = 0; d < 4; ++d) mp[32 * d] = (bf16)f2bf(op[32 * d] + o[d][r] * s); }
#endif
    __syncthreads();
}

__device__ __forceinline__ void sb_mfma_unit(Frame& F, int unit) {
    const int qb = unit & 7, hh = (unit >> 3) & 7, b = unit >> 6;
    const int tid = F.tid, wid = F.wave, lane = F.lane, r32 = lane & 31, hi = lane >> 5;
    const int tq0 = qb * 256 + wid * 32, tq = tq0 + r32;
    LAS char* L = (LAS char*)F.lds;
    LAS unsigned* actf = (LAS unsigned*)(L + AT_MISC);
    const int vb0 = (int)(unsigned)(uintptr_t)(L + AT_V) + v_rd_base(lane);
    const int sr = tid >> 4, sc = (tid & 15) * 8;
    const bf16* pbase = F.proj + (size_t)b * SEQ * EVEN_IN + hh * 128;
    bf16x8 qr[8];
    { const bf16* qp = pbase + (size_t)tq * EVEN_IN + E_Q + hi * 8;
#pragma unroll
      for (int d0 = 0; d0 < 8; ++d0) qr[d0] = *(const bf16x8*)(qp + d0 * 16); }
    f32x16 o[4];
#pragma unroll
    for (int d = 0; d < 4; ++d) o[d] = f32x16{};
    float R = 0.f;
    KVStage st;
    int jt = qb * 4 + 3;
    DmaOff dof; dma_offsets(dof, wid, lane, EVEN_IN * 2);
    const unsigned ldsK0 = (unsigned)(uintptr_t)(L + AT_K), ldsV0 = (unsigned)(uintptr_t)(L + AT_V);
    dma_tile(dof, pbase + (size_t)(64 * jt) * EVEN_IN + E_K, pbase + (size_t)(64 * jt) * EVEN_IN + E_V, ldsK0, ldsV0, wid);
    DMA_WAIT();
    __syncthreads();
    for (int it = 0;; ++it, --jt) {
        const int bo = (it & 1) * 16384;
        if (jt > 0) dma_tile(dof, pbase + (size_t)(64 * (jt - 1)) * EVEN_IN + E_K, pbase + (size_t)(64 * (jt - 1)) * EVEN_IN + E_V, ldsK0 + (16384u - (unsigned)bo), ldsV0 + (16384u - (unsigned)bo), wid);
        const bool act = (64 * jt < tq0 + 32) && __any(R > -120.f);
        if (act) {
            f32x16 p0, p1;
            qkt(p0, p1, L + AT_K + bo, qr, r32, hi);
            const int kbase = 64 * jt;
            f32x16 k0, k1;
            const int thr = tq - kbase - 4 * hi;
#pragma unroll
            for (int r = 0; r < 16; ++r) {
                const float z0 = p0[r] * QSCALE, z1 = p1[r] * QSCALE;
                const float lb0 = logsigf_(z0), lb1 = logsigf_(z1);
                k0[r] = (crow0(r) < thr) ? lb0 - z0 : 0.f; k1[r] = (32 + crow0(r) < thr) ? lb1 - z1 : 0.f;
                p0[r] = (crow0(r) < thr) ? lb0 : -__builtin_inff(); p1[r] = (32 + crow0(r) < thr) ? lb1 : -__builtin_inff(); }
            float run = R;
#pragma unroll
            for (int ti = 1; ti >= 0; --ti)
#pragma unroll
                for (int rg = 3; rg >= 0; --rg) {
                    const float a0 = ti ? k1[4 * rg] : k0[4 * rg], a1 = ti ? k1[4 * rg + 1] : k0[4 * rg + 1], a2 = ti ? k1[4 * rg + 2] : k0[4 * rg + 2], a3 = ti ? k1[4 * rg + 3] : k0[4 * rg + 3];
                    const float gs_ = (a0 + a1) + (a2 + a3), go_ = xhalf_other(gs_, hi);
                    const float godd = hi ? gs_ : go_, gev = hi ? go_ : gs_;
                    const float sx = hi ? run : run + godd;
                    run += godd + gev;
                    const float e3 = sx, e2 = sx + a3, e1 = e2 + a2, e0 = e1 + a1;
                    if (ti) { p1[4 * rg] = __expf(p1[4 * rg] + e0); p1[4 * rg + 1] = __expf(p1[4 * rg + 1] + e1); p1[4 * rg + 2] = __expf(p1[4 * rg + 2] + e2); p1[4 * rg + 3] = __expf(p1[4 * rg + 3] + e3); }
                    else    { p0[4 * rg] = __expf(p0[4 * rg] + e0); p0[4 * rg + 1] = __expf(p0[4 * rg + 1] + e1); p0[4 * rg + 2] = __expf(p0[4 * rg + 2] + e2); p0[4 * rg + 3] = __expf(p0[4 * rg + 3] + e3); }
                }
            R = run;
            bf16x8 pa0, pa1, pa2, pa3; pack_p(p0, p1, pa0, pa1, pa2, pa3);
            pv_d0(o, vb0 + bo, pa0, pa1, pa2, pa3);
        }
        const bool actn = (jt > 0) && (64 * (jt - 1) < tq0 + 32) && __any(R > -120.f);
        if (lane == 0) actf[(it & 1) * 8 + wid] = actn ? 1u : 0u;
        DMA_WAIT();
        __syncthreads();
        unsigned any = 0u;
#pragma unroll
        for (int w = 0; w < 8; ++w) any |= actf[(it & 1) * 8 + w];
        if (!any) break;
    }
    bf16* mrow = launder(F.mix + (size_t)(b * SEQ + tq0 + 4 * hi) * DM + hh * 128 + r32);
#pragma unroll
    for (int r = 0; r < 16; ++r) { bf16* mp = mrow + (size_t)crow0(r) * DM;
#pragma unroll
        for (int d = 0; d < 4; ++d) mp[32 * d] = (bf16)f2bf(o[d][r]); }
    __syncthreads();
}

__device__ __forceinline__ void cmp_posbias(Frame& F, int idx) {
    const int which = idx >> 5, part = idx & 31;
    const float* w1 = which ? F.cmp_v_w1 : F.cmp_k_w1; const float* pos = which ? F.cmp_pos_v : F.cmp_pos_k;
    LAS float* red = (LAS float*)(F.lds);
    const int dout = F.tid & 127, ks = F.tid >> 7; float acc = 0.f;
    const int kb = part * 128 + ks * 32;
#pragma unroll 16
    for (int k = 0; k < 32; ++k) acc += pos[kb + k] * w1[(size_t)(kb + k) * 128 + dout];
    __syncthreads();
    red[F.tid] = acc;
    __syncthreads();
    if (F.tid < 128) F.cmp_pb[(which * 32 + part) * 128 + F.tid] = (red[F.tid] + red[128 + F.tid]) + (red[256 + F.tid] + red[384 + F.tid]);
    __syncthreads();
}
__device__ __forceinline__ void cmp_mfma_unit(Frame& F, int unit) {
    const int mt = unit % 5, bg = (unit / 5) & 15, which = unit / 80;
    const int b = bg >> 2, g = bg & 3, m0 = 31 * mt;
    const int tid = F.tid, wid = F.wave, lane = F.lane, r32 = lane & 31, hi = lane >> 5, kq = wid & 3, nh = wid >> 2;
    const bf16* W1t = which ? F.Wc1v : F.Wc1k; const bf16* W2t = which ? F.Wc2v : F.Wc2k;
    bf16* outb = which ? F.vcmpb : F.kcmpb;
    const int coff = (which ? N_VC : N_KC) + g * 128;
    LAS float* part = (LAS float*)(F.lds);
    LAS char* hidb = (LAS char*)(F.lds) + 131072;
    LAS float* pb = (LAS float*)(F.lds + 131072 + 32 * 272);
    if (tid < 128) { float s = 0.f; for (int p = 0; p < 32; ++p) s += F.cmp_pb[(which * 32 + p) * 128 + tid]; pb[tid] = s; }
    const int m = m0 + r32; const bool mv = m < 128;
    const bf16* arow = F.proj + ((size_t)b * SEQ + 16 * (mv ? m : 0)) * NSA_INP + coff + 8 * hi;
    const bf16* brow = W1t + (size_t)(nh * 128 + r32) * 2048 + 8 * hi;
    f32x16 acc[4];
#pragma unroll
    for (int i = 0; i < 4; ++i) acc[i] = f32x16{};
#pragma unroll 4
    for (int s = 0; s < 32; ++s) { const int ksg = kq * 32 + s;
        bf16x8 a = *(const bf16x8*)(arow + (size_t)(ksg >> 3) * NSA_INP + (ksg & 7) * 16);
        if (!mv) a = bf16x8{};
#pragma unroll
        for (int nt = 0; nt < 4; ++nt) { const bf16x8 bb = *(const bf16x8*)(brow + (size_t)(nt * 32) * 2048 + ksg * 16);
            acc[nt] = __builtin_amdgcn_mfma_f32_32x32x16_bf16(a, bb, acc[nt], 0, 0, 0); } }
    { LAS float* pp = part + (kq * 32 + 4 * hi) * 256 + nh * 128 + r32;
#pragma unroll
      for (int r = 0; r < 16; ++r)
#pragma unroll
        for (int nt = 0; nt < 4; ++nt) pp[crow0(r) * 256 + nt * 32] = acc[nt][r]; }
    __syncthreads();
    { const int nl = tid >> 4, d8 = (tid & 15) * 8;
      unsigned pk[4];
#pragma unroll
      for (int i = 0; i < 4; ++i) { float hv[2];
#pragma unroll
          for (int q = 0; q < 2; ++q) { const int dd = d8 + 2 * i + q; float u = 0.f;
              if (nl < 31) { u = pb[dd];
#pragma unroll
                  for (int k4 = 0; k4 < 4; ++k4) u += part[(k4 * 32 + nl) * 256 + dd] + part[(k4 * 32 + nl + 1) * 256 + 128 + dd];
                  u = gelu_tanh(u); }
              hv[q] = u; }
          pk[i] = pk2(hv[0], hv[1]); }
      *(LAS v4u*)(hidb + nl * 272 + d8 * 2) = (v4u){pk[0], pk[1], pk[2], pk[3]}; }
    __syncthreads();
    if (wid < 4) {
        f32x16 a2 = f32x16{};
#pragma unroll
        for (int ks = 0; ks < 8; ++ks) { const bf16x8 a = *(const LAS bf16x8*)(hidb + r32 * 272 + (ks * 16 + 8 * hi) * 2);
            const bf16x8 bb = *(const bf16x8*)(W2t + (size_t)(wid * 32 + r32) * 128 + ks * 16 + 8 * hi);
            a2 = __builtin_amdgcn_mfma_f32_32x32x16_bf16(a, bb, a2, 0, 0, 0); }
#pragma unroll
        for (int r = 0; r < 16; ++r) { const int nl = crow0(r) + 4 * hi, n = m0 + nl;
            if (nl < 31 && n < 128) outb[((size_t)bg * 128 + n) * 128 + wid * 32 + r32] = (n < NCMP) ? (bf16)f2bf(a2[r]) : (bf16)0; }
    }
    __syncthreads();
}

__device__ __forceinline__ int lane_now() { int l; asm volatile("v_mbcnt_lo_u32_b32 %0, -1, 0\n\tv_mbcnt_hi_u32_b32 %0, -1, %0" : "=v"(l)); return l; }
struct Args { const float* in[33]; float* out; unsigned char* ws; int ph_lo, ph_hi; };
#define CAS __attribute__((address_space(4)))
__device__ __forceinline__ void load_frame(Frame& F) {
    const CAS Args* ap = (const CAS Args*)__builtin_amdgcn_kernarg_segment_ptr();
    asm volatile("" : "+s"(ap));
    unsigned char* ws = ap->ws;
    F.ctl = (gu32*)(ws + WS_CTL);
    F.x = ap->in[0]; F.c = ap->in[1]; F.ada_mix_w = ap->in[2]; F.ada_mix_b = ap->in[3]; F.norm_mix_g = ap->in[4]; F.ada_ffn_w = ap->in[5]; F.ada_ffn_b = ap->in[6]; F.norm_ffn_g = ap->in[7];
    F.even_in_w = ap->in[8]; F.rg_conv_w = ap->in[9]; F.rg_conv_b = ap->in[10]; F.rg_wa = ap->in[11]; F.rg_ba = ap->in[12]; F.rg_wx = ap->in[13]; F.rg_bx = ap->in[14]; F.rg_lambda = ap->in[15];
    F.even_out_w = ap->in[16]; F.dense_w_gate = ap->in[17]; F.dense_w_up = ap->in[18]; F.dense_w_down = ap->in[19]; F.nsa_in_w = ap->in[20]; F.cmp_pos_k = ap->in[21]; F.cmp_pos_v = ap->in[22];
    F.cmp_k_w1 = ap->in[23]; F.cmp_k_w2 = ap->in[24]; F.cmp_v_w1 = ap->in[25]; F.cmp_v_w2 = ap->in[26]; F.nsa_out_w = ap->in[27]; F.router_w = ap->in[28];
    F.moe_w_gate = ap->in[29]; F.moe_w_up = ap->in[30]; F.moe_w_down = ap->in[31]; F.final_norm_g = ap->in[32]; F.out = ap->out;
    F.Win0 = (bf16*)(ws + WS_WIN0); F.Wout0 = (bf16*)(ws + WS_WOUT0); F.Wgu0 = (bf16*)(ws + WS_WGU0); F.Wdn0 = (bf16*)(ws + WS_WDN0); F.Win1 = (bf16*)(ws + WS_WIN1); F.Wout1 = (bf16*)(ws + WS_WOUT1);
    F.Wmgu = (bf16*)(ws + WS_WMGU); F.Wmdn = (bf16*)(ws + WS_WMDN);
    F.mod = (float*)(ws + WS_MOD); F.xa = (float*)(ws + WS_XA); F.xb = (float*)(ws + WS_XB); F.kcmp = (float*)(ws + WS_KCMP); F.vcmp = (float*)(ws + WS_VCMP);
    F.sumP = (float*)(ws + WS_SUMP); F.sumH = (float*)(ws + WS_SUMH); F.hl = (float*)(ws + WS_HL); F.pc = (float*)(ws + WS_PC); F.y = (float*)(ws + WS_Y); F.rowp = (float*)(ws + WS_ROWP);
    F.route = (int*)(ws + WS_ROUTE);
    F.h = (bf16*)(ws + WS_H); F.proj = (bf16*)(ws + WS_PROJ); F.mix = (bf16*)(ws + WS_MIX); F.act = (bf16*)(ws + WS_ACT); F.hperm = (bf16*)(ws + WS_HPERM); F.kcmpb = (bf16*)(ws + WS_KCMPB); F.vcmpb = (bf16*)(ws + WS_VCMPB); F.Wc1k = (bf16*)(ws + WS_WC1K); F.Wc1v = (bf16*)(ws + WS_WC1V); F.Wc2k = (bf16*)(ws + WS_WC2K); F.Wc2v = (bf16*)(ws + WS_WC2V); F.cmp_pb = (float*)(ws + WS_CMPPB); F.rowsa = (float*)(ws + WS_ROWSA); F.part = (float*)(ws + WS_PART);
}
__global__ void __launch_bounds__(NTHR, 2) mk_fwd(Args args) {
    extern __shared__ __attribute__((aligned(16))) unsigned char lds[];
    Frame F;
    F.lds = (LAS unsigned char*)lds;
    F.MISC = (volatile LAS unsigned*)(F.lds + MISC_OFF);
    const int wave0 = __builtin_amdgcn_readfirstlane((int)threadIdx.x >> 6);
    F.lane = lane_now(); F.wave = wave0; F.tid = wave0 * 64 + F.lane;
    F.G = gridDim.x; { const int bx = blockIdx.x; F.vcu = (F.G % 8 == 0) ? (bx % 8) * (F.G / 8) + bx / 8 : bx; }
    load_frame(F);
    for (int u = F.tid; u < (LDS_BYTES - LDSCTL_OFF) / 4; u += NTHR) ((LAS unsigned*)(F.lds + LDSCTL_OFF))[u] = 0u;
    __syncthreads();
    XcdBarrier bar; bar.bar = (unsigned*)(F.ctl + CW_BAR); bar.x = 0; bar.st = nullptr;
    if (N_LAUNCHES == 1) bar = xcd_barrier_post((unsigned*)(F.ctl + CW_BAR), F.MISC + 8, F.tid);
    const int lo = args.ph_lo, hi = args.ph_hi;
#define IN(k) (lo <= (k) && (k) < hi)
#define SEAM(k) do { if (IN(k) && IN((k) + 1)) xcd_barrier(bar, wave0 * 64 + lane_now()); } while (0)
#ifndef PROBE_DUP
#define PROBE_DUP -1
#endif
#define REP(k) for (int rep_ = (load_frame(F), F.lane = lane_now(), F.wave = wave0, F.tid = wave0 * 64 + F.lane, 0); rep_ < ((PROBE_DUP) == (k) ? 2 : 1); ++rep_)
#define mod0 (F.mod)
#define mod1 (F.mod + 4 * 6144)
#define mod2 (F.mod + 8 * 6144)
#define mod3 (F.mod + 12 * 6144)

    if (IN(0)) REP(0) { p0_adaln(F); p0_zero_pad(F);
        { CvtSeg sg; const int aLo = I8_P2 ? 2560 : 0;
          const int gLo = 3584, gN = I8_DUP ? 7168 : 0;
          const int nLo = 14336, nN = I8_P10 ? 2592 : 0;
          sg.n0 = gLo - aLo; sg.b0 = aLo; sg.n1 = nLo - (gLo + gN); sg.b1 = gLo + gN; sg.b2 = nLo + nN; sg.nv = sg.n0 + sg.n1 + (CVT_TOTAL - sg.b2) - (F.G == 256 ? LATE_ALL : 0);
          p0_convert(F, sg, 0.f); }
        if (I8_DUP) p0_absmax(F, F.dense_w_gate, F.dense_w_up, DM * DFF / 4, CW_WMAX);
#ifdef ABSMAX_PROBE
        for (int rr = 0; rr < 8; ++rr) { asm volatile("" ::: "memory"); p0_absmax(F, F.dense_w_gate, F.dense_w_up, DM * DFF / 4, CW_WMAX); }
#endif
        if (I8_P2) p0_absmax(F, F.even_in_w, F.even_in_w, DM * EVEN_IN / 4, CW_WMAX + 1);
        if (I8_P10) p0_absmax(F, F.nsa_in_w, F.nsa_in_w, DM * NSA_IN / 4, CW_WMAX + 2);
    } SEAM(0);
    if (IN(1)) REP(1) {
        if (I8_DUP) { const float wm = __builtin_bit_cast(float, __hip_atomic_load(F.ctl + CW_WMAX, RLX_AGENT)); CvtSeg sg{7168, 3584, 0, 0, 0, 7168}; p0_convert(F, sg, wm > 0.f ? 127.f / wm : 0.f); }
        if (I8_P2) { const float w1 = __builtin_bit_cast(float, __hip_atomic_load(F.ctl + CW_WMAX + 1, RLX_AGENT)); CvtSeg s1{2560, 0, 0, 0, 0, 2560}; p0_convert(F, s1, w1 > 0.f ? 127.f / w1 : 0.f); }
        if (I8_P10) { const float w2 = __builtin_bit_cast(float, __hip_atomic_load(F.ctl + CW_WMAX + 2, RLX_AGENT)); CvtSeg s2{2592, 14336, 0, 0, 0, 2592}; p0_convert(F, s2, w2 > 0.f ? 127.f / w2 : 0.f); }
        __syncthreads();
        normmod_phase<(I8_P2 ? 2 : 0)>(F, F.x, F.norm_mix_g, mod0); for (int i = F.vcu; i < 64; i += F.G) cmp_posbias(F, i); } SEAM(1);
    if (IN(2)) REP(2) { pg8::StaticOrder S; S.init(MTOK, EVEN_IN, F.G, (int)blockIdx.x);
#if I8_P2
        const float wm = __builtin_bit_cast(float, __hip_atomic_load(F.ctl + CW_WMAX + 1, RLX_AGENT));
        pg8::Gemm g{(const pg8::bf16_t*)F.h, (const pg8::bf16_t*)F.Win0, MTOK, EVEN_IN, DM / 2};
        pg8::EpiBf16Pi8 E{F.proj, EVEN_IN, F.rowsa, wm * (1.f / 127.f)};
        pg8::gemm_phase<pg8::EpiBf16Pi8, pg8::StaticOrder, true, true, 2>(F.lds + RING_OFF, g, S, E, F.tid);
#else
        pg8::Gemm g{F.h, F.Win0, MTOK, EVEN_IN, DM};
        pg8::EpiBf16P E{F.proj, EVEN_IN};
        pg8::gemm_phase<pg8::EpiBf16P, pg8::StaticOrder, true, true>(F.lds + RING_OFF, g, S, E, F.tid);
#endif
        if (LATE_P2 && F.G == 256 && blockIdx.x >= 128) { CvtSeg sl{LATE_P2, CVT_TOTAL - LATE_ALL, 0, 0, 0, LATE_P2}; p0_convert(F, sl, 0.f, ((int)blockIdx.x - 128) * NWAVES + F.wave, 128 * NWAVES); }
    } SEAM(2);
    if (IN(3)) REP(3) { for (int u = F.vcu; u < 256; u += F.G) sb_mfma_unit(F, u);
#ifdef PROBE_SB
        for (int u = F.vcu; u < 256; u += F.G) sb_mfma_unit(F, u);
#endif
        for (int u = F.vcu; u < 2048; u += F.G) rglru_local_unit(F, u);
#ifdef PROBE_RG
        for (int u = F.vcu; u < 2048; u += F.G) rglru_local_unit(F, u);
#endif
    } SEAM(3);
    if (IN(4)) REP(4) { for (int u = F.vcu; u < 512; u += F.G) rglru_fix_unit(F, u); } SEAM(4);
    if (IN(5)) REP(5) { pg8::Gemm g{F.mix, F.Wout0, MTOK, DM, DM}; pg8::StaticOrder S; S.init(MTOK, DM, F.G, (int)blockIdx.x);
#if RES_BF16
        pg8::EpiResidB<true> E{F.x, (pg8::bf16_t*)F.xa, DM, mod0 + 4096, 6144, SEQ, 1.f};
        pg8::gemm_phase<pg8::EpiResidB<true>, pg8::StaticOrder, false, true>(F.lds + RING_OFF, g, S, E, F.tid);
#else
        pg8::EpiResid E{F.x, F.xa, DM, mod0 + 4096, 6144, SEQ, 1.f};
        pg8::gemm_phase<pg8::EpiResid, pg8::StaticOrder, false, true>(F.lds + RING_OFF, g, S, E, F.tid);
#endif
    } SEAM(5);
    if (IN(6)) REP(6) { normmod_phase<(I8_DUP ? 2 : (FP8_DUP ? 1 : 0)), RES_BF16 != 0>(F, F.xa, F.norm_ffn_g, mod1); } SEAM(6);
    if (IN(7)) REP(7) { pg8::StaticOrder S; S.init(MTOK, 2 * DFF, F.G, (int)blockIdx.x);
#if I8_DUP
        const float wm = __builtin_bit_cast(float, __hip_atomic_load(F.ctl + CW_WMAX, RLX_AGENT));
        pg8::Gemm g{(const pg8::bf16_t*)F.h, (const pg8::bf16_t*)F.Wgu0, MTOK, 2 * DFF, DM / 2};
        pg8::EpiSwiGLUi8<FP8_DDN != 0> E{F.act, DFF, F.rowsa, wm * (1.f / 127.f)};
        pg8::gemm_phase<pg8::EpiSwiGLUi8<FP8_DDN != 0>, pg8::StaticOrder, true, true, 2>(F.lds + RING_OFF, g, S, E, F.tid);
#elif FP8_DUP && FP8_DDN
        pg8::Gemm g{(const pg8::bf16_t*)F.h, (const pg8::bf16_t*)F.Wgu0, MTOK, 2 * DFF, DM / 2};
        pg8::EpiSwiGLU8 E{(unsigned char*)F.act, DFF, W8_INV};
        pg8::gemm_phase<pg8::EpiSwiGLU8, pg8::StaticOrder, true, true, 1>(F.lds + RING_OFF, g, S, E, F.tid);
#elif FP8_DUP
        pg8::Gemm g{(const pg8::bf16_t*)F.h, (const pg8::bf16_t*)F.Wgu0, MTOK, 2 * DFF, DM / 2};
        pg8::EpiSwiGLU E{F.act, DFF, W8_INV};
        pg8::gemm_phase<pg8::EpiSwiGLU, pg8::StaticOrder, true, true, 1>(F.lds + RING_OFF, g, S, E, F.tid);
#else
        pg8::Gemm g{F.h, F.Wgu0, MTOK, 2 * DFF, DM};
        pg8::EpiSwiGLU E{F.act, DFF, 1.f};
        pg8::gemm_phase<pg8::EpiSwiGLU, pg8::StaticOrder, true, true>(F.lds + RING_OFF, g, S, E, F.tid);
#endif
    } SEAM(7);
    if (IN(8)) REP(8) { pg8::StaticOrder S; S.init(MTOK, DM, F.G, (int)blockIdx.x);
#if FP8_DDN
        pg8::Gemm g{(const pg8::bf16_t*)F.act, (const pg8::bf16_t*)F.Wdn0, MTOK, DM, DFF / 2};
#if RES_BF16
        pg8::EpiResidB<false> E{F.xa, (pg8::bf16_t*)F.xb, DM, mod1 + 4096, 6144, SEQ, W8_INV};
        pg8::gemm_phase<pg8::EpiResidB<false>, pg8::StaticOrder, false, true, 1>(F.lds + RING_OFF, g, S, E, F.tid);
#else
        pg8::EpiResid E{F.xa, F.xb, DM, mod1 + 4096, 6144, SEQ, W8_INV};
        pg8::gemm_phase<pg8::EpiResid, pg8::StaticOrder, false, true, 1>(F.lds + RING_OFF, g, S, E, F.tid);
#endif
#else
        pg8::Gemm g{F.act, F.Wdn0, MTOK, DM, DFF};
        pg8::EpiResid E{F.xa, F.xb, DM, mod1 + 4096, 6144, SEQ, 1.f};
        pg8::gemm_phase<pg8::EpiResid, pg8::StaticOrder, false, true>(F.lds + RING_OFF, g, S, E, F.tid);
#endif
    } SEAM(8);
    if (IN(9)) REP(9) { normmod_phase<(I8_P10 ? 2 : 0), RES_BF16 != 0>(F, F.xb, F.norm_mix_g + DM, mod2); } SEAM(9);
    if (IN(10)) REP(10) { pg8::StaticOrder S; S.init(MTOK, NSA_INP, F.G, (int)blockIdx.x);
#if I8_P10
        const float wm = __builtin_bit_cast(float, __hip_atomic_load(F.ctl + CW_WMAX + 2, RLX_AGENT));
        pg8::Gemm g{(const pg8::bf16_t*)F.h, (const pg8::bf16_t*)F.Win1, MTOK, NSA_INP, DM / 2};
        pg8::EpiBf16Pi8 E{F.proj, NSA_INP, F.rowsa, wm * (1.f / 127.f)};
        pg8::gemm_phase<pg8::EpiBf16Pi8, pg8::StaticOrder, true, true, 2>(F.lds + RING_OFF, g, S, E, F.tid);
#else
        pg8::Gemm g{F.h, F.Win1, MTOK, NSA_INP, DM};
        pg8::EpiBf16P E{F.proj, NSA_INP};
        pg8::gemm_phase<pg8::EpiBf16P, pg8::StaticOrder, true, true>(F.lds + RING_OFF, g, S, E, F.tid);
#endif
        if (LATE_P10 && F.G == 256 && blockIdx.x >= 160) { CvtSeg sl{LATE_P10, CVT_TOTAL - LATE_ALL + LATE_P2, 0, 0, 0, LATE_P10}; p0_convert(F, sl, 0.f, ((int)blockIdx.x - 160) * NWAVES + F.wave, 96 * NWAVES); }
    } SEAM(10);
    if (IN(11)) REP(11) { for (int u = F.vcu; u < 160; u += F.G) cmp_mfma_unit(F, u);
        if (LATE_P11 && F.G == 256 && F.vcu >= 160) { CvtSeg sl{LATE_P11, CVT_TOTAL - LATE_ALL + LATE_P2 + LATE_P10, 0, 0, 0, LATE_P11}; p0_convert(F, sl, 0.f, (F.vcu - 160) * NWAVES + F.wave, 96 * NWAVES); }
    } SEAM(11);
    if (IN(12)) REP(12) { for (int idx = F.vcu; idx < 256; idx += F.G) { const int bg = idx >> 4, q16 = idx & 15; nsa_mfma_unit(F, (bg << 5) | q16); nsa_mfma_unit(F, (bg << 5) | (31 - q16)); } } SEAM(12);
    if (IN(13)) REP(13) { pg8::StaticOrder S; S.init(MTOK, DM, F.G, (int)blockIdx.x);
#if FP8_P13
        pg8::Gemm g{(const pg8::bf16_t*)F.mix, (const pg8::bf16_t*)F.Wout1, MTOK, DM, DM / 2};
        pg8::EpiResid E{F.xb, F.xa, DM, mod2 + 4096, 6144, SEQ, W8_INV};
        pg8::gemm_phase<pg8::EpiResid, pg8::StaticOrder, false, true, 1>(F.lds + RING_OFF, g, S, E, F.tid);
#else
        pg8::Gemm g{F.mix, F.Wout1, MTOK, DM, DM};
#if RES_BF16
        pg8::EpiResidB<false> E{F.xb, (pg8::bf16_t*)F.xa, DM, mod2 + 4096, 6144, SEQ, 1.f};
        pg8::gemm_phase<pg8::EpiResidB<false>, pg8::StaticOrder, false, true>(F.lds + RING_OFF, g, S, E, F.tid);
#else
        pg8::EpiResid E{F.xb, F.xa, DM, mod2 + 4096, 6144, SEQ, 1.f};
        pg8::gemm_phase<pg8::EpiResid, pg8::StaticOrder, false, true>(F.lds + RING_OFF, g, S, E, F.tid);
#endif
#endif
    } SEAM(13);
    if (IN(14)) REP(14) { for (int tb = F.vcu; tb < 256; tb += F.G) router_block(F, tb, F.xa, F.norm_ffn_g + DM, mod3); } SEAM(14);
    if (IN(15)) REP(15) { for (int tb = F.vcu; tb < 256; tb += F.G) moe_scatter_block(F, tb); } SEAM(15);
    if (IN(16)) REP(16) { pg8::MoeOrder S;
#pragma unroll
        for (int e = 0; e < 9; ++e) S.tc[e] = __builtin_amdgcn_readfirstlane((int)__hip_atomic_load(F.ctl + CW_TILE + e, RLX_AGENT));
        S.nN = 2 * DFF / 256; S.G = F.G; S.c = (int)blockIdx.x; S.plan(0, 0);
#if FP8_MOE
        S.estride = 2u * DFF * DM;
        pg8::Gemm g{(const pg8::bf16_t*)F.hperm, (const pg8::bf16_t*)F.Wmgu, MOE_ROWS, 2 * DFF, DM / 2};
        pg8::EpiSwiGLU8 E{(unsigned char*)F.act, DFF, W8_INV};
        pg8::gemm_phase<pg8::EpiSwiGLU8, pg8::MoeOrder, true, true, 1>(F.lds + RING_OFF, g, S, E, F.tid);
#else
        S.estride = 2u * DFF * DM * 2u;
        pg8::Gemm g{F.hperm, F.Wmgu, MOE_ROWS, 2 * DFF, DM};
        pg8::EpiSwiGLU E{F.act, DFF, 1.f};
        pg8::gemm_phase<pg8::EpiSwiGLU, pg8::MoeOrder, true, true>(F.lds + RING_OFF, g, S, E, F.tid);
#endif
    } SEAM(16);
    if (IN(17)) REP(17) {
#if FP8_MOE
        pg8::MoeOrderT<MOE_SPLIT != 0> S;
#pragma unroll
        for (int e = 0; e < 9; ++e) S.tc[e] = __builtin_amdgcn_readfirstlane((int)__hip_atomic_load(F.ctl + CW_TILE + e, RLX_AGENT));
        S.nN = DM / 256; S.G = F.G; S.c = (int)blockIdx.x; S.estride = (unsigned)DFF * DM; S.plan(DFF / 128, DFF);
        typedef pg8::EpiMoeDown<WS_Y, WS_ROWP, WS_PART, DM> EpiMD; EpiMD E{(unsigned char*)F.mod - WS_MOD};
        pg8::Gemm g{(const pg8::bf16_t*)F.act, (const pg8::bf16_t*)F.Wmdn, MOE_ROWS, DM, DFF / 2};
        pg8::gemm_phase<EpiMD, pg8::MoeOrderT<MOE_SPLIT != 0>, true, true, 1>(F.lds + RING_OFF, g, S, E, F.tid);
#else
        pg8::MoeOrder S;
#pragma unroll
        for (int e = 0; e < 9; ++e) S.tc[e] = __builtin_amdgcn_readfirstlane((int)__hip_atomic_load(F.ctl + CW_TILE + e, RLX_AGENT));
        S.nN = DM / 256; S.G = F.G; S.c = (int)blockIdx.x; S.estride = (unsigned)DFF * DM * 2u; S.plan(DFF / 64, DFF * 2);
        typedef pg8::EpiMoeDown<WS_Y, WS_ROWP, WS_PART, DM> EpiMD; EpiMD E{(unsigned char*)F.mod - WS_MOD};
        pg8::Gemm g{F.act, F.Wmdn, MOE_ROWS, DM, DFF};
        pg8::gemm_phase<EpiMD, pg8::MoeOrder, true, true>(F.lds + RING_OFF, g, S, E, F.tid);
#endif
    } SEAM(17);
    if (IN(18)) REP(18) { final_phase(F, F.xa, mod3 + 4096); }
#undef IN
#undef SEAM
#undef mod0
#undef mod1
#undef mod2
#undef mod3
}

extern "C" void kernel_launch(void* const* d_in, const int* in_sizes, int n_in, void* d_out, int out_size, void* d_ws, size_t ws_size, hipStream_t stream) {
    static int grid = 0;
    if (grid == 0) {
        if (n_in != 33 || in_sizes[0] != MTOK * DM || out_size != MTOK * DM || ws_size < WS_END) {
            fprintf(stderr, "kernel_launch: built for 33 inputs, x/out of %d floats, >= %zu bytes of workspace; got n_in %d, in0 %d, out %d, ws %zu; nothing launched\n", MTOK * DM, (size_t)WS_END, n_in, n_in > 0 ? in_sizes[0] : -1, out_size, ws_size); grid = -1; return; }
        int dev = 0, cus = 0, per_cu = 0;
        if (hipGetDevice(&dev) != hipSuccess || hipDeviceGetAttribute(&cus, hipDeviceAttributeMultiprocessorCount, dev) != hipSuccess) { fprintf(stderr, "kernel_launch: device query failed\n"); grid = -1; return; }
        if (hipFuncSetAttribute((const void*)mk_fwd, hipFuncAttributeMaxDynamicSharedMemorySize, LDS_BYTES) != hipSuccess) { fprintf(stderr, "kernel_launch: hipFuncSetAttribute failed\n"); grid = -1; return; }
        if (hipOccupancyMaxActiveBlocksPerMultiprocessor(&per_cu, (const void*)mk_fwd, NTHR, LDS_BYTES) != hipSuccess || per_cu < 1)
            fprintf(stderr, "kernel_launch: note: occupancy query reports %d workgroups per CU\n", per_cu);
        (void)hipGetLastError();
        grid = cus;
    }
    if (grid < 0) return;
    if (hipMemsetAsync((char*)d_ws + WS_CTL, 0, CTL_ZERO_BYTES, stream) != hipSuccess) { fprintf(stderr, "kernel_launch: memset failed\n"); return; }
    Args a{};
    for (int i = 0; i < 33; ++i) a.in[i] = (const float*)d_in[i];
    a.out = (float*)d_out; a.ws = (unsigned char*)d_ws;
    for (int li = 0; li < N_LAUNCHES; ++li) {
        a.ph_lo = (N_LAUNCHES == 1) ? 0 : li; a.ph_hi = (N_LAUNCHES == 1) ? NPH : li + 1;
        hipLaunchKernelGGL(mk_fwd, dim3(grid), dim3(NTHR), LDS_BYTES, stream, a);
        const hipError_t le = hipPeekAtLastError();
        if (le != hipSuccess) { fprintf(stderr, "kernel_launch: launch %d failed: %s\n", li, hipGetErrorName(le)); break; }
    }
}
```
